# Optimizing an MI355X kernel written in HIP

```python
import math
import jax, jax.numpy as jnp
from jax import lax
import numpy as np

D_MODEL = 1024
BATCH = 8
SEQ = 2048
DEPTH = 1

MEM_LEN = 256
SSM_HEAD_DIM = 64
SSM_HEADS = D_MODEL // SSM_HEAD_DIM
SSM_D_INNER = SSM_HEADS * SSM_HEAD_DIM
SSM_GROUPS = 2
SSM_STATE = 128
CONV_WIDTH = 4
CHUNK = 128
CONV_DIM = SSM_D_INNER + 2 * SSM_GROUPS * SSM_STATE
ATTN_HEAD_DIM = 64
ATTN_HEADS = D_MODEL // ATTN_HEAD_DIM
ATTN_WIDTH = ATTN_HEADS * ATTN_HEAD_DIM
Q_BLOCK = 128
MIX_WIDTH = SSM_D_INNER + ATTN_WIDTH
IN_COLS = 2 * SSM_D_INNER + 2 * SSM_GROUPS * SSM_STATE + SSM_HEADS + 3 * ATTN_WIDTH + ATTN_HEADS
XATTN_HEADS = 4
XATTN_HEAD_DIM = D_MODEL // XATTN_HEADS
D_FF = 4 * D_MODEL
EPS = 1e-5

kernel_name = "hymba_ssd_fox_memxattn_layer"


def rms_norm(u, g):
    uf = u.astype(jnp.float32)
    y = uf * lax.rsqrt(jnp.mean(uf * uf, axis=-1, keepdims=True) + EPS)
    return (y * g.astype(jnp.float32)).astype(u.dtype)


def segsum(a):
    T = a.shape[-1]
    x = jnp.broadcast_to(a[..., :, None], a.shape + (T,))
    x = jnp.where(jnp.tril(jnp.ones((T, T), dtype=bool), -1), x, 0.0)
    x = jnp.cumsum(x, axis=-2)
    return jnp.where(jnp.tril(jnp.ones((T, T), dtype=bool)), x, -jnp.inf)


def causal_depthwise_conv(u, w, b):
    c = u.shape[-1]
    out = lax.conv_general_dilated(
        u, w[:, None, :].astype(u.dtype), window_strides=(1,),
        padding=[(CONV_WIDTH - 1, 0)], dimension_numbers=("NWC", "WIO", "NWC"),
        feature_group_count=c)
    return out + b.astype(u.dtype)


def ssd_chunked(xh, dt, A, Bm, Cm):
    b, S, g, r, p = xh.shape
    n = Bm.shape[-1]
    c = S // CHUNK
    X = (xh * dt[..., None]).reshape(b, c, CHUNK, g, r, p)
    dA = (dt * A).reshape(b, c, CHUNK, g, r).transpose(0, 3, 4, 1, 2)
    Bc = Bm.reshape(b, c, CHUNK, g, n)
    Cc = Cm.reshape(b, c, CHUNK, g, n)
    A_cs = jnp.cumsum(dA, axis=-1)
    Lmat = jnp.exp(segsum(dA))
    CB = jnp.einsum("bclgn,bcsgn->bcgls", Cc, Bc)
    y_diag = jnp.einsum("bcgls,bgrcls,bcsgrp->bclgrp", CB, Lmat, X)
    decay_states = jnp.exp(A_cs[..., -1:] - A_cs)
    states = jnp.einsum("bclgn,bgrcl,bclgrp->bcgrpn", Bc, decay_states, X)
    states = jnp.concatenate([jnp.zeros_like(states[:, :1]), states], axis=1)
    A_last = jnp.pad(A_cs[..., -1], ((0, 0), (0, 0), (0, 0), (1, 0)))
    chunk_decay = jnp.exp(segsum(A_last))
    new_states = jnp.einsum("bgrzc,bcgrpn->bzgrpn", chunk_decay, states)
    states_in = new_states[:, :-1]
    y_off = jnp.einsum("bclgn,bcgrpn,bgrcl->bclgrp", Cc, states_in, jnp.exp(A_cs))
    return (y_diag + y_off).reshape(b, S, g, r, p)


def forgetting_attention(q, k, v, log_f):
    b, S, h, d = q.shape
    cum = jnp.cumsum(log_f, axis=1).transpose(0, 2, 1)
    scale = d ** -0.5
    outs = []
    for i in range(S // Q_BLOCK):
        qs, qe = i * Q_BLOCK, (i + 1) * Q_BLOCK
        s = jnp.einsum("bqhd,bkhd->bhqk", q[:, qs:qe], k[:, :qe]) * scale
        s = s + cum[:, :, qs:qe, None] - cum[:, :, None, :qe]
        mask = jnp.arange(qs, qe)[:, None] >= jnp.arange(qe)[None, :]
        s = jnp.where(mask, s, -jnp.inf)
        pr = jax.nn.softmax(s, axis=-1)
        outs.append(jnp.einsum("bhqk,bkhd->bqhd", pr, v[:, :qe]))
    return jnp.concatenate(outs, axis=1)


def parallel_mixer(h, w_in, conv_w, conv_b, dt_bias, a_log, d_skip, ssm_norm_w,
                   g_q, g_k, f_bias, w_out):
    b, S, _ = h.shape
    proj = h @ w_in
    sizes = [SSM_D_INNER, CONV_DIM, SSM_HEADS, ATTN_WIDTH, ATTN_WIDTH, ATTN_WIDTH]
    idx = list(np.cumsum(sizes))
    z, xbc, dt_raw, q, k, v, f_raw = jnp.split(proj, idx, axis=-1)
    xbc = jax.nn.silu(causal_depthwise_conv(xbc, conv_w, conv_b)).astype(jnp.float32)
    xs, Bm, Cm = jnp.split(xbc, [SSM_D_INNER, SSM_D_INNER + SSM_GROUPS * SSM_STATE], axis=-1)
    r = SSM_HEADS // SSM_GROUPS
    xs = xs.reshape(b, S, SSM_GROUPS, r, SSM_HEAD_DIM)
    Bm = Bm.reshape(b, S, SSM_GROUPS, SSM_STATE)
    Cm = Cm.reshape(b, S, SSM_GROUPS, SSM_STATE)
    dt = jax.nn.softplus(dt_raw.astype(jnp.float32) + dt_bias.astype(jnp.float32))
    dt = dt.reshape(b, S, SSM_GROUPS, r)
    A = -jnp.exp(a_log.astype(jnp.float32)).reshape(SSM_GROUPS, r)
    y = ssd_chunked(xs, dt, A, Bm, Cm)
    y = y + d_skip.astype(jnp.float32).reshape(SSM_GROUPS, r)[..., None] * xs
    y = y.reshape(b, S, SSM_D_INNER) * jax.nn.silu(z.astype(jnp.float32))
    y = y.reshape(b, S, SSM_GROUPS, SSM_D_INNER // SSM_GROUPS)
    y = y * lax.rsqrt(jnp.mean(y * y, axis=-1, keepdims=True) + EPS)
    y = y.reshape(b, S, SSM_D_INNER) * ssm_norm_w.astype(jnp.float32)
    q = rms_norm(q.astype(jnp.float32).reshape(b, S, ATTN_HEADS, ATTN_HEAD_DIM), g_q)
    k = rms_norm(k.astype(jnp.float32).reshape(b, S, ATTN_HEADS, ATTN_HEAD_DIM), g_k)
    v = v.astype(jnp.float32).reshape(b, S, ATTN_HEADS, ATTN_HEAD_DIM)
    log_f = jax.nn.log_sigmoid(f_raw.astype(jnp.float32) + f_bias.astype(jnp.float32))
    o = forgetting_attention(q, k, v, log_f).reshape(b, S, ATTN_WIDTH)
    mixed = jnp.concatenate([y, o], axis=-1).astype(h.dtype)
    return mixed @ w_out


def memory_cross_attention(h, mem_n, xq_w, xkv_w, xg_q, xg_k, xo_w):
    b, S, _ = h.shape
    q = (h @ xq_w).astype(jnp.float32).reshape(b, S, XATTN_HEADS, XATTN_HEAD_DIM)
    kv = (mem_n @ xkv_w).astype(jnp.float32)
    k, v = jnp.split(kv, 2, axis=-1)
    k = k.reshape(b, MEM_LEN, XATTN_HEADS, XATTN_HEAD_DIM)
    v = v.reshape(b, MEM_LEN, XATTN_HEADS, XATTN_HEAD_DIM)
    q = rms_norm(q, xg_q)
    k = rms_norm(k, xg_k)
    s = jnp.einsum("bqhd,bkhd->bhqk", q, k) * (XATTN_HEAD_DIM ** -0.5)
    pr = jax.nn.softmax(s, axis=-1)
    o = jnp.einsum("bhqk,bkhd->bqhd", pr, v).reshape(b, S, D_MODEL).astype(h.dtype)
    return o @ xo_w


def squared_relu_mlp(h, w_up, w_down):
    u = jax.nn.relu(h @ w_up)
    return (u * u) @ w_down


def setup_inputs(seed: int = 0) -> dict:
    key = jax.random.key(seed)
    ks = jax.random.split(key, 24)
    f32 = jnp.float32

    def nrm(k, shape, fan_in):
        return jax.random.normal(k, shape, f32) * (fan_in ** -0.5)

    def gain(k, shape):
        return 1.0 + 0.02 * jax.random.normal(k, shape, f32)

    dt0 = jnp.exp(jax.random.uniform(ks[6], (DEPTH, SSM_HEADS), f32,
                                     math.log(1e-3), math.log(1e-1)))
    dt_bias = dt0 + jnp.log(-jnp.expm1(-dt0))
    return {
        "x": jax.random.normal(ks[0], (BATCH, SEQ, D_MODEL), f32),
        "mem": jax.random.normal(ks[1], (BATCH, MEM_LEN, D_MODEL), f32),
        "g_mix": gain(ks[2], (DEPTH, D_MODEL)),
        "w_in": nrm(ks[3], (DEPTH, D_MODEL, IN_COLS), D_MODEL),
        "conv_w": nrm(ks[4], (DEPTH, CONV_WIDTH, CONV_DIM), CONV_WIDTH),
        "conv_b": 0.02 * jax.random.normal(ks[5], (DEPTH, CONV_DIM), f32),
        "dt_bias": dt_bias,
        "a_log": jnp.log(jax.random.uniform(ks[7], (DEPTH, SSM_HEADS), f32, 1.0, 16.0)),
        "d_skip": gain(ks[8], (DEPTH, SSM_HEADS)),
        "ssm_norm_w": gain(ks[9], (DEPTH, SSM_D_INNER)),
        "g_q": gain(ks[10], (DEPTH, ATTN_HEAD_DIM)),
        "g_k": gain(ks[11], (DEPTH, ATTN_HEAD_DIM)),
        "f_bias": jax.random.uniform(ks[12], (DEPTH, ATTN_HEADS), f32, 2.0, 6.0),
        "w_out": nrm(ks[13], (DEPTH, MIX_WIDTH, D_MODEL), MIX_WIDTH),
        "g_xattn": gain(ks[14], (DEPTH, D_MODEL)),
        "g_mem": gain(ks[15], (DEPTH, D_MODEL)),
        "xq_w": nrm(ks[16], (DEPTH, D_MODEL, D_MODEL), D_MODEL),
        "xkv_w": nrm(ks[17], (DEPTH, D_MODEL, 2 * D_MODEL), D_MODEL),
        "xg_q": gain(ks[18], (DEPTH, XATTN_HEAD_DIM)),
        "xg_k": gain(ks[19], (DEPTH, XATTN_HEAD_DIM)),
        "xo_w": nrm(ks[20], (DEPTH, D_MODEL, D_MODEL), D_MODEL),
        "g_mlp": gain(ks[21], (DEPTH, D_MODEL)),
        "w_up": nrm(ks[22], (DEPTH, D_MODEL, D_FF), D_MODEL),
        "w_down": nrm(ks[23], (DEPTH, D_FF, D_MODEL), D_FF),
    }


def reference(x, mem, g_mix, w_in, conv_w, conv_b, dt_bias, a_log, d_skip, ssm_norm_w,
              g_q, g_k, f_bias, w_out, g_xattn, g_mem, xq_w, xkv_w, xg_q, xg_k, xo_w,
              g_mlp, w_up, w_down):
    for l in range(DEPTH):
        h = rms_norm(x, g_mix[l])
        x = x + parallel_mixer(h, w_in[l], conv_w[l], conv_b[l], dt_bias[l], a_log[l],
                               d_skip[l], ssm_norm_w[l], g_q[l], g_k[l], f_bias[l], w_out[l])
        h = rms_norm(x, g_xattn[l])
        mem_n = rms_norm(mem, g_mem[l])
        x = x + memory_cross_attention(h, mem_n, xq_w[l], xkv_w[l], xg_q[l], xg_k[l], xo_w[l])
        h = rms_norm(x, g_mlp[l])
        x = x + squared_relu_mlp(h, w_up[l], w_down[l])
    return x
```

```cpp
#include <hip/hip_runtime.h>
#include <hip/hip_bf16.h>
#include <cmath>
#include <cstdio>
#include <cstdint>

typedef unsigned short bf16_t;
#define GAS __attribute__((address_space(1)))
#define LAS __attribute__((address_space(3)))
typedef unsigned v4u __attribute__((ext_vector_type(4)));
typedef float f32x4 __attribute__((ext_vector_type(4)));

constexpr int D = 1024, BATCH = 8, SEQ = 2048, M = BATCH * SEQ, MEML = 256, MM = BATCH * MEML;
constexpr int NH = 16, HD = 64, NGRP = 2, NST = 128, CHUNK = 128, NCH = SEQ / CHUNK, CONVD = 1536, MIXW = 2048;
constexpr int IN_COLS = 5664, NIN = 5888;
constexpr int XH = 4, XHD = 256, FF = 4096;
constexpr float EPS = 1e-5f, LOG2E = 1.4426950408889634f;
constexpr float C2 = 0.125f * LOG2E;
constexpr float CX2 = 0.0625f * LOG2E;

__host__ __device__ __forceinline__ int win_src_col(int n) { if (n < 2560) return n; if (n < 5632) return n + 16; if (n < 5648) return n - 5632 + 2560; if (n < 5664) return n; return -1; }

constexpr int NWAVES = 8, NTHR = NWAVES * 64;
constexpr size_t MiB = 1u << 20;
constexpr size_t WS_CTL = 0, CTL_ZERO_BYTES = 32768;
constexpr size_t WS_WIN = 1 * MiB, WS_XKV = 13 * MiB, WS_WOUT = 17 * MiB, WS_XQ = 21 * MiB, WS_XO = 23 * MiB, WS_WUP = 25 * MiB, WS_WDN = 33 * MiB;
constexpr size_t WS_BCA = 1 * MiB;
constexpr size_t WS_ZS = 41 * MiB;
constexpr size_t WS_X1B = WS_ZS;
constexpr size_t WS_BCR = 73 * MiB;
constexpr size_t WS_MIXED = WS_BCR;
constexpr size_t WS_Q = 137 * MiB, WS_K = 169 * MiB, WS_V = 201 * MiB;
constexpr size_t WS_QX = WS_Q, WS_OX = WS_K, WS_X2B = WS_V;
constexpr size_t WS_HB = 73 * MiB;
constexpr size_t WS_KX = 233 * MiB, WS_VX = 237 * MiB;
constexpr size_t WS_DT = 241 * MiB, WS_LF = 242 * MiB, WS_DTT = 243 * MiB, WS_ACS = 244 * MiB, WS_CUMB = 245 * MiB;
constexpr size_t WS_SSQ = 246 * MiB, WS_SSQ2 = 247 * MiB, WS_SSQ3 = 248 * MiB, WS_RSTD1 = 249 * MiB, WS_CBT = 250 * MiB, WS_MEMN = WS_CBT, WS_END = 255 * MiB;
constexpr size_t DO_XB = 0, DO_XRAW = 32 * MiB;

__device__ __forceinline__ float bf2f(bf16_t v) { return __uint_as_float((unsigned)v << 16); }
__device__ __forceinline__ unsigned f2bf(float f) { unsigned u = __float_as_uint(f); return (u + 0x7fffu + ((u >> 16) & 1u)) >> 16; }
__device__ __forceinline__ unsigned pk2(float lo, float hi) { return f2bf(lo) | (f2bf(hi) << 16); }
__device__ __forceinline__ float wave_sum(float v) {
#pragma unroll
    for (int o = 1; o < 64; o <<= 1) v += __shfl_xor(v, o);
    return v;
}
__device__ __forceinline__ float wave_max(float v) {
#pragma unroll
    for (int o = 1; o < 64; o <<= 1) v = fmaxf(v, __shfl_xor(v, o));
    return v;
}
__device__ __forceinline__ float silu_f(float x) { return x * __builtin_amdgcn_rcpf(1.f + __builtin_amdgcn_exp2f(-x * LOG2E)); }
__device__ __forceinline__ float softplus_f(float x) { return x > 20.f ? x : log1pf(expf(x)); }

#define KAS __attribute__((address_space(4)))
struct Ptrs {
    const float *x, *mem, *g_mix, *w_in, *conv_w, *conv_b, *dt_bias, *a_log, *d_skip, *ssm_norm_w, *g_q, *g_k, *f_bias, *w_out, *g_xattn, *g_mem,
        *xq_w, *xkv_w, *xg_q, *xg_k, *xo_w, *g_mlp, *w_up, *w_down;
    float* out; unsigned char* ws;
};
typedef const KAS Ptrs* PtrsK;

namespace pg8 {
typedef short bf16x8 __attribute__((ext_vector_type(8)));
typedef unsigned u32x4 __attribute__((ext_vector_type(4)));
constexpr int BM = 256, BK = 64, HALF = 128, HTB = HALF * BK * 2, STAGE_BYTES = 8 * HTB;
__host__ __device__ __forceinline__ int lds_byte(int r, int c) { const int st = (r >> 4) * 2 + (c >> 5), rr = r & 15, cc = c & 31, ob = rr * 64 + cc * 2; return st * 1024 + (ob ^ (((ob >> 9) & 1) << 5)); }
__host__ __device__ __forceinline__ void stage_rc(int b, int& R, int& C) { const int st = b / 1024, sb = b % 1024, swz = sb ^ (((sb >> 9) & 1) << 5); R = (st >> 1) * 16 + swz / 64; C = (st & 1) * 32 + (swz % 64) / 2; }
__host__ __device__ __forceinline__ int perm32(int rho) { const int n = rho >> 4, i = rho & 15; return 8 * (i >> 2) + 4 * n + (i & 3); }
struct Unit { int pm, pn, kind; const char* a; const char* b; };
typedef f32x4 Acc[2][2][4][2];
__device__ __forceinline__ unsigned cvt_pk_bf16(float lo, float hi) { unsigned r; asm volatile("v_cvt_pk_bf16_f32 %0, %1, %2" : "=v"(r) : "v"(lo), "v"(hi)); return r; }

template <class Epi, class Sched>
__device__ __forceinline__ void gemm_phase(LAS unsigned char* lds, LAS unsigned char* xl, const int K, const Sched& S, const Epi& E) {
    const int tid = threadIdx.x, wid = __builtin_amdgcn_readfirstlane(tid >> 6), lane = tid & 63, wr = wid >> 2, wc = wid & 3, fr = lane & 15, fq = lane >> 4;
    const int nt = K / BK;
    unsigned voffA[2], voffB[2];
#pragma unroll
    for (int i = 0; i < 2; ++i) { int R, C; stage_rc(tid * 16 + i * 8192, R, C); const int Rb = (R >> 5) * 64 + perm32(R & 31);
        voffA[i] = (unsigned)(R * K + C) * 2u; voffB[i] = (unsigned)(Rb * K + C) * 2u; }
    const size_t kstep = (size_t)(BK * 2);
    const size_t hstep = (size_t)HALF * K * 2;
    const size_t bstep = (size_t)32 * K * 2;
    const unsigned ldsw = (unsigned)wid * 1024u;
    const int aoff = lds_byte(wr * 64 + fr, fq * 8), boff = lds_byte(wc * 32 + fr, fq * 8);
#define PG8_SA(b, h) (((b) * 2 + (h)) * HTB)
#define PG8_SB(b, h) ((4 + (b) * 2 + (h)) * HTB)
#define PG8_STAGE(bufoff, gbase, voff) do { _Pragma("unroll") for (int _i = 0; _i < 2; ++_i) \
        __builtin_amdgcn_global_load_lds((const unsigned*)((const char*)(gbase) + (voff)[_i]), (LAS unsigned*)(lds + (bufoff) + ldsw + _i * 8192), 16, 0, 0); } while (0)
#define PG8_LDA(dst, b, h) do { _Pragma("unroll") for (int m = 0; m < 4; ++m) _Pragma("unroll") for (int k = 0; k < 2; ++k) dst[m][k] = *(const LAS bf16x8*)(lds + PG8_SA(b, h) + aoff + m * 2048 + k * 1024); } while (0)
#define PG8_LDB(dst, b, h) do { _Pragma("unroll") for (int n = 0; n < 2; ++n) _Pragma("unroll") for (int k = 0; k < 2; ++k) dst[n][k] = *(const LAS bf16x8*)(lds + PG8_SB(b, h) + boff + n * 2048 + k * 1024); } while (0)
#define PG8_MMA(ai, bj, At, Bt) do { __builtin_amdgcn_s_setprio(1); _Pragma("unroll") for (int m = 0; m < 4; ++m) _Pragma("unroll") for (int n = 0; n < 2; ++n) _Pragma("unroll") for (int k = 0; k < 2; ++k) \
        acc[ai][bj][m][n] = __builtin_amdgcn_mfma_f32_16x16x32_bf16(Bt[n][k], At[m][k], acc[ai][bj][m][n], 0, 0, 0); __builtin_amdgcn_s_setprio(0); } while (0)
#define PG8_WAIT_V(n) asm volatile("s_waitcnt vmcnt(" #n ")" ::: "memory")
#define PG8_WAIT_L(n) asm volatile("s_waitcnt lgkmcnt(" #n ")" ::: "memory")
#define PG8_BAR __builtin_amdgcn_s_barrier()
#define PG8_SCHED __builtin_amdgcn_sched_barrier(0)
    Unit cur, nxt; int ui = 0;
    if (!S.next(0, cur)) return;
    E.prepare(xl, cur, tid);
    asm volatile("s_waitcnt vmcnt(0) lgkmcnt(0)" ::: "memory"); __builtin_amdgcn_s_barrier(); asm volatile("" ::: "memory");
    Acc acc;
#pragma unroll
    for (int a = 0; a < 2; ++a)
#pragma unroll
        for (int b = 0; b < 2; ++b)
#pragma unroll
            for (int m = 0; m < 4; ++m)
#pragma unroll
                for (int n = 0; n < 2; ++n) acc[a][b][m][n] = (f32x4){0.f, 0.f, 0.f, 0.f};
    bf16x8 At[4][2], B0[2][2], B1[2][2];
    const char* cA = cur.a; const char* cB = cur.b;
    PG8_STAGE(PG8_SB(0, 0), cB, voffB); PG8_STAGE(PG8_SB(0, 1), cB + bstep, voffB); PG8_STAGE(PG8_SA(0, 0), cA, voffA); PG8_STAGE(PG8_SA(0, 1), cA + hstep, voffA);
    if (wr == 1) PG8_BAR;
    PG8_WAIT_V(2); PG8_BAR;
    PG8_STAGE(PG8_SB(1, 0), cB + kstep, voffB); PG8_STAGE(PG8_SA(1, 0), cA + kstep, voffA); PG8_STAGE(PG8_SB(1, 1), cB + bstep + kstep, voffB);
    PG8_WAIT_V(6); PG8_BAR;
    for (;;) {
        const bool has_next = S.next(ui + 1, nxt);
        const char* nA = has_next ? nxt.a : cA; const char* nB = has_next ? nxt.b : cB;
        for (int t = 0; t < nt; t += 2) {
            const bool last = (t == nt - 2);
            const char* a1 = cA + (size_t)(t + 1) * kstep;
            const char* a2 = last ? nA : cA + (size_t)(t + 2) * kstep; const char* b2 = last ? nB : cB + (size_t)(t + 2) * kstep;
            const char* a3 = a2 + kstep; const char* b3 = b2 + kstep;
            if constexpr (Epi::KSEG) { if (t == 8 || t == 16) E.kseg(acc, cur, t, wr, fr, xl); }
            PG8_LDB(B0, 0, 0); PG8_LDB(B1, 0, 1); PG8_SCHED; PG8_LDA(At, 0, 0); PG8_STAGE(PG8_SA(1, 1), a1 + hstep, voffA);
            PG8_WAIT_V(8); PG8_WAIT_L(0); PG8_BAR; PG8_MMA(0, 0, At, B0); PG8_MMA(0, 1, At, B1); PG8_BAR; PG8_SCHED;
            PG8_LDA(At, 0, 1); PG8_STAGE(PG8_SB(0, 0), b2, voffB); PG8_STAGE(PG8_SB(0, 1), b2 + bstep, voffB); PG8_STAGE(PG8_SA(0, 0), a2, voffA);
            PG8_WAIT_V(8); PG8_WAIT_L(0); PG8_BAR; PG8_MMA(1, 0, At, B0); PG8_MMA(1, 1, At, B1); PG8_BAR; PG8_SCHED;
            PG8_LDB(B0, 1, 0); PG8_LDB(B1, 1, 1); PG8_SCHED; PG8_LDA(At, 1, 0); PG8_STAGE(PG8_SA(0, 1), a2 + hstep, voffA);
            PG8_WAIT_V(8); PG8_WAIT_L(0); PG8_BAR; PG8_MMA(0, 0, At, B0); PG8_MMA(0, 1, At, B1); PG8_BAR; PG8_SCHED;
            PG8_LDA(At, 1, 1); PG8_STAGE(PG8_SB(1, 0), b3, voffB); PG8_STAGE(PG8_SB(1, 1), b3 + bstep, voffB); PG8_STAGE(PG8_SA(1, 0), a3, voffA);
            PG8_WAIT_V(8); PG8_WAIT_L(0); PG8_BAR; PG8_MMA(1, 0, At, B0); PG8_MMA(1, 1, At, B1); PG8_BAR; PG8_SCHED;
        }
        if (wr == 0) PG8_BAR;
        E.run(acc, cur, wr, wc, fr, fq, xl, lane);
        if (!has_next) break;
#pragma unroll
        for (int a = 0; a < 2; ++a)
#pragma unroll
            for (int b = 0; b < 2; ++b)
#pragma unroll
                for (int m = 0; m < 4; ++m)
#pragma unroll
                    for (int n = 0; n < 2; ++n) acc[a][b][m][n] = (f32x4){0.f, 0.f, 0.f, 0.f};
        cur = nxt; cA = nA; cB = nB; ++ui;
        if (wr == 1) PG8_BAR;
    }
    PG8_WAIT_V(0);
    PG8_BAR;
#undef PG8_SA
#undef PG8_SB
#undef PG8_STAGE
#undef PG8_LDA
#undef PG8_LDB
#undef PG8_MMA
#undef PG8_WAIT_V
#undef PG8_WAIT_L
#undef PG8_BAR
#undef PG8_SCHED
}

struct SchedOne {
    const char* A; const char* Bt; int x, c, ntile; size_t tstep;
    __device__ __forceinline__ bool next(int i, Unit& u) const { const int j = i * 32 + c; if (j >= ntile) return false; u.pm = 8 * x + (j & 7); u.pn = j >> 3; u.kind = 0; u.a = A + (size_t)u.pm * tstep; u.b = Bt + (size_t)u.pn * tstep; return true; }
};
struct SchedP1 {
    const char *outb, *ws; int x, c;
    __device__ __forceinline__ bool next(int i, Unit& u) const {
        const int j = i * 32 + c; if (j >= 192) return false; constexpr size_t tstep = (size_t)256 * D * 2;
        if (j < 184) { u.pm = 8 * x + (j & 7); u.pn = j >> 3; const int pn = u.pn; u.kind = pn < 4 ? 0 : pn < 10 ? 1 : pn < 14 ? 2 : pn < 18 ? 3 : pn < 22 ? 4 : 5; u.a = outb + DO_XB + (size_t)u.pm * tstep; u.b = ws + WS_WIN + (size_t)pn * tstep; }
        else { u.pm = x; u.pn = j - 184; u.kind = u.pn < 4 ? 6 : 7; u.a = ws + WS_MEMN + (size_t)u.pm * tstep; u.b = ws + WS_XKV + (size_t)u.pn * tstep; }
        return true;
    }
};

__device__ __forceinline__ float row_ssq64(const Acc& acc, int ai, int m) {
    float s = 0.f;
#pragma unroll
    for (int bj = 0; bj < 2; ++bj)
#pragma unroll
        for (int n = 0; n < 2; ++n) { const f32x4 v = acc[ai][bj][m][n]; s += (v[0] * v[0] + v[1] * v[1]) + (v[2] * v[2] + v[3] * v[3]); }
    s += __shfl_xor(s, 16); s += __shfl_xor(s, 32); return s;
}
__device__ __forceinline__ void row_ssq256(const Acc& acc, int wr, int wc, int fr, int fq, LAS unsigned char* xl, float (&tot)[2][4]) {
    LAS float* Pp = (LAS float*)xl;
#pragma unroll
    for (int ai = 0; ai < 2; ++ai)
#pragma unroll
        for (int m = 0; m < 4; ++m) { const float s = row_ssq64(acc, ai, m); if (fq == 0) Pp[(ai * HALF + wr * 64 + m * 16 + fr) * 4 + wc] = s; }
    asm volatile("s_waitcnt lgkmcnt(0)" ::: "memory"); __builtin_amdgcn_s_barrier(); asm volatile("" ::: "memory");
#pragma unroll
    for (int ai = 0; ai < 2; ++ai)
#pragma unroll
        for (int m = 0; m < 4; ++m) { const f32x4 p = *(const LAS f32x4*)(Pp + (ai * HALF + wr * 64 + m * 16 + fr) * 4); tot[ai][m] = (p[0] + p[1]) + (p[2] + p[3]); }
    asm volatile("s_waitcnt lgkmcnt(0)" ::: "memory"); __builtin_amdgcn_s_barrier(); asm volatile("" ::: "memory");
}
__device__ __forceinline__ u32x4 pack8(const f32x4 a, const f32x4 b) { u32x4 w; w.x = cvt_pk_bf16(a[0], a[1]); w.y = cvt_pk_bf16(a[2], a[3]); w.z = cvt_pk_bf16(b[0], b[1]); w.w = cvt_pk_bf16(b[2], b[3]); return w; }
__device__ __forceinline__ float sum16(const float* p) { const f32x4 a = *(const f32x4*)p, b = *(const f32x4*)(p + 4), c = *(const f32x4*)(p + 8), d = *(const f32x4*)(p + 12);
    return ((a[0] + a[1]) + (a[2] + a[3])) + ((b[0] + b[1]) + (b[2] + b[3])) + ((c[0] + c[1]) + (c[2] + c[3])) + ((d[0] + d[1]) + (d[2] + d[3])); }

__device__ __forceinline__ float softplus_fast(float x) {
    const float t = __builtin_amdgcn_exp2f(fminf(x, 60.f) * LOG2E);
    const float small = t * (1.f - t * (0.5f - t * 0.33333334f)), big = __builtin_amdgcn_logf(1.f + t) * 0.6931471805599453f;
    return x > 20.f ? x : (t < 0.015625f ? small : big);
}
struct EpiP1 {
    static constexpr bool KSEG = false;
    PtrsK PP;
    __device__ __forceinline__ void kseg(Acc&, const Unit&, int, int, int, LAS unsigned char*) const {}
    __device__ __forceinline__ void prepare(LAS unsigned char* xl, const Unit& u, int tid) const {
        if (tid < 256) ((LAS float*)(xl + 4096))[tid] = ((const float*)(PP->ws + WS_RSTD1))[u.pm * BM + tid]; }
    template <int KIND> __device__ __forceinline__ void body(Acc& acc, const Unit& u, int wr, int wc, int fr, int fq, LAS unsigned char* xl, bf16_t* base, int ldc, int colt, const float* gp) const {
        const int rowt = wr * 64 + fr, row0 = u.pm * BM + rowt, colw = wc * 64 + 8 * fq;
        const LAS float* RSC = (const LAS float*)(xl + 4096) + rowt;
        float tot[2][4];
        if (KIND == 6) row_ssq256(acc, wr, wc, fr, fq, xl, tot);
        f32x4 g[2][2];
        if (KIND == 2 || KIND == 3 || KIND == 6) {
#pragma unroll
            for (int bj = 0; bj < 2; ++bj)
#pragma unroll
                for (int n = 0; n < 2; ++n) g[bj][n] = *(const f32x4*)(gp + bj * 32 + n * 4);
        }
#pragma unroll
        for (int ai = 0; ai < 2; ++ai)
#pragma unroll
            for (int m = 0; m < 4; ++m) {
                const int row = row0 + ai * HALF + m * 16;
                float rs = KIND < 6 ? RSC[ai * HALF + m * 16] : 1.f;
                if (KIND == 2 || KIND == 3) { const float s2 = row_ssq64(acc, ai, m) * rs * rs; rs *= rsqrtf(s2 * (1.f / 64.f) + EPS); if (KIND == 2) rs *= C2; }
                if (KIND == 6) rs = rsqrtf(tot[ai][m] * (1.f / 256.f) + EPS);
                bf16_t* rowp = base + (size_t)row * ldc + colt + colw;
#pragma unroll
                for (int bj = 0; bj < 2; ++bj) {
                    f32x4 v0 = acc[ai][bj][m][0], v1 = acc[ai][bj][m][1];
                    if (KIND != 7) { v0 = v0 * rs; v1 = v1 * rs; }
                    if (KIND == 2 || KIND == 3 || KIND == 6) { v0 = v0 * g[bj][0]; v1 = v1 * g[bj][1]; }
                    if (KIND == 0) {
#pragma unroll
                        for (int e = 0; e < 4; ++e) { v0[e] = silu_f(v0[e]); v1[e] = silu_f(v1[e]); } }
                    *(u32x4*)(rowp + bj * 32) = pack8(v0, v1);
                }
            }
    }
    __device__ __forceinline__ void run(Acc& acc, const Unit& u, int wr, int wc, int fr, int fq, LAS unsigned char* xl, int lane) const {
        const int kind = u.kind; unsigned char* ws = PP->ws; const int colw = wc * 64 + 8 * fq;
        switch (kind) {
        case 0: body<0>(acc, u, wr, wc, fr, fq, xl, (bf16_t*)(ws + WS_ZS), 1024, u.pn * 256, nullptr); break;
        case 1: if (u.pn < 8) body<1>(acc, u, wr, wc, fr, fq, xl, (bf16_t*)((unsigned char*)PP->out + DO_XRAW), 1024, (u.pn - 4) * 256, nullptr);
                else body<1>(acc, u, wr, wc, fr, fq, xl, (bf16_t*)(ws + WS_BCR), 512, (u.pn - 8) * 256, nullptr); break;
        case 2: body<2>(acc, u, wr, wc, fr, fq, xl, (bf16_t*)(ws + WS_Q), 1024, (u.pn - 10) * 256, PP->g_q + 8 * fq); break;
        case 3: body<3>(acc, u, wr, wc, fr, fq, xl, (bf16_t*)(ws + WS_K), 1024, (u.pn - 14) * 256, PP->g_k + 8 * fq); break;
        case 4: body<1>(acc, u, wr, wc, fr, fq, xl, (bf16_t*)(ws + WS_V), 1024, (u.pn - 18) * 256, nullptr); break;
        case 6: body<6>(acc, u, wr, wc, fr, fq, xl, (bf16_t*)(ws + WS_KX), 1024, u.pn * 256, PP->xg_k + colw); break;
        case 7: body<7>(acc, u, wr, wc, fr, fq, xl, (bf16_t*)(ws + WS_VX), 1024, (u.pn - 4) * 256, nullptr); break;
        default: {
            if (wc == 0) {
                const int rowt = wr * 64 + fr, row0 = u.pm * BM + rowt; const LAS float* RSC = (const LAS float*)(xl + 4096) + rowt;
                const int c0 = 8 * fq; const bool isdt = fq < 2;
                const float* bias = isdt ? PP->dt_bias + c0 : PP->f_bias + (c0 - 16); float* dst = isdt ? (float*)(ws + WS_DT) + c0 : (float*)(ws + WS_LF) + (c0 - 16);
                const f32x4 b0 = *(const f32x4*)bias, b1 = *(const f32x4*)(bias + 4); const float sg = isdt ? 1.f : -1.f;
#pragma unroll
                for (int ai = 0; ai < 2; ++ai)
#pragma unroll
                    for (int m = 0; m < 4; ++m) { const int row = row0 + ai * HALF + m * 16; const float rs = RSC[ai * HALF + m * 16];
                        f32x4 v0 = acc[ai][0][m][0] * rs + b0, v1 = acc[ai][0][m][1] * rs + b1;
#pragma unroll
                        for (int e = 0; e < 4; ++e) { v0[e] = sg * softplus_fast(sg * v0[e]); v1[e] = sg * softplus_fast(sg * v1[e]); }
                        *(f32x4*)(dst + (size_t)row * 16) = v0; *(f32x4*)(dst + (size_t)row * 16 + 4) = v1; }
            } } break;
        }
    }
};
template <bool KSEG_, bool BASE_BF16> struct EpiRes {
    static constexpr bool KSEG = KSEG_;
    const void* base; bf16_t* XBo; float* SSQo; const float* SSQi;
    __device__ __forceinline__ void prepare(LAS unsigned char* xl, const Unit& u, int tid) const {
        if (KSEG_ && tid < 256) { const float* sp = SSQi + (size_t)(u.pm * BM + tid) * 16;
            const f32x4 a = *(const f32x4*)sp, b = *(const f32x4*)(sp + 4), c = *(const f32x4*)(sp + 8), d = *(const f32x4*)(sp + 12);
            const float q0 = ((a[0] + a[1]) + (a[2] + a[3])) + ((b[0] + b[1]) + (b[2] + b[3])), q1 = ((c[0] + c[1]) + (c[2] + c[3])) + ((d[0] + d[1]) + (d[2] + d[3]));
            const float r0 = rsqrtf(q0 * (1.f / 512.f) + EPS), r1 = rsqrtf(q1 * (1.f / 512.f) + EPS);
            ((LAS float*)(xl + 4096))[tid] = r0 / r1; ((LAS float*)(xl + 5120))[tid] = r1; } }
    __device__ __forceinline__ void kseg(Acc& acc, const Unit& u, int t, int wr, int fr, LAS unsigned char* xl) const {
        const LAS float* F = (const LAS float*)(xl + (t == 8 ? 4096 : 5120)) + wr * 64 + fr;
#pragma unroll
        for (int ai = 0; ai < 2; ++ai)
#pragma unroll
            for (int m = 0; m < 4; ++m) { const float f = F[ai * HALF + m * 16];
#pragma unroll
                for (int bj = 0; bj < 2; ++bj)
#pragma unroll
                    for (int n = 0; n < 2; ++n) acc[ai][bj][m][n] = acc[ai][bj][m][n] * f; }
    }
    __device__ __forceinline__ void run(Acc& acc, const Unit& u, int wr, int wc, int fr, int fq, LAS unsigned char* xl, int lane) const {
        const int row0 = u.pm * BM + wr * 64 + fr, col0 = u.pn * 256 + wc * 64 + 8 * fq;
        static_assert(BASE_BF16, "the residual base is a bf16 stream");
        u32x4 wb[2][4][2];
#pragma unroll
        for (int ai = 0; ai < 2; ++ai)
#pragma unroll
            for (int m = 0; m < 4; ++m)
#pragma unroll
                for (int bj = 0; bj < 2; ++bj) wb[ai][m][bj] = *(const u32x4*)((const bf16_t*)base + (size_t)(row0 + ai * HALF + m * 16) * D + col0 + bj * 32);
        asm volatile("" ::: "memory");
#pragma unroll
        for (int ai = 0; ai < 2; ++ai) {
#pragma unroll
            for (int m = 0; m < 4; ++m) { const int row = row0 + ai * HALF + m * 16; const size_t off = (size_t)row * D + col0; float s = 0.f;
#pragma unroll
                for (int bj = 0; bj < 2; ++bj) { const u32x4 w = wb[ai][m][bj];
                    const f32x4 x0 = (f32x4){__uint_as_float(w.x << 16), __uint_as_float(w.x & 0xffff0000u), __uint_as_float(w.y << 16), __uint_as_float(w.y & 0xffff0000u)};
                    const f32x4 x1 = (f32x4){__uint_as_float(w.z << 16), __uint_as_float(w.z & 0xffff0000u), __uint_as_float(w.w << 16), __uint_as_float(w.w & 0xffff0000u)};
                    const f32x4 v0 = acc[ai][bj][m][0] + x0, v1 = acc[ai][bj][m][1] + x1;
                    *(u32x4*)(XBo + off + bj * 32) = pack8(v0, v1);
                    s += ((v0[0] * v0[0] + v0[1] * v0[1]) + (v0[2] * v0[2] + v0[3] * v0[3])) + ((v1[0] * v1[0] + v1[1] * v1[1]) + (v1[2] * v1[2] + v1[3] * v1[3])); }
                s += __shfl_xor(s, 16); s += __shfl_xor(s, 32);
                if (fq == 0) SSQo[(size_t)row * 16 + u.pn * 4 + wc] = s; } }
    }
};
struct EpiXq {
    static constexpr bool KSEG = false;
    const float *SSQ2, *xg_q; bf16_t* QX;
    __device__ __forceinline__ void kseg(Acc&, const Unit&, int, int, int, LAS unsigned char*) const {}
    __device__ __forceinline__ void prepare(LAS unsigned char* xl, const Unit& u, int tid) const {
        if (tid < 256) ((LAS float*)(xl + 4096))[tid] = rsqrtf(sum16(SSQ2 + (size_t)(u.pm * BM + tid) * 16) * (1.f / 1024.f) + EPS); }
    __device__ __forceinline__ void run(Acc& acc, const Unit& u, int wr, int wc, int fr, int fq, LAS unsigned char* xl, int lane) const {
        const int row0 = u.pm * BM + wr * 64 + fr, colw = wc * 64 + 8 * fq;
        float tot[2][4];
        row_ssq256(acc, wr, wc, fr, fq, xl, tot);
        f32x4 g[2][2];
#pragma unroll
        for (int bj = 0; bj < 2; ++bj)
#pragma unroll
            for (int n = 0; n < 2; ++n) g[bj][n] = *(const f32x4*)(xg_q + colw + bj * 32 + n * 4);
#pragma unroll
        for (int ai = 0; ai < 2; ++ai)
#pragma unroll
            for (int m = 0; m < 4; ++m) { const int row = row0 + ai * HALF + m * 16;
                const float rs2 = ((const LAS float*)(xl + 4096))[wr * 64 + fr + ai * HALF + m * 16];
                const float rs = rs2 * rsqrtf(tot[ai][m] * rs2 * rs2 * (1.f / 256.f) + EPS) * CX2;
                bf16_t* rowp = QX + (size_t)row * D + u.pn * 256 + colw;
#pragma unroll
                for (int bj = 0; bj < 2; ++bj) *(u32x4*)(rowp + bj * 32) = pack8(acc[ai][bj][m][0] * rs * g[bj][0], acc[ai][bj][m][1] * rs * g[bj][1]); }
    }
};
struct EpiUp {
    static constexpr bool KSEG = false;
    const float* SSQ3; bf16_t* HB;
    __device__ __forceinline__ void kseg(Acc&, const Unit&, int, int, int, LAS unsigned char*) const {}
    __device__ __forceinline__ void prepare(LAS unsigned char* xl, const Unit& u, int tid) const {
        if (tid < 256) ((LAS float*)(xl + 4096))[tid] = rsqrtf(sum16(SSQ3 + (size_t)(u.pm * BM + tid) * 16) * (1.f / 1024.f) + EPS); }
    __device__ __forceinline__ void run(Acc& acc, const Unit& u, int wr, int wc, int fr, int fq, LAS unsigned char* xl, int lane) const {
        const int row0 = u.pm * BM + wr * 64 + fr, colw = wc * 64 + 8 * fq;
#pragma unroll
        for (int ai = 0; ai < 2; ++ai)
#pragma unroll
            for (int m = 0; m < 4; ++m) { const int row = row0 + ai * HALF + m * 16;
                const float rs = ((const LAS float*)(xl + 4096))[wr * 64 + fr + ai * HALF + m * 16];
                bf16_t* rowp = HB + (size_t)row * FF + u.pn * 256 + colw;
#pragma unroll
                for (int bj = 0; bj < 2; ++bj) { f32x4 v0 = acc[ai][bj][m][0] * rs, v1 = acc[ai][bj][m][1] * rs;
#pragma unroll
                    for (int e = 0; e < 4; ++e) { const float a = fmaxf(v0[e], 0.f), b = fmaxf(v1[e], 0.f); v0[e] = a * a; v1[e] = b * b; }
                    *(u32x4*)(rowp + bj * 32) = pack8(v0, v1); } }
    }
};
struct EpiDown {
    static constexpr bool KSEG = false;
    const bf16_t* X2B; float* out;
    __device__ __forceinline__ void kseg(Acc&, const Unit&, int, int, int, LAS unsigned char*) const {}
    __device__ __forceinline__ void prepare(LAS unsigned char*, const Unit&, int) const {}
    __device__ __forceinline__ void run(Acc& acc, const Unit& u, int wr, int wc, int fr, int fq, LAS unsigned char* xl, int lane) const {
        const int row0 = u.pm * BM + wr * 64 + fr, col0 = u.pn * 256 + wc * 64 + 8 * fq;
        u32x4 w[2][4][2];
#pragma unroll
        for (int ai = 0; ai < 2; ++ai)
#pragma unroll
            for (int m = 0; m < 4; ++m)
#pragma unroll
                for (int bj = 0; bj < 2; ++bj) w[ai][m][bj] = *(const u32x4*)(X2B + (size_t)(row0 + ai * HALF + m * 16) * D + col0 + bj * 32);
        asm volatile("" ::: "memory");
#pragma unroll
        for (int ai = 0; ai < 2; ++ai) {
#pragma unroll
            for (int m = 0; m < 4; ++m) { const size_t off = (size_t)(row0 + ai * HALF + m * 16) * D + col0;
#pragma unroll
                for (int bj = 0; bj < 2; ++bj) { const u32x4 ww = w[ai][m][bj];
                    const f32x4 x0 = (f32x4){__uint_as_float(ww.x << 16), __uint_as_float(ww.x & 0xffff0000u), __uint_as_float(ww.y << 16), __uint_as_float(ww.y & 0xffff0000u)};
                    const f32x4 x1 = (f32x4){__uint_as_float(ww.z << 16), __uint_as_float(ww.z & 0xffff0000u), __uint_as_float(ww.w << 16), __uint_as_float(ww.w & 0xffff0000u)};
                    *(f32x4*)(out + off + bj * 32) = acc[ai][bj][m][0] + x0; *(f32x4*)(out + off + bj * 32 + 4) = acc[ai][bj][m][1] + x1; } }
            asm volatile("" ::: "memory"); }
    }
};
}

namespace attn_body {
using bf16=__hip_bfloat16;
using bf16x8=__attribute__((ext_vector_type(8)))short;
using s16x4=__attribute__((ext_vector_type(4)))short;
using f32x16=__attribute__((ext_vector_type(16)))float;
using u32x4=__attribute__((ext_vector_type(4)))unsigned;
using f32x4_t=__attribute__((ext_vector_type(4)))float;
constexpr int BATCH=8,NHEAD=16,SEQ=2048,D=64,DM=NHEAD*D,OPITCH=2048,OCOL0=1024;
constexpr int NW=8,QBLK=32,QB=QBLK*NW,KVBLK=64,NQB=SEQ/QB;
constexpr int ATTN_PITCH=DM, ATTN_UNIT_ROWS=QB;
__device__ __forceinline__ int crow(int r,int hi){return (r&3)+8*(r>>2)+4*hi;}
#define SBAR() __builtin_amdgcn_sched_barrier(0)
__device__ __forceinline__ void cmask(f32x16&p0,f32x16&p1,int jb,int qrel,int hi){
  const float NEG=-INFINITY; int kb=64*jb+4*hi;
  #pragma unroll
  for(int r=0;r<16;++r){int kv=kb+(r&3)+8*(r>>2); if(kv>qrel)p0[r]=NEG; if(kv+32>qrel)p1[r]=NEG;}
}

constexpr int NSLOT=3, SLOTB=8192;
constexpr int LDS_K=0, LDS_V=NSLOT*SLOTB, LDS_WS=2*NSLOT*SLOTB, LDS_OST=LDS_WS+NW*64*4, LDS_CBL=LDS_OST+NW*4096, LDS_BYTES=LDS_CBL+SEQ*4;
__device__ __forceinline__ void glds16(const void*sbase,unsigned voff,unsigned lds_dst){unsigned keep;
  asm volatile("s_mov_b32 %0, m0\n\ts_mov_b32 m0, %2\n\ts_nop 4\n\tglobal_load_lds_dwordx4 %1, %3\n\ts_mov_b32 m0, %0":"=&s"(keep):"v"(voff),"s"(lds_dst),"s"(sbase):"memory");}
__device__ __forceinline__ float max3f(float a,float b,float c){float r;asm("v_max3_f32 %0, %1, %2, %3":"=v"(r):"v"(a),"v"(b),"v"(c));return r;}
__device__ __forceinline__ float max2f(float a,float b){float r;asm("v_max_f32_e32 %0, %1, %2":"=v"(r):"v"(a),"v"(b));return r;}
__device__ __forceinline__ float fadd_s(float a,float b){float r;asm("v_add_f32_e32 %0, %1, %2":"=v"(r):"v"(a),"v"(b));return r;}
__device__ __forceinline__ float fsub_s(float a,float b){float r;asm("v_sub_f32_e32 %0, %1, %2":"=v"(r):"v"(a),"v"(b));return r;}
typedef float f32x2_t __attribute__((ext_vector_type(2))); typedef __bf16 bf16x2_t __attribute__((ext_vector_type(2)));
__device__ __forceinline__ unsigned cvtpk_s(float lo,float hi){f32x2_t v={lo,hi};bf16x2_t b=__builtin_convertvector(v,bf16x2_t);return __builtin_bit_cast(unsigned,b);}
#define WAIT_BAR(N) asm volatile("s_waitcnt vmcnt(" #N ") lgkmcnt(0)\n\ts_barrier":::"memory")

__device__ __forceinline__ void qkt(f32x16&p0,f32x16&p1,const char*Kslot,const bf16x8*qr,int r32,int hi){
  const char*kb=Kslot+hi*1024+r32*16;
  #pragma unroll
  for(int d0=0;d0<4;++d0){
    const bf16x8 b0=*reinterpret_cast<const bf16x8*>(kb+d0*2048);
    const bf16x8 b1=*reinterpret_cast<const bf16x8*>(kb+d0*2048+512);
    p0=__builtin_amdgcn_mfma_f32_32x32x16_bf16(b0,qr[d0],p0,0,0,0);p1=__builtin_amdgcn_mfma_f32_32x32x16_bf16(b1,qr[d0],p1,0,0,0);}
}
typedef __attribute__((address_space(3))) const char* lds_cptr;
typedef short v4i16_t __attribute__((ext_vector_type(4)));
__device__ __forceinline__ void kload8(bf16x8*kf,lds_cptr kp){
  kf[0]=*(const __attribute__((address_space(3))) bf16x8*)(kp);      kf[1]=*(const __attribute__((address_space(3))) bf16x8*)(kp+512);
  kf[2]=*(const __attribute__((address_space(3))) bf16x8*)(kp+2048); kf[3]=*(const __attribute__((address_space(3))) bf16x8*)(kp+2560);
  kf[4]=*(const __attribute__((address_space(3))) bf16x8*)(kp+4096); kf[5]=*(const __attribute__((address_space(3))) bf16x8*)(kp+4608);
  kf[6]=*(const __attribute__((address_space(3))) bf16x8*)(kp+6144); kf[7]=*(const __attribute__((address_space(3))) bf16x8*)(kp+6656);
}
__device__ __forceinline__ void kload2(bf16x8*kf,lds_cptr kp,int j){ kf[2*j]=*(const __attribute__((address_space(3))) bf16x8*)(kp+j*2048); kf[2*j+1]=*(const __attribute__((address_space(3))) bf16x8*)(kp+j*2048+512); }
__device__ __forceinline__ s16x4 vtr(lds_cptr p){ return __builtin_bit_cast(s16x4,__builtin_amdgcn_ds_read_tr16_b64_v4i16((__attribute__((address_space(3))) v4i16_t*)p)); }
__device__ __forceinline__ float rowmax(const f32x16&p0,const f32x16&p1){
  float a=max3f(p0[0],p0[1],p1[0]),b=max3f(p0[2],p0[3],p1[1]);a=max3f(a,p1[2],p1[3]);
  #pragma unroll
  for(int r=4;r<16;r+=4){a=max3f(a,p0[r],p0[r+1]);b=max3f(b,p0[r+2],p0[r+3]);a=max3f(a,p1[r],p1[r+1]);b=max3f(b,p1[r+2],p1[r+3]);}
  const float m=max2f(a,b);
  auto rr=__builtin_amdgcn_permlane32_swap(__float_as_uint(m),__float_as_uint(m),false,false);
  return max2f(__uint_as_float(rr[0]),__uint_as_float(rr[1]));
}
__device__ __forceinline__ void pv(f32x16*o,int vb,bf16x8 pa0,bf16x8 pa1,bf16x8 pa2,bf16x8 pa3){
  #pragma unroll
  for(int d0=0;d0<2;++d0){s16x4 lo[4],hi[4];
    #pragma unroll
    for(int ks=0;ks<4;++ks){
      asm volatile("ds_read_b64_tr_b16 %0,%1 offset:%c2":"=&v"(lo[ks]):"v"(vb),"i"(d0*4096+ks*1024):"memory");
      asm volatile("ds_read_b64_tr_b16 %0,%1 offset:%c2":"=&v"(hi[ks]):"v"(vb),"i"(d0*4096+ks*1024+512):"memory");}
    asm volatile("s_waitcnt lgkmcnt(0)":::"memory");SBAR();
    #define PK(k) (bf16x8){lo[k][0],lo[k][1],lo[k][2],lo[k][3],hi[k][0],hi[k][1],hi[k][2],hi[k][3]}
    o[d0]=__builtin_amdgcn_mfma_f32_32x32x16_bf16(pa0,PK(0),o[d0],0,0,0);
    o[d0]=__builtin_amdgcn_mfma_f32_32x32x16_bf16(pa1,PK(1),o[d0],0,0,0);
    o[d0]=__builtin_amdgcn_mfma_f32_32x32x16_bf16(pa2,PK(2),o[d0],0,0,0);
    o[d0]=__builtin_amdgcn_mfma_f32_32x32x16_bf16(pa3,PK(3),o[d0],0,0,0);
    #undef PK
  }
}

#ifndef ATTN_STORE16
#define ATTN_STORE16(p,v) (*(u32x4*)(p)=(v))
#endif
template<int THRL> __device__ __forceinline__ void attn_unit(int b,int h,int qb,const bf16*Q,const bf16*__restrict__ K,const bf16*__restrict__ V,bf16*O,char*shm,int&r0,const bool pre,const bool pre_next){
  const int tid=threadIdx.x,lane=tid&63,r32=lane&31,hi=lane>>5; const int wid=__builtin_amdgcn_readfirstlane(tid>>6);
  const long rowbase=(long)b*SEQ; const int q0=qb*QB;
  const bf16*Qw=Q+(rowbase+q0+wid*QBLK)*DM+h*D;
  const bf16*Kh=K+rowbase*DM+h*D,*Vh=V+rowbase*DM+h*D;
  const unsigned lds0=(unsigned)(uintptr_t)shm;
  float*wsf=(float*)(shm+LDS_WS)+wid*64;
  const unsigned koff=(unsigned)((lane*DM+wid*8)*2);
  const unsigned voff=(unsigned)(((16*(wid&3)+(lane>>2))*DM+(wid>>2)*32+(lane&3)*8)*2);
  const unsigned kdst=lds0+LDS_K+wid*1024, vdst=lds0+LDS_V+wid*1024;
  #define DMA_K(t,slot) glds16(Kh+(long)(t)*KVBLK*DM,koff,(unsigned)__builtin_amdgcn_readfirstlane(kdst+(slot)))
  #define DMA_V(t,slot) glds16(Vh+(long)(t)*KVBLK*DM,voff,(unsigned)__builtin_amdgcn_readfirstlane(vdst+(slot)))
  const int vb0=(int)(lds0+LDS_V)+((lane>>4)&1)*32+(lane&3)*8+(4*hi+((lane&15)>>2))*64;
  const char*Kbase=shm+LDS_K; bf16x8 kf[8];
  const lds_cptr shm3=(lds_cptr)shm; const lds_cptr kp0=shm3+LDS_K+hi*1024+r32*16; const lds_cptr vp0=shm3+LDS_V+((lane>>4)&1)*32+(lane&3)*8+(4*hi+((lane&15)>>2))*64;
  const int NT=(q0+QB)/KVBLK;
  const int s0=r0*SLOTB, s1=(r0==2?0:r0+1)*SLOTB, s2=(r0==0?2:r0-1)*SLOTB;
  if(!pre){ DMA_K(0,s0);DMA_V(0,s0);DMA_K(1,s1); }
  bf16x8 qr[4];
  #pragma unroll
  for(int d0=0;d0<4;++d0)qr[d0]=*reinterpret_cast<const bf16x8*>(&Qw[(long)r32*DM+d0*16+hi*8]);
  float mhat=0.f,l_reg=0.f;f32x16 o[2];o[0]=f32x16{};o[1]=f32x16{};
  const int qrel=wid*QBLK+r32;
  #define CMASK(P0,P1,t) do{int jb_=(t)-(NT-4); if(jb_>=0)cmask(P0,P1,jb_,qrel,hi);}while(0)
  typedef __attribute__((address_space(3))) const f32x4_t* lds_f4p;
  #define CIN(C0,C1,t) do{ const float nm_=-mhat; const lds_f4p cp_=(lds_f4p)(shm3+LDS_CBL+(t)*256+hi*16); \
    const f32x4_t b0_=cp_[0],b1_=cp_[2],b2_=cp_[4],b3_=cp_[6],b4_=cp_[8],b5_=cp_[10],b6_=cp_[12],b7_=cp_[14]; \
    _Pragma("unroll") for(int e_=0;e_<4;++e_){ C0[e_]=nm_-b0_[e_]; C0[4+e_]=nm_-b1_[e_]; C0[8+e_]=nm_-b2_[e_]; C0[12+e_]=nm_-b3_[e_]; C1[e_]=nm_-b4_[e_]; C1[4+e_]=nm_-b5_[e_]; C1[8+e_]=nm_-b6_[e_]; C1[12+e_]=nm_-b7_[e_]; } \
    asm volatile("":"+v"(C0),"+v"(C1)); }while(0)
  bool resc=false;
  #define START(P0,P1) do{ const float rm=rowmax(P0,P1); resc=false; \
    { const float dl=rm; mhat=fadd_s(mhat,dl); \
      _Pragma("unroll") for(int r=0;r<16;++r){P0[r]=fsub_s(P0[r],dl);P1[r]=fsub_s(P1[r],dl);} } \
    _Pragma("unroll") for(int r=0;r<16;++r)P0[r]=__builtin_amdgcn_exp2f(P0[r]); }while(0)
  #define RESC() do{ if(resc){ asm volatile("s_waitcnt lgkmcnt(0)":::"memory"); \
      _Pragma("unroll") for(int d_=0;d_<2;++d_) _Pragma("unroll") for(int r=0;r<16;++r)o[d_][r]*=wsf[crow(r,hi)]; } }while(0)
  f32x16 pA0,pA1,pB0,pB1;
  int sl_prev=s0,sl_cur=s0,sl_next=s1;
  #define ROT() do{sl_prev=sl_cur;sl_cur=sl_next;sl_next=(sl_next==(NSLOT-1)*SLOTB)?0:sl_next+SLOTB;}while(0)
  if(!pre){ DMA_K(2,s2); }
  WAIT_BAR(3);
  CIN(pA0,pA1,0);
  qkt(pA0,pA1,Kbase+s0,qr,r32,hi);asm volatile("s_nop 15\n\ts_nop 7":"+v"(pA0),"+v"(pA1));CMASK(pA0,pA1,0);
  START(pA0,pA1);
  _Pragma("unroll") for(int r=0;r<16;++r)pA1[r]=__builtin_amdgcn_exp2f(pA1[r]);
  WAIT_BAR(0);
  DMA_K(3,s0);DMA_V(1,s1);
  ROT();
  kload8(kf,kp0+sl_cur);
  WAIT_BAR(2);
  s16x4 vlo[8],vhi[8]; u32x4 pw0,pw1,pw2,pw3;
  #define PKW(P,B) cvtpk_s(P[B],P[B+1])
  #define PAF(k) __builtin_bit_cast(bf16x8,pw##k)
  #define VFR(i) (bf16x8){vlo[i][0],vlo[i][1],vlo[i][2],vlo[i][3],vhi[i][0],vhi[i][1],vhi[i][2],vhi[i][3]}
  #define PIN(x) asm volatile("":"+v"(x))
  #define MX3(a,b,c) __builtin_fmaxf(__builtin_fmaxf((a),(b)),(c))
  #define GAPA(MF,A0,A1,A2,A3,W0,W1,PW) do{ MF; sacc+=A0; sacc+=A1; sacc+=A2; sacc+=A3; PIN(sacc); W0; W1; PIN(PW); SBAR(); }while(0)
  #define EX(v) __builtin_amdgcn_exp2f(v)
  #define GAPB(MF,X,B) do{ MF; X[B]=EX(X[B]); X[B+1]=EX(X[B+1]); X[B+2]=EX(X[B+2]); X[B+3]=EX(X[B+3]); PIN(X); SBAR(); }while(0)
  #define VRD(i) do{ vlo[i]=vtr(vp_+(((i)>>2)*4096+((i)&3)*1024)); vhi[i]=vtr(vp_+(((i)>>2)*4096+((i)&3)*1024+512)); }while(0)
  #define KRD(G,j) do{ if(G){ kload2(kf,kp0+sl_next,j); SBAR(); } }while(0)
  #define STEP(C0,C1,P0,P1,t,GK,GV,GL) do{ SBAR(); CIN(C0,C1,t); SBAR(); \
    const lds_cptr vp_=vp0+sl_prev; \
    VRD(0); SBAR(); float sacc=(P0[0]+P0[1]); \
    GAPA(C0=__builtin_amdgcn_mfma_f32_32x32x16_bf16(kf[0],qr[0],C0,0,0,0), P0[2],P0[3],P0[4],P0[5],     pw0[0]=PKW(P0,0), pw0[1]=PKW(P0,2), pw0); \
    VRD(4); SBAR(); GAPA(C1=__builtin_amdgcn_mfma_f32_32x32x16_bf16(kf[1],qr[0],C1,0,0,0), P0[6],P0[7],P0[8],P0[9],     pw0[2]=PKW(P0,4), pw0[3]=PKW(P0,6), pw0); \
    VRD(1); SBAR(); GAPA(C0=__builtin_amdgcn_mfma_f32_32x32x16_bf16(kf[2],qr[1],C0,0,0,0),   P0[10],P0[11],P0[12],P0[13], pw1[0]=PKW(P0,8), pw1[1]=PKW(P0,10), pw1); \
    VRD(5); SBAR(); GAPA(C1=__builtin_amdgcn_mfma_f32_32x32x16_bf16(kf[3],qr[1],C1,0,0,0),   P0[14],P0[15],P1[0],P1[1],   pw1[2]=PKW(P0,12),pw1[3]=PKW(P0,14), pw1); \
    VRD(2); SBAR(); GAPA(C0=__builtin_amdgcn_mfma_f32_32x32x16_bf16(kf[4],qr[2],C0,0,0,0),   P1[2],P1[3],P1[4],P1[5],     pw2[0]=PKW(P1,0), pw2[1]=PKW(P1,2), pw2); \
    VRD(6); SBAR(); GAPA(C1=__builtin_amdgcn_mfma_f32_32x32x16_bf16(kf[5],qr[2],C1,0,0,0),   P1[6],P1[7],P1[8],P1[9],     pw2[2]=PKW(P1,4), pw2[3]=PKW(P1,6), pw2); \
    VRD(3); SBAR(); GAPA(C0=__builtin_amdgcn_mfma_f32_32x32x16_bf16(kf[6],qr[3],C0,0,0,0),   P1[10],P1[11],P1[12],P1[13], pw3[0]=PKW(P1,8), pw3[1]=PKW(P1,10), pw3); \
    VRD(7); SBAR(); GAPA(C1=__builtin_amdgcn_mfma_f32_32x32x16_bf16(kf[7],qr[3],C1,0,0,0),   P1[14],P1[15],0.f,0.f,       pw3[2]=PKW(P1,12),pw3[3]=PKW(P1,14), pw3); \
    l_reg+=sacc; \
    if(GK){DMA_K((t)+3,sl_cur);} if(GV){DMA_V((t)+1,sl_next);} \
    CMASK(C0,C1,t); \
    { float a=MX3(C0[0],C0[1],C1[0]),b=MX3(C0[2],C0[3],C1[1]); a=MX3(a,C1[2],C1[3]); \
      _Pragma("unroll") for(int r=4;r<16;r+=4){a=MX3(a,C0[r],C0[r+1]);b=MX3(b,C0[r+2],C0[r+3]);a=MX3(a,C1[r],C1[r+1]);b=MX3(b,C1[r+2],C1[r+3]);} \
      float rm=__builtin_fmaxf(a,b); { auto rr=__builtin_amdgcn_permlane32_swap(__float_as_uint(rm),__float_as_uint(rm),false,false); rm=__builtin_fmaxf(__uint_as_float(rr[0]),__uint_as_float(rr[1])); } \
      resc=false; \
      if(__builtin_expect(__any(rm>(float)THRL),0)){ const float dl=__builtin_fmaxf(rm,0.f); mhat+=dl; \
        _Pragma("unroll") for(int r=0;r<16;++r){C0[r]-=dl;C1[r]-=dl;} \
        const float f=__builtin_amdgcn_exp2f(-dl); l_reg*=f; if(hi==0)wsf[r32]=f; resc=true; } } \
    SBAR(); \
    GAPB(o[0]=__builtin_amdgcn_mfma_f32_32x32x16_bf16(PAF(0),VFR(0),o[0],0,0,0), C0,0); \
    GAPB(o[1]=__builtin_amdgcn_mfma_f32_32x32x16_bf16(PAF(0),VFR(4),o[1],0,0,0), C0,4); \
    KRD(GL,0); GAPB(o[0]=__builtin_amdgcn_mfma_f32_32x32x16_bf16(PAF(1),VFR(1),o[0],0,0,0), C0,8); \
    KRD(GL,1); GAPB(o[1]=__builtin_amdgcn_mfma_f32_32x32x16_bf16(PAF(1),VFR(5),o[1],0,0,0), C0,12); \
    KRD(GL,2); GAPB(o[0]=__builtin_amdgcn_mfma_f32_32x32x16_bf16(PAF(2),VFR(2),o[0],0,0,0), C1,0); \
    KRD(GL,3); GAPB(o[1]=__builtin_amdgcn_mfma_f32_32x32x16_bf16(PAF(2),VFR(6),o[1],0,0,0), C1,4); \
    GAPB(o[0]=__builtin_amdgcn_mfma_f32_32x32x16_bf16(PAF(3),VFR(3),o[0],0,0,0), C1,8); \
    GAPB(o[1]=__builtin_amdgcn_mfma_f32_32x32x16_bf16(PAF(3),VFR(7),o[1],0,0,0), C1,12); \
    }while(0)
  int t=1;
  #undef CMASK
  #define CMASK(P0,P1,t) do{}while(0)
  for(;t+5<NT;t+=2){
    STEP(pB0,pB1,pA0,pA1,t,true,true,true);     WAIT_BAR(2); RESC(); ROT();
    STEP(pA0,pA1,pB0,pB1,t+1,true,true,true);   WAIT_BAR(2); RESC(); ROT();
  }
  #undef CMASK
  #define CMASK(P0,P1,t) do{int jb_=(t)-(NT-4); if(jb_>=0)cmask(P0,P1,jb_,qrel,hi);}while(0)
  #define ENDW(tt) do{ if((tt)+3<NT){WAIT_BAR(2);} else if((tt)+2<NT){WAIT_BAR(1);} else {WAIT_BAR(0);} }while(0)
  for(;t+1<NT;t+=2){
    STEP(pB0,pB1,pA0,pA1,t,(t+3<NT),(t+1<NT),(t+1<NT));       ENDW(t);   RESC(); ROT();
    STEP(pA0,pA1,pB0,pB1,t+1,(t+4<NT),(t+2<NT),(t+2<NT));     ENDW(t+1); RESC(); ROT();
  }
  STEP(pB0,pB1,pA0,pA1,NT-1,false,false,false); RESC();
  { const int rn=(r0+NT)%3;
    if(pre_next){ const int n0=rn*SLOTB, n1=(rn==2?0:rn+1)*SLOTB, n2=(rn==0?2:rn-1)*SLOTB;
      DMA_K(0,n0);DMA_V(0,n0);DMA_K(1,n1);DMA_K(2,n2); }
    r0=rn; }
  { float sacc=pB0[0]+pB0[1]; _Pragma("unroll") for(int r=2;r<16;++r)sacc+=pB0[r]; _Pragma("unroll") for(int r=0;r<16;++r)sacc+=pB1[r]; l_reg+=sacc;
    pw0=(u32x4){PKW(pB0,0),PKW(pB0,2),PKW(pB0,4),PKW(pB0,6)};pw1=(u32x4){PKW(pB0,8),PKW(pB0,10),PKW(pB0,12),PKW(pB0,14)};pw2=(u32x4){PKW(pB1,0),PKW(pB1,2),PKW(pB1,4),PKW(pB1,6)};pw3=(u32x4){PKW(pB1,8),PKW(pB1,10),PKW(pB1,12),PKW(pB1,14)};
    SBAR(); pv(o,vb0+sl_cur,PAF(0),PAF(1),PAF(2),PAF(3)); }
  #undef PKW
  #undef PAF
  #undef VFR
  #undef PIN
  #undef MX3
  #undef GAPA
  #undef GAPB
  #undef EX
  #undef VRD
  #undef KRD
  #undef STEP
  #undef ENDW
  {auto rr=__builtin_amdgcn_permlane32_swap(__float_as_uint(l_reg),__float_as_uint(l_reg),false,false);l_reg=__uint_as_float(rr[0])+__uint_as_float(rr[1]);}
  if(hi==0)wsf[32+r32]=l_reg;asm volatile("s_waitcnt lgkmcnt(0)":::"memory");
  float rli[16];
  #pragma unroll
  for(int r=0;r<16;++r)rli[r]=__builtin_amdgcn_rcpf(wsf[32+crow(r,hi)]);
  bf16*Ow=O+(rowbase+q0+wid*QBLK)*OPITCH+OCOL0+h*D;
  { bf16*stg=(bf16*)(shm+LDS_OST)+wid*2048;
    #pragma unroll
    for(int r=0;r<16;++r){const int orow=crow(r,hi);
      #pragma unroll
      for(int d0=0;d0<2;++d0)stg[orow*64+d0*32+r32]=__float2bfloat16(o[d0][r]*rli[r]);}
    asm volatile("s_waitcnt lgkmcnt(0)":::"memory");
    #pragma unroll
    for(int i=0;i<4;++i){const int row=i*8+(lane>>3),ch=lane&7; const u32x4 v=*(const u32x4*)(stg+row*64+ch*8); ATTN_STORE16(Ow+(long)row*OPITCH+ch*8,v);} }
  asm volatile("s_waitcnt lgkmcnt(0)\n\ts_barrier":::"memory");
  #undef DMA_K
  #undef DMA_V
  #undef CMASK
  #undef START
  #undef RESC
  #undef ROT
  #undef CIN
}
constexpr int ATTN_LDS_BYTES=LDS_BYTES;
struct AttnTensors { const bf16* Q; const bf16* K; const bf16* V; bf16* O; };
struct AttnUnit { int bh; int qb; };
struct StaticOrder {
  int vcu;
  __device__ __forceinline__ explicit StaticOrder(int v):vcu(v){}
  __device__ __forceinline__ bool next(int i,AttnUnit&u)const{ u.bh=vcu>>1;
    if((vcu&1)==0){ if(i>=2)return false; u.qb=(i==0)?6:2; }
    else { if(i>=6)return false; u.qb=(i==0)?7:(i==1)?5:(i==2)?4:(i==3)?3:(i==4)?1:0; }
    return true; }
  __device__ __forceinline__ void a_ready(const AttnUnit&)const{}
  __device__ __forceinline__ void done(const AttnUnit&)const{}
};
struct AttnTensorsB { const bf16* Q; const bf16* K; const bf16* V; bf16* O; const float* CB; };
template<class Sched,int THRL=20> __device__ __forceinline__ void attn_phase(char*lds,const AttnTensorsB&T,const Sched&S){
  AttnUnit u; int cur_bh=-1; int r0=0; bool pre=false;
  for(int i=0;S.next(i,u);++i){ S.a_ready(u);
    if(u.bh!=cur_bh){ cur_bh=u.bh; float*cbl=(float*)(lds+LDS_CBL); const float*src=T.CB+(size_t)u.bh*SEQ;
      int j0=threadIdx.x; asm volatile("":"+v"(j0));
      for(int j=j0;j<SEQ/4;j+=NW*64) ((f32x4_t*)cbl)[j]=((const f32x4_t*)src)[j];
      __syncthreads(); }
    AttnUnit un; const bool has_next=S.next(i+1,un)&&un.bh==u.bh;
    attn_unit<THRL>(u.bh/NHEAD,u.bh%NHEAD,u.qb,T.Q,T.K,T.V,T.O,lds,r0,pre,has_next); pre=has_next; S.done(u); }
}
#undef SBAR
#undef WAIT_BAR
}

namespace xattn {
typedef short bf16x8 __attribute__((ext_vector_type(8)));
typedef short s16x4 __attribute__((ext_vector_type(4)));
typedef short v4i16_t __attribute__((ext_vector_type(4)));
typedef float f32x16 __attribute__((ext_vector_type(16)));
typedef unsigned u32x4 __attribute__((ext_vector_type(4)));
constexpr int LDS_KV = 0, LDS_OST = 131072, LDS_WSF = LDS_OST + 8 * 2048, LDS_BYTES = LDS_WSF + 8 * 256;
__device__ __forceinline__ int crow(int r, int hi) { return (r & 3) + 8 * (r >> 2) + 4 * hi; }
__device__ __forceinline__ unsigned cvtpk(float lo, float hi) { typedef float f2 __attribute__((ext_vector_type(2))); typedef __bf16 b2 __attribute__((ext_vector_type(2))); f2 v = {lo, hi}; b2 b = __builtin_convertvector(v, b2); return __builtin_bit_cast(unsigned, b); }
__device__ __forceinline__ void xattn_unit(const bf16_t* QX, const bf16_t* KX, const bf16_t* VX, bf16_t* OX, int b, int h, int qb, LAS unsigned char* lds) {
    const int tid = threadIdx.x, lane = tid & 63, r32 = lane & 31, hi = lane >> 5, wid = __builtin_amdgcn_readfirstlane(tid >> 6);
#pragma unroll
    for (int i = 0; i < 16; ++i) { const int p = wid * 16 + i, c = p >> 2, rg = p & 3;
        __builtin_amdgcn_global_load_lds((const unsigned*)(KX + (size_t)(b * MEML + rg * 64 + lane) * D + h * XHD + c * 8), (LAS unsigned*)(lds + LDS_KV + c * 4096 + rg * 1024), 16, 0, 0); }
    const size_t qrow0 = (size_t)b * SEQ + qb * 256 + wid * 32;
    bf16x8 qf[8];
#pragma unroll
    for (int s_ = 0; s_ < 8; ++s_) qf[s_] = *(const bf16x8*)(QX + (qrow0 + r32) * D + h * XHD + 16 * s_ + 8 * hi);
    asm volatile("s_waitcnt vmcnt(0)" ::: "memory"); __builtin_amdgcn_s_barrier(); asm volatile("" ::: "memory");
    f32x16 S[8];
#pragma unroll
    for (int kb = 0; kb < 8; ++kb) S[kb] = f32x16{};
#pragma unroll
    for (int half = 0; half < 2; ++half) {
        if (half == 1) {
#pragma unroll
            for (int s_ = 0; s_ < 8; ++s_) qf[s_] = *(const bf16x8*)(QX + (qrow0 + r32) * D + h * XHD + 16 * (8 + s_) + 8 * hi);
        }
#pragma unroll
        for (int s_ = 0; s_ < 8; ++s_) { bf16x8 kf[8];
#pragma unroll
            for (int kb = 0; kb < 8; ++kb) kf[kb] = *(const LAS bf16x8*)(lds + LDS_KV + (2 * (8 * half + s_) + hi) * 4096 + (32 * kb + r32) * 16);
            __builtin_amdgcn_sched_barrier(0);
#pragma unroll
            for (int kb = 0; kb < 8; ++kb) S[kb] = __builtin_amdgcn_mfma_f32_32x32x16_bf16(kf[kb], qf[s_], S[kb], 0, 0, 0);
            __builtin_amdgcn_sched_barrier(0); }
        asm volatile("" ::: "memory");
    }
    float mx = S[0][0];
#pragma unroll
    for (int kb = 0; kb < 8; ++kb)
#pragma unroll
        for (int r = 0; r < 16; ++r) mx = fmaxf(mx, S[kb][r]);
    { auto rr = __builtin_amdgcn_permlane32_swap(__float_as_uint(mx), __float_as_uint(mx), false, false); mx = fmaxf(__uint_as_float(rr[0]), __uint_as_float(rr[1])); }
    float l = 0.f;
#pragma unroll
    for (int kb = 0; kb < 8; ++kb)
#pragma unroll
        for (int r = 0; r < 16; ++r) { const float p = __builtin_amdgcn_exp2f(S[kb][r] - mx); S[kb][r] = p; l += p; }
    { auto rr = __builtin_amdgcn_permlane32_swap(__float_as_uint(l), __float_as_uint(l), false, false); l = __uint_as_float(rr[0]) + __uint_as_float(rr[1]); }
    u32x4 pw[16];
#pragma unroll
    for (int kb = 0; kb < 8; ++kb)
#pragma unroll
        for (int sp = 0; sp < 2; ++sp) { u32x4 w; w.x = cvtpk(S[kb][8 * sp + 0], S[kb][8 * sp + 1]); w.y = cvtpk(S[kb][8 * sp + 2], S[kb][8 * sp + 3]); w.z = cvtpk(S[kb][8 * sp + 4], S[kb][8 * sp + 5]); w.w = cvtpk(S[kb][8 * sp + 6], S[kb][8 * sp + 7]); pw[2 * kb + sp] = w; }
    asm volatile("s_waitcnt lgkmcnt(0)" ::: "memory"); __builtin_amdgcn_s_barrier(); asm volatile("" ::: "memory");
#pragma unroll
    for (int i = 0; i < 16; ++i) { const int p = wid * 16 + i, dblk = p >> 4, kg = p & 15;
        __builtin_amdgcn_global_load_lds((const unsigned*)(VX + (size_t)(b * MEML + kg * 16 + (lane >> 2)) * D + h * XHD + dblk * 32 + (lane & 3) * 8), (LAS unsigned*)(lds + LDS_KV + dblk * 16384 + kg * 1024), 16, 0, 0); }
    LAS float* wsf = (LAS float*)(lds + LDS_WSF) + wid * 64;
    if (hi == 0) wsf[r32] = l;
    asm volatile("s_waitcnt vmcnt(0) lgkmcnt(0)" ::: "memory"); __builtin_amdgcn_s_barrier(); asm volatile("" ::: "memory");
    float rli[16];
#pragma unroll
    for (int r = 0; r < 16; ++r) rli[r] = __builtin_amdgcn_rcpf(wsf[crow(r, hi)]);
    const LAS unsigned char* vb = lds + LDS_KV + ((lane >> 4) & 1) * 32 + (lane & 3) * 8 + (4 * hi + ((lane & 15) >> 2)) * 64;
    LAS bf16_t* stg = (LAS bf16_t*)(lds + LDS_OST + wid * 2048);
#pragma unroll 1
    for (int dblk = 0; dblk < 8; ++dblk) {
        f32x16 o = f32x16{};
#pragma unroll
        for (int kh = 0; kh < 2; ++kh) { bf16x8 vf[8];
#pragma unroll
            for (int k8 = 0; k8 < 8; ++k8) { const int ks = 8 * kh + k8;
                const s16x4 lo = __builtin_bit_cast(s16x4, __builtin_amdgcn_ds_read_tr16_b64_v4i16((LAS v4i16_t*)(vb + dblk * 16384 + ks * 1024)));
                const s16x4 hh = __builtin_bit_cast(s16x4, __builtin_amdgcn_ds_read_tr16_b64_v4i16((LAS v4i16_t*)(vb + dblk * 16384 + ks * 1024 + 512)));
                vf[k8] = (bf16x8){lo[0], lo[1], lo[2], lo[3], hh[0], hh[1], hh[2], hh[3]}; }
            __builtin_amdgcn_sched_barrier(0);
#pragma unroll
            for (int k8 = 0; k8 < 8; ++k8) o = __builtin_amdgcn_mfma_f32_32x32x16_bf16(__builtin_bit_cast(bf16x8, pw[8 * kh + k8]), vf[k8], o, 0, 0, 0);
            __builtin_amdgcn_sched_barrier(0); }
#pragma unroll
        for (int r = 0; r < 16; ++r) stg[crow(r, hi) * 32 + r32] = (bf16_t)f2bf(o[r] * rli[r]);
        asm volatile("s_waitcnt lgkmcnt(0)" ::: "memory");
#pragma unroll
        for (int i = 0; i < 2; ++i) { const int idx = lane + 64 * i, row = idx >> 2, ch = idx & 3; const u32x4 v = *(const LAS u32x4*)(stg + row * 32 + ch * 8);
            *(u32x4*)(OX + (qrow0 + row) * D + h * XHD + dblk * 32 + ch * 8) = v; }
        asm volatile("s_waitcnt lgkmcnt(0)" ::: "memory");
    }
    asm volatile("s_waitcnt lgkmcnt(0)" ::: "memory"); __builtin_amdgcn_s_barrier(); asm volatile("" ::: "memory");
}
}

namespace ssd {
typedef short bf16x8 __attribute__((ext_vector_type(8)));
typedef short s16x4 __attribute__((ext_vector_type(4)));
typedef short v4i16_t __attribute__((ext_vector_type(4)));
typedef float f32x16 __attribute__((ext_vector_type(16)));
typedef unsigned u32x4 __attribute__((ext_vector_type(4)));
typedef unsigned u32x2 __attribute__((ext_vector_type(2)));
constexpr int L_B = 0, L_C = 32768, L_XD = 65536, L_XDD = 81920, L_SIN = 98304, L_Y = 114688, L_A2 = 147456, L_FL = 147968  , L_DT = 150528, L_CW = 151040, LDS_BYTES = 152320;
__device__ __forceinline__ int crow(int r, int hi) { return (r & 3) + 8 * (r >> 2) + 4 * hi; }
__device__ __forceinline__ unsigned cvtpk(float lo, float hi) { typedef float f2 __attribute__((ext_vector_type(2))); typedef __bf16 b2 __attribute__((ext_vector_type(2))); f2 v = {lo, hi}; b2 b = __builtin_convertvector(v, b2); return __builtin_bit_cast(unsigned, b); }
__device__ __forceinline__ bf16x8 trpair(const LAS unsigned char* p, int second_off) {
    const s16x4 lo = __builtin_bit_cast(s16x4, __builtin_amdgcn_ds_read_tr16_b64_v4i16((LAS v4i16_t*)(p)));
    const s16x4 hh = __builtin_bit_cast(s16x4, __builtin_amdgcn_ds_read_tr16_b64_v4i16((LAS v4i16_t*)(p + second_off)));
    return (bf16x8){lo[0], lo[1], lo[2], lo[3], hh[0], hh[1], hh[2], hh[3]};
}
#define SSD_BAR() do { asm volatile("s_waitcnt lgkmcnt(0)" ::: "memory"); __builtin_amdgcn_s_barrier(); asm volatile("" ::: "memory"); } while (0)
__device__ __forceinline__ void ssd_item(const KAS Ptrs& P, int bh, LAS unsigned char* lds) {
    const int tid = threadIdx.x, lane = tid & 63, r32 = lane & 31, hi = lane >> 5, wid = __builtin_amdgcn_readfirstlane(tid >> 6);
    const int lb = wid < 4 ? (wid >> 1) : 3 - ((wid - 4) >> 1), pb = wid & 1, par = pb;
    const int b = bh / NH, h = bh % NH, g = h / 8;
    unsigned char* ws = P.ws;
    const bf16_t* XA = (const bf16_t*)(ws + WS_BCA) + (size_t)b * SEQ * 512;
    const bf16_t* XRh = (const bf16_t*)((const unsigned char*)P.out + DO_XRAW) + (size_t)b * SEQ * 1024 + h * 64;
    const bf16_t* ZS = (const bf16_t*)(ws + WS_ZS) + (size_t)b * SEQ * 1024 + h * 64;
    const float* DTT = (const float*)(ws + WS_DTT) + (size_t)bh * SEQ; const float* ACS = (const float*)(ws + WS_ACS) + (size_t)bh * SEQ;
    bf16_t* MX = (bf16_t*)(ws + WS_MIXED) + (size_t)b * SEQ * MIXW + h * 64; float* SSQ = (float*)(ws + WS_SSQ) + (size_t)b * SEQ * 16 + h;
    const bf16_t* CBTw = (const bf16_t*)(ws + WS_CBT) + ((size_t)(b * NCH * NGRP + g) * 10 + lb * (lb + 1) / 2) * 64 * 16 + lane * 16;
    const float Dk = P.d_skip[h];
    f32x16 sacc = f32x16{};
    for (int i = tid; i < 16384 / 16; i += NTHR) ((LAS u32x4*)(lds + L_SIN))[i] = (u32x4){0u, 0u, 0u, 0u};
    if (tid < 320) ((LAS float*)(lds + L_CW))[tid] = tid < 256 ? P.conv_w[(tid >> 6) * CONVD + h * 64 + (tid & 63)] : P.conv_b[h * 64 + (tid & 63)];
    const int brow = tid & 127, bch0 = tid >> 7;
    const int srow0 = tid >> 4, sch = tid & 15;
#define SSD_IMG(row, ch) ((row) * 256 + ((((ch) ^ (row)) & 15) << 4))
    const int xr2 = tid >> 3, xpc = tid & 7;
    u32x4 pB[4], pC[4], pXr[5]; float pdt[2], pac[2], pa127 = 0.f, pas = 0.f, pdtb = 0.f;
    u32x4 ez0, ez1;
    const int el = tid >> 2, ep0 = (tid & 3) * 16;
#define SSD_PREFETCH(c) do { const int t0_ = (c) * CHUNK; \
        _Pragma("unroll") for (int i = 0; i < 4; ++i) { const bf16_t* rp = XA + (size_t)(t0_ + srow0 + 32 * i) * 512 + g * 128 + sch * 8; pB[i] = *(const u32x4*)rp; pC[i] = *(const u32x4*)(rp + 256); } \
        _Pragma("unroll") for (int j = 0; j < 5; ++j) { const int tr_ = t0_ + 2 * xr2 - 3 + j; pXr[j] = (u32x4){0u, 0u, 0u, 0u}; if (tr_ >= 0) pXr[j] = *(const u32x4*)(XRh + (size_t)tr_ * 1024 + xpc * 8); } \
        _Pragma("unroll") for (int i = 0; i < 2; ++i) { pdt[i] = DTT[t0_ + 2 * xr2 + i]; pac[i] = ACS[t0_ + 2 * xr2 + i]; } \
        pa127 = ACS[t0_ + 127]; pas = ACS[t0_ + brow]; pdtb = DTT[t0_ + brow]; } while (0)
#define SSD_WRITE() do { \
        _Pragma("unroll") for (int i = 0; i < 4; ++i) { const int off_ = SSD_IMG(srow0 + 32 * i, sch); *(LAS u32x4*)(lds + L_B + off_) = pB[i]; *(LAS u32x4*)(lds + L_C + off_) = pC[i]; } \
        { float xf_[5][8];   \
          _Pragma("unroll") for (int j = 0; j < 5; ++j) { const unsigned w_[4] = {pXr[j].x, pXr[j].y, pXr[j].z, pXr[j].w}; \
              _Pragma("unroll") for (int k = 0; k < 4; ++k) { xf_[j][2 * k] = __uint_as_float(w_[k] << 16); xf_[j][2 * k + 1] = __uint_as_float(w_[k] & 0xffff0000u); } } \
          float cw_[5][8]; _Pragma("unroll") for (int j = 0; j < 5; ++j) { const f32x4 a_ = *(const LAS f32x4*)(lds + L_CW + (j * 64 + xpc * 8) * 4), b_ = *(const LAS f32x4*)(lds + L_CW + (j * 64 + xpc * 8 + 4) * 4); \
              _Pragma("unroll") for (int k = 0; k < 4; ++k) { cw_[j][k] = a_[k]; cw_[j][4 + k] = b_[k]; } } \
          _Pragma("unroll") for (int i = 0; i < 2; ++i) { const int row = 2 * xr2 + i; const float s1 = pdt[i], s2 = s1 * __builtin_amdgcn_exp2f((pa127 - pac[i]) * LOG2E); \
            float xc_[8]; _Pragma("unroll") for (int k = 0; k < 8; ++k) xc_[k] = silu_f(cw_[4][k] + cw_[0][k] * xf_[i][k] + cw_[1][k] * xf_[i + 1][k] + cw_[2][k] * xf_[i + 2][k] + cw_[3][k] * xf_[i + 3][k]); \
            u32x4 o1, o2; unsigned r1[4], r2[4]; \
            _Pragma("unroll") for (int k = 0; k < 4; ++k) { r1[k] = cvtpk(xc_[2 * k] * s1, xc_[2 * k + 1] * s1); r2[k] = cvtpk(xc_[2 * k] * s2, xc_[2 * k + 1] * s2); } \
            o1 = (u32x4){r1[0], r1[1], r1[2], r1[3]}; o2 = (u32x4){r2[0], r2[1], r2[2], r2[3]}; \
            const int off = (xpc >> 2) * 8192 + (row >> 4) * 1024 + (row & 15) * 64 + (xpc & 3) * 16; \
            *(LAS u32x4*)(lds + L_XD + off) = o1; *(LAS u32x4*)(lds + L_XDD + off) = o2; } } \
        if (bch0 == (brow >> 5)) { ((LAS float*)(lds + L_A2))[brow] = pas * LOG2E; ((LAS float*)(lds + L_FL))[brow] = __builtin_amdgcn_exp2f(pas * LOG2E); ((LAS float*)(lds + L_DT))[brow] = pdtb; } } while (0)
    u32x4 pcb[2][2];
#pragma unroll
    for (int jb = 0; jb < 2; ++jb) { pcb[jb][0] = (u32x4){0u, 0u, 0u, 0u}; pcb[jb][1] = pcb[jb][0]; if (par + 2 * jb <= lb) { const bf16_t* cp = CBTw + (par + 2 * jb) * 64 * 16; pcb[jb][0] = *(const u32x4*)cp; pcb[jb][1] = *(const u32x4*)(cp + 8); } }
    SSD_BAR();
    SSD_PREFETCH(0); SSD_WRITE(); SSD_BAR();
    const int trbase = (4 * hi + ((lane & 15) >> 2)) * 64 + ((lane >> 4) & 1) * 32 + (lane & 3) * 8;
    const int nb = lb;
    const int btr_n = 32 * nb + 16 * ((lane >> 4) & 1) + 4 * (lane & 3);
    const int btr_l = 4 * hi + ((lane & 15) >> 2);
    const int btrb0 = SSD_IMG(btr_l, btr_n >> 3) + (btr_n & 7) * 2, btrb1 = SSD_IMG(btr_l + 8, btr_n >> 3) + (btr_n & 7) * 2;
#pragma unroll 1
    for (int c = 0; c < NCH; ++c) {
        if (c + 1 < NCH) SSD_PREFETCH(c + 1);
        { const size_t t = (size_t)c * CHUNK + el;
          ez0 = *(const u32x4*)(ZS + t * 1024 + ep0); ez1 = *(const u32x4*)(ZS + t * 1024 + ep0 + 8); }
        f32x16 yacc[2]; yacc[0] = f32x16{}; yacc[1] = f32x16{};
        { bf16x8 cfr[4], sfr[2][4];
#pragma unroll
          for (int k4 = 0; k4 < 4; ++k4) { const int kn = 4 * par + k4; cfr[k4] = *(const LAS bf16x8*)(lds + L_C + SSD_IMG(32 * lb + r32, 2 * kn + hi));
#pragma unroll
              for (int q = 0; q < 2; ++q) sfr[q][k4] = *(const LAS bf16x8*)(lds + L_SIN + (2 * kn + hi) * 1024 + (32 * q + r32) * 16); }
          __builtin_amdgcn_sched_barrier(0);
#pragma unroll
          for (int k4 = 0; k4 < 4; ++k4)
#pragma unroll
              for (int q = 0; q < 2; ++q) yacc[q] = __builtin_amdgcn_mfma_f32_32x32x16_bf16(cfr[k4], sfr[q][k4], yacc[q], 0, 0, 0);
#pragma unroll
          for (int g4 = 0; g4 < 4; ++g4) { const f32x4 ea = *(const LAS f32x4*)(lds + L_FL + (32 * lb + 8 * g4 + 4 * hi) * 4);
#pragma unroll
              for (int e_ = 0; e_ < 4; ++e_)
#pragma unroll
                  for (int q = 0; q < 2; ++q) yacc[q][4 * g4 + e_] *= ea[e_]; } }
        const float a2l = *(const LAS float*)(lds + L_A2 + (32 * lb + r32) * 4);
#pragma unroll
        for (int jb = 0; jb < 2; ++jb) { const int sb = par + 2 * jb; if (sb <= lb) {
            f32x4 gv[4];
#pragma unroll
            for (int g4 = 0; g4 < 4; ++g4) gv[g4] = *(const LAS f32x4*)(lds + L_A2 + (32 * sb + 8 * g4 + 4 * hi) * 4);
            const LAS unsigned char* xp = lds + L_XD + (2 * sb) * 1024 + trbase;
            const bf16x8 xv00 = trpair(xp, 512), xv01 = trpair(xp + 1024, 512), xv10 = trpair(xp + 8192, 512), xv11 = trpair(xp + 8192 + 1024, 512);
            const unsigned cw[8] = {pcb[jb][0].x, pcb[jb][0].y, pcb[jb][0].z, pcb[jb][0].w, pcb[jb][1].x, pcb[jb][1].y, pcb[jb][1].z, pcb[jb][1].w};
            float cbt[16];
#pragma unroll
            for (int k = 0; k < 8; ++k) { cbt[2 * k] = __uint_as_float(cw[k] << 16); cbt[2 * k + 1] = __uint_as_float(cw[k] & 0xffff0000u); }
            const bool diag = (sb == lb);
            const float dd = diag ? Dk * __builtin_amdgcn_rcpf(fmaxf(*(const LAS float*)(lds + L_DT + (32 * lb + r32) * 4), 1e-30f)) : 0.f;
#pragma unroll
            for (int g4 = 0; g4 < 4; ++g4)
#pragma unroll
                for (int e_ = 0; e_ < 4; ++e_) { const int r = 4 * g4 + e_; float v = (cbt[r] + (crow(r, hi) == r32 ? dd : 0.f)) * __builtin_amdgcn_exp2f(fminf(a2l - gv[g4][e_], 0.f)); if (diag && crow(r, hi) > r32) v = 0.f; cbt[r] = v; }
            u32x4 pw0, pw1;
            pw0.x = cvtpk(cbt[0], cbt[1]); pw0.y = cvtpk(cbt[2], cbt[3]); pw0.z = cvtpk(cbt[4], cbt[5]); pw0.w = cvtpk(cbt[6], cbt[7]);
            pw1.x = cvtpk(cbt[8], cbt[9]); pw1.y = cvtpk(cbt[10], cbt[11]); pw1.z = cvtpk(cbt[12], cbt[13]); pw1.w = cvtpk(cbt[14], cbt[15]);
            yacc[0] = __builtin_amdgcn_mfma_f32_32x32x16_bf16(__builtin_bit_cast(bf16x8, pw0), xv00, yacc[0], 0, 0, 0);
            yacc[1] = __builtin_amdgcn_mfma_f32_32x32x16_bf16(__builtin_bit_cast(bf16x8, pw0), xv10, yacc[1], 0, 0, 0);
            yacc[0] = __builtin_amdgcn_mfma_f32_32x32x16_bf16(__builtin_bit_cast(bf16x8, pw1), xv01, yacc[0], 0, 0, 0);
            yacc[1] = __builtin_amdgcn_mfma_f32_32x32x16_bf16(__builtin_bit_cast(bf16x8, pw1), xv11, yacc[1], 0, 0, 0);
        } }
        if (c + 1 < NCH) {
#pragma unroll
            for (int jb = 0; jb < 2; ++jb) if (par + 2 * jb <= lb) { const bf16_t* cp = CBTw + (size_t)(c + 1) * (NGRP * 10 * 64 * 16) + (par + 2 * jb) * 64 * 16; pcb[jb][0] = *(const u32x4*)cp; pcb[jb][1] = *(const u32x4*)(cp + 8); } }
#pragma unroll
        for (int g4 = 0; g4 < 4; ++g4)
#pragma unroll
            for (int e_ = 0; e_ < 4; ++e_)
#pragma unroll
                for (int q = 0; q < 2; ++q) ((LAS bf16_t*)(lds + L_Y + par * 16384))[(32 * lb + 8 * g4 + 4 * hi + e_) * 64 + 32 * q + r32] = (bf16_t)(cvtpk(yacc[q][4 * g4 + e_], 0.f) & 0xffffu);
        { const float cd = __builtin_amdgcn_exp2f(*(const LAS float*)(lds + L_A2 + 127 * 4));
#pragma unroll
          for (int r = 0; r < 16; ++r) sacc[r] *= cd;
#pragma unroll
          for (int kh = 0; kh < 2; ++kh) { bf16x8 af[4], bfq[4];
#pragma unroll
              for (int k4 = 0; k4 < 4; ++k4) { const int ks = 4 * kh + k4; af[k4] = trpair(lds + L_B + btrb0 + ks * 4096, btrb1 - btrb0); bfq[k4] = trpair(lds + L_XDD + pb * 8192 + ks * 1024 + trbase, 512); }
              __builtin_amdgcn_sched_barrier(0);
#pragma unroll
              for (int k4 = 0; k4 < 4; ++k4) sacc = __builtin_amdgcn_mfma_f32_32x32x16_bf16(af[k4], bfq[k4], sacc, 0, 0, 0); } }
        SSD_BAR();
        { const int l = el, p0 = ep0; const size_t t = (size_t)c * CHUNK + l;
          const u32x4 z0 = ez0, z1 = ez1;
          const unsigned zw[8] = {z0.x, z0.y, z0.z, z0.w, z1.x, z1.y, z1.z, z1.w};
          unsigned ow[8]; float ss = 0.f;
          const LAS bf16_t* ya = (const LAS bf16_t*)(lds + L_Y) + l * 64 + p0; const LAS bf16_t* yb = (const LAS bf16_t*)(lds + L_Y + 16384) + l * 64 + p0;
          const u32x4 a0 = *(const LAS u32x4*)ya, a1 = *(const LAS u32x4*)(ya + 8), b0 = *(const LAS u32x4*)yb, b1 = *(const LAS u32x4*)(yb + 8);
          const unsigned aw[8] = {a0.x, a0.y, a0.z, a0.w, a1.x, a1.y, a1.z, a1.w}, bw[8] = {b0.x, b0.y, b0.z, b0.w, b1.x, b1.y, b1.z, b1.w};
#pragma unroll
          for (int wi = 0; wi < 8; ++wi) {
              const float ya_ = (__uint_as_float(aw[wi] << 16) + __uint_as_float(bw[wi] << 16)) * __uint_as_float(zw[wi] << 16), yb_ = (__uint_as_float(aw[wi] & 0xffff0000u) + __uint_as_float(bw[wi] & 0xffff0000u)) * __uint_as_float(zw[wi] & 0xffff0000u);
              const unsigned w = cvtpk(ya_, yb_); ow[wi] = w; const float ra = __uint_as_float(w << 16), rb = __uint_as_float(w & 0xffff0000u); ss += ra * ra + rb * rb; }
          *(u32x4*)(MX + t * MIXW + p0) = (u32x4){ow[0], ow[1], ow[2], ow[3]}; *(u32x4*)(MX + t * MIXW + p0 + 8) = (u32x4){ow[4], ow[5], ow[6], ow[7]};
          ss += __shfl_xor(ss, 1); ss += __shfl_xor(ss, 2);
          if ((tid & 3) == 0) SSQ[t * 16] = ss; }
#pragma unroll
        for (int g4 = 0; g4 < 4; ++g4) { const int n0 = 32 * nb + 8 * g4 + 4 * hi; u32x2 w; w.x = cvtpk(sacc[4 * g4], sacc[4 * g4 + 1]); w.y = cvtpk(sacc[4 * g4 + 2], sacc[4 * g4 + 3]);
            *(LAS u32x2*)(lds + L_SIN + (n0 >> 3) * 1024 + (32 * pb + r32) * 16 + (n0 & 7) * 2) = w; }
        if (c + 1 < NCH) SSD_WRITE();
        SSD_BAR();
    }
#undef SSD_PREFETCH
#undef SSD_WRITE
#undef SSD_IMG
}
#undef SSD_BAR
}

constexpr int LDS_BYTES = 160 * 1024;
constexpr int RING_BYTES = 156 * 1024;
constexpr int MISC_OFF = RING_BYTES;

struct Frame {
    LAS unsigned char* lds; int tid, lane, wave, vcu, G; PtrsK PP;
};

template <bool MAPCOL> __device__ __forceinline__ void p0_transpose_item(const float* W, int K, int N, const float* gk, int gklen, bf16_t* WT, LAS float* scr, int item, int nblk, int lane) {
    const int kb = item / nblk, nb = item % nblk, k0 = 64 * kb, n0 = 64 * nb;
    const int c4 = lane & 15, kr = lane >> 4, ncol = n0 + 4 * c4, sc = MAPCOL ? win_src_col(ncol) : ncol;
    f32x4 v[16];
#pragma unroll
    for (int i = 0; i < 16; ++i) { const int kk = 4 * i + kr; v[i] = (f32x4){0.f, 0.f, 0.f, 0.f}; if (sc >= 0) v[i] = __builtin_nontemporal_load((const f32x4*)(W + (size_t)(k0 + kk) * N + sc)); }
#pragma unroll
    for (int i = 0; i < 16; ++i) { const int kk = 4 * i + kr; f32x4 t = v[i]; if (gk && k0 + kk < gklen) t = t * gk[k0 + kk];
        LAS float* d = scr + kk * 65 + 4 * c4; d[0] = t[0]; d[1] = t[1]; d[2] = t[2]; d[3] = t[3]; }
    asm volatile("s_waitcnt lgkmcnt(0)" ::: "memory");
    const int c = lane & 7;
#pragma unroll
    for (int j = 0; j < 8; ++j) { const int n = (lane >> 3) + 8 * j; const LAS float* sp = scr + (8 * c) * 65 + n;
        v4u o; o.x = pk2(sp[0 * 65], sp[1 * 65]); o.y = pk2(sp[2 * 65], sp[3 * 65]); o.z = pk2(sp[4 * 65], sp[5 * 65]); o.w = pk2(sp[6 * 65], sp[7 * 65]);
        *(GAS v4u*)(WT + (size_t)(n0 + n) * K + k0 + 8 * c) = o; }
    asm volatile("s_waitcnt lgkmcnt(0)" ::: "memory");
}
constexpr int I_IN = (D / 64) * (NIN / 64), I_XKV = (D / 64) * (2 * D / 64), I_OUT = (MIXW / 64) * (D / 64), I_XQ = (D / 64) * (D / 64), I_XO = I_XQ, I_UP = (D / 64) * (FF / 64), I_DN = (FF / 64) * (D / 64);
constexpr int I_EARLY = I_IN + I_XKV, I_ALL = I_EARLY + I_OUT + I_XQ + I_XO + I_UP + I_DN;
__device__ __forceinline__ void p0_transposes(Frame& F, const int lo, const int hi) {
    const PtrsK PPk = F.PP; const KAS Ptrs& P = *PPk; unsigned char* ws = P.ws;
    LAS float* scr = (LAS float*)(F.lds + F.wave * 16640);
    const int gw = F.vcu * NWAVES + F.wave, NGW = F.G * NWAVES;
    for (int it = lo + gw; it < hi; it += NGW) {
        int r = it;
        if (r < I_IN) { p0_transpose_item<true>(P.w_in, D, IN_COLS, P.g_mix, D, (bf16_t*)(ws + WS_WIN), scr, r, NIN / 64, F.lane); continue; } r -= I_IN;
        if (r < I_XKV) { p0_transpose_item<false>(P.xkv_w, D, 2 * D, nullptr, 0, (bf16_t*)(ws + WS_XKV), scr, r, 2 * D / 64, F.lane); continue; } r -= I_XKV;
        if (r < I_OUT) { p0_transpose_item<false>(P.w_out, MIXW, D, P.ssm_norm_w, 1024, (bf16_t*)(ws + WS_WOUT), scr, r, D / 64, F.lane); continue; } r -= I_OUT;
        if (r < I_XQ) { p0_transpose_item<false>(P.xq_w, D, D, P.g_xattn, D, (bf16_t*)(ws + WS_XQ), scr, r, D / 64, F.lane); continue; } r -= I_XQ;
        if (r < I_XO) { p0_transpose_item<false>(P.xo_w, D, D, nullptr, 0, (bf16_t*)(ws + WS_XO), scr, r, D / 64, F.lane); continue; } r -= I_XO;
        if (r < I_UP) { p0_transpose_item<false>(P.w_up, D, FF, P.g_mlp, D, (bf16_t*)(ws + WS_WUP), scr, r, FF / 64, F.lane); continue; } r -= I_UP;
        p0_transpose_item<false>(P.w_down, FF, D, nullptr, 0, (bf16_t*)(ws + WS_WDN), scr, r, D / 64, F.lane);
    }
}
__device__ __forceinline__ void p0_transposes_dyn(Frame& F, unsigned* ctr) {
    const PtrsK PPk = F.PP; const KAS Ptrs& P = *PPk; unsigned char* ws = P.ws;
    LAS float* scr = (LAS float*)(F.lds + F.wave * 16640);
    constexpr int NLATE = I_ALL - I_EARLY - I_DN, PER = NLATE / 8;
    static_assert(NLATE % 16 == 0, "late items split evenly over 8 counters, pulled two at a time");
    const int grp = F.vcu >> 5; unsigned* myctr = ctr + 64 * grp;
    for (;;) {
        unsigned it0 = 0; if (F.lane == 0) it0 = __hip_atomic_fetch_add(myctr, 2u, __ATOMIC_RELAXED, __HIP_MEMORY_SCOPE_AGENT);
        it0 = (unsigned)__builtin_amdgcn_readfirstlane((int)it0);
        if (it0 >= (unsigned)PER) break;
      for (int sub = 0; sub < 2; ++sub) {
        int r = grp * PER + (int)it0 + sub;
        if (r < I_OUT) { p0_transpose_item<false>(P.w_out, MIXW, D, P.ssm_norm_w, 1024, (bf16_t*)(ws + WS_WOUT), scr, r, D / 64, F.lane); continue; } r -= I_OUT;
        if (r < I_XQ) { p0_transpose_item<false>(P.xq_w, D, D, P.g_xattn, D, (bf16_t*)(ws + WS_XQ), scr, r, D / 64, F.lane); continue; } r -= I_XQ;
        if (r < I_XO) { p0_transpose_item<false>(P.xo_w, D, D, nullptr, 0, (bf16_t*)(ws + WS_XO), scr, r, D / 64, F.lane); continue; } r -= I_XO;
        if (r < I_UP) { p0_transpose_item<false>(P.w_up, D, FF, P.g_mlp, D, (bf16_t*)(ws + WS_WUP), scr, r, FF / 64, F.lane); continue; } r -= I_UP;
        p0_transpose_item<false>(P.w_down, FF, D, nullptr, 0, (bf16_t*)(ws + WS_WDN), scr, r, D / 64, F.lane);
      }
    }
}
__device__ __forceinline__ void p0_prologue(Frame& F) {
    const PtrsK PPk = F.PP; const KAS Ptrs& P = *PPk; unsigned char* ws = P.ws;
    const int gw = F.vcu * NWAVES + F.wave, NGW = F.G * NWAVES;
    bf16_t* XB = (bf16_t*)((unsigned char*)P.out + DO_XB); float* RS = (float*)(ws + WS_RSTD1);
    for (int m0 = 8 * gw; m0 < 8 * gw + 8 && m0 < M; m0 += 4) {
        f32x4 v[4][4]; float s2[4];
#pragma unroll
        for (int q = 0; q < 4; ++q) { const int m = m0 + q; const GAS f32x4* xr = (const GAS f32x4*)(P.x + (size_t)(m < M ? m : 0) * D) + F.lane;
#pragma unroll
            for (int j = 0; j < 4; ++j) v[q][j] = __builtin_nontemporal_load(xr + 64 * j); }
#pragma unroll
        for (int q = 0; q < 4; ++q) { float a = 0.f;
#pragma unroll
            for (int j = 0; j < 4; ++j) a += (v[q][j].x * v[q][j].x + v[q][j].y * v[q][j].y) + (v[q][j].z * v[q][j].z + v[q][j].w * v[q][j].w);
            s2[q] = wave_sum(a); }
#pragma unroll
        for (int q = 0; q < 4; ++q) { const int m = m0 + q; if (m < M) {
            if (F.lane == 0) RS[m] = rsqrtf(s2[q] * (1.f / D) + EPS);
            GAS unsigned long long* o8 = (GAS unsigned long long*)(XB + (size_t)m * D) + F.lane;
#pragma unroll
            for (int j = 0; j < 4; ++j) o8[64 * j] = (unsigned long long)pk2(v[q][j].x, v[q][j].y) | ((unsigned long long)pk2(v[q][j].z, v[q][j].w) << 32); } }
    }
    bf16_t* MN = (bf16_t*)(ws + WS_MEMN);
    for (int m = gw; m < MM; m += NGW) {
        const GAS f32x4* xr = (const GAS f32x4*)(P.mem + (size_t)m * D) + F.lane;
        f32x4 v[4]; float s2 = 0.f;
#pragma unroll
        for (int j = 0; j < 4; ++j) { v[j] = __builtin_nontemporal_load(xr + 64 * j); s2 += (v[j].x * v[j].x + v[j].y * v[j].y) + (v[j].z * v[j].z + v[j].w * v[j].w); }
        const float rs = rsqrtf(wave_sum(s2) * (1.f / D) + EPS);
        GAS unsigned long long* o8 = (GAS unsigned long long*)(MN + (size_t)m * D) + F.lane;
#pragma unroll
        for (int j = 0; j < 4; ++j) { const f32x4 g = ((const GAS f32x4*)P.g_mem)[F.lane + 64 * j];
            o8[64 * j] = (unsigned long long)pk2(v[j].x * rs * g.x, v[j].y * rs * g.y) | ((unsigned long long)pk2(v[j].z * rs * g.z, v[j].w * rs * g.w) << 32); }
    }
    p0_transposes(F, 0, I_EARLY);
}

__device__ __forceinline__ void p2_conv_scan(Frame& F) {
    const PtrsK PPk = F.PP; const KAS Ptrs& P = *PPk; unsigned char* ws = P.ws;
    const bf16_t* XR = (const bf16_t*)(ws + WS_BCR); bf16_t* XA = (bf16_t*)(ws + WS_BCA);
    for (int item = F.vcu; item < BATCH * NCH * NGRP; item += F.G) {
        typedef short bf16x8 __attribute__((ext_vector_type(8))); typedef float f32x16 __attribute__((ext_vector_type(16)));
        const int b = item >> 5, c = (item >> 1) & 15, g = item & 1, tid = F.tid, lane = F.lane, r32 = lane & 31, hi = lane >> 5;
        const size_t t0 = (size_t)b * SEQ + c * CHUNK;
        { const int ch8 = tid & 31, run = tid >> 5, isC = ch8 >> 4, c0 = 1024 + isC * 256 + g * 128 + (ch8 & 15) * 8, cb0 = c0 - 1024;
          float w[4][8], bb[8];
#pragma unroll
          for (int j = 0; j < 4; ++j)
#pragma unroll
              for (int i = 0; i < 8; ++i) w[j][i] = P.conv_w[j * CONVD + c0 + i];
#pragma unroll
          for (int i = 0; i < 8; ++i) bb[i] = P.conv_b[c0 + i];
          float h0[8], h1[8], h2[8];
          { v4u r0 = {0, 0, 0, 0}, r1 = r0, r2 = r0; const size_t tr = t0 + run * 8;
            if (!(c == 0 && run == 0)) { r0 = *(const v4u*)(XR + (tr - 3) * 512 + cb0); r1 = *(const v4u*)(XR + (tr - 2) * 512 + cb0); r2 = *(const v4u*)(XR + (tr - 1) * 512 + cb0); }
            const unsigned a0[4] = {r0.x, r0.y, r0.z, r0.w}, a1[4] = {r1.x, r1.y, r1.z, r1.w}, a2[4] = {r2.x, r2.y, r2.z, r2.w};
#pragma unroll
            for (int i = 0; i < 4; ++i) { h0[2 * i] = __uint_as_float(a0[i] << 16); h0[2 * i + 1] = __uint_as_float(a0[i] & 0xffff0000u);
                h1[2 * i] = __uint_as_float(a1[i] << 16); h1[2 * i + 1] = __uint_as_float(a1[i] & 0xffff0000u);
                h2[2 * i] = __uint_as_float(a2[i] << 16); h2[2 * i + 1] = __uint_as_float(a2[i] & 0xffff0000u); } }
#pragma unroll
          for (int r = 0; r < 8; ++r) { const int row = run * 8 + r;
              const v4u cv = *(const v4u*)(XR + (t0 + row) * 512 + cb0); const unsigned cw[4] = {cv.x, cv.y, cv.z, cv.w};
              float cur[8], o[8];
#pragma unroll
              for (int i = 0; i < 4; ++i) { cur[2 * i] = __uint_as_float(cw[i] << 16); cur[2 * i + 1] = __uint_as_float(cw[i] & 0xffff0000u); }
#pragma unroll
              for (int i = 0; i < 8; ++i) { o[i] = silu_f(bb[i] + w[0][i] * h0[i] + w[1][i] * h1[i] + w[2][i] * h2[i] + w[3][i] * cur[i]); h0[i] = h1[i]; h1[i] = h2[i]; h2[i] = cur[i]; }
              v4u ov; ov.x = pk2(o[0], o[1]); ov.y = pk2(o[2], o[3]); ov.z = pk2(o[4], o[5]); ov.w = pk2(o[6], o[7]);
              *(v4u*)(XA + (t0 + row) * 512 + cb0) = ov;
              *(LAS v4u*)(F.lds + isC * 32768 + (ch8 & 15) * 2048 + row * 16) = ov; } }
        asm volatile("s_waitcnt lgkmcnt(0)" ::: "memory"); __builtin_amdgcn_s_barrier(); asm volatile("" ::: "memory");
        bf16_t* CBT = (bf16_t*)(ws + WS_CBT) + (size_t)item * 10 * 64 * 16;
#pragma unroll 1
        for (int blk = F.wave; blk < 10; blk += NWAVES) {
            const int lb = blk < 1 ? 0 : blk < 3 ? 1 : blk < 6 ? 2 : 3, sb = blk - lb * (lb + 1) / 2;
            bf16x8 bfr[8], cfr[8];
#pragma unroll
            for (int kn = 0; kn < 8; ++kn) { bfr[kn] = *(const LAS bf16x8*)(F.lds + (2 * kn + hi) * 2048 + (32 * sb + r32) * 16); cfr[kn] = *(const LAS bf16x8*)(F.lds + 32768 + (2 * kn + hi) * 2048 + (32 * lb + r32) * 16); }
            __builtin_amdgcn_sched_barrier(0);
            f32x16 cbt = f32x16{};
#pragma unroll
            for (int kn = 0; kn < 8; ++kn) cbt = __builtin_amdgcn_mfma_f32_32x32x16_bf16(bfr[kn], cfr[kn], cbt, 0, 0, 0);
            v4u o0, o1;
            o0.x = pk2(cbt[0], cbt[1]); o0.y = pk2(cbt[2], cbt[3]); o0.z = pk2(cbt[4], cbt[5]); o0.w = pk2(cbt[6], cbt[7]);
            o1.x = pk2(cbt[8], cbt[9]); o1.y = pk2(cbt[10], cbt[11]); o1.z = pk2(cbt[12], cbt[13]); o1.w = pk2(cbt[14], cbt[15]);
            *(v4u*)(CBT + ((size_t)blk * 64 + lane) * 16) = o0; *(v4u*)(CBT + ((size_t)blk * 64 + lane) * 16 + 8) = o1;
        }
        asm volatile("s_waitcnt lgkmcnt(0)" ::: "memory"); __builtin_amdgcn_s_barrier(); asm volatile("" ::: "memory");
    }
    if (F.vcu < BATCH * NH) {
        const int bh = F.vcu, b = bh / NH, h = bh % NH, lane = F.lane, p0 = 256 * F.wave + 4 * lane;
        const float* DT = (const float*)(ws + WS_DT); const float* LF = (const float*)(ws + WS_LF);
        float* DTT = (float*)(ws + WS_DTT) + (size_t)bh * SEQ; float* ACS = (float*)(ws + WS_ACS) + (size_t)bh * SEQ; float* CB = (float*)(ws + WS_CUMB) + (size_t)bh * SEQ;
        const float A = -expf(P.a_log[h]);
        float dt[4], da[4], lf[4];
#pragma unroll
        for (int j4 = 0; j4 < 4; ++j4) { const size_t m = (size_t)b * SEQ + p0 + j4; dt[j4] = DT[m * 16 + h]; lf[j4] = LF[m * 16 + h]; }
        da[0] = dt[0] * A;
#pragma unroll
        for (int j4 = 1; j4 < 4; ++j4) { da[j4] = da[j4 - 1] + dt[j4] * A; lf[j4] += lf[j4 - 1]; }
        float pa = da[3], pf = lf[3];
#pragma unroll
        for (int o = 1; o < 32; o <<= 1) { const float t = __shfl_up(pa, o); if ((lane & 31) >= o) pa += t; }
#pragma unroll
        for (int o = 1; o < 64; o <<= 1) { const float t = __shfl_up(pf, o); if (lane >= o) pf += t; }
        LAS float* wt = (LAS float*)(F.lds + 140 * 1024);
        if (lane == 63) wt[F.wave] = pf;
        asm volatile("s_waitcnt lgkmcnt(0)" ::: "memory"); __builtin_amdgcn_s_barrier(); asm volatile("" ::: "memory");
        float base = 0.f;
        for (int w = 0; w < F.wave; ++w) base += wt[w];
        const float ea = pa - da[3], ef = pf - lf[3] + base;
        *(f32x4*)(DTT + p0) = (f32x4){dt[0], dt[1], dt[2], dt[3]};
        *(f32x4*)(ACS + p0) = (f32x4){da[0] + ea, da[1] + ea, da[2] + ea, da[3] + ea};
        *(f32x4*)(CB + p0) = (f32x4){(lf[0] + ef) * LOG2E, (lf[1] + ef) * LOG2E, (lf[2] + ef) * LOG2E, (lf[3] + ef) * LOG2E};
    }
}

struct Args { Ptrs P; int ph_lo, ph_hi, flags, pad; };
__device__ __forceinline__ bool in_phase(const KAS Args* ka, int k) { asm volatile("" : "+s"(ka)); return ka->ph_lo <= k && k < ka->ph_hi; }
__device__ __forceinline__ PtrsK launder(PtrsK p) { asm volatile("" : "+s"(p)); return p; }

typedef GAS unsigned gu32;
#define XB_TMO      128
#define XB_XCNT(j)  (256  + 64 * (j))
#define XB_XSUB(j)  (1280 + 64 * (j))
#define XB_XGEN(j)  (2304 + 64 * (j))
#define XB_TOP      3328
#define XB_TOPGEN   3392
#define XCD_BAR_WORDS 3456
#define XB_SPIN_CAP (1u << 18)
__device__ __forceinline__ unsigned xb_ld(unsigned* p)              { return __hip_atomic_load(p, __ATOMIC_RELAXED, __HIP_MEMORY_SCOPE_AGENT); }
__device__ __forceinline__ unsigned xb_add(unsigned* p, unsigned v) { return __hip_atomic_fetch_add(p, v, __ATOMIC_RELAXED, __HIP_MEMORY_SCOPE_AGENT); }
__device__ __forceinline__ unsigned xb_xcc_id() { return (unsigned)__builtin_amdgcn_s_getreg((3 << 11) | 20) & 0xFu; }
#define XB_SPIN(cond, bar) do { unsigned _sp = 0; while (cond) { __builtin_amdgcn_s_sleep(1); \
    if ((++_sp & 255u) == 0u) { if (xb_ld(&(bar)[XB_TMO])) break; if (_sp > XB_SPIN_CAP) { atomicAdd(&(bar)[XB_TMO], 1u); break; } } } } while (0)
struct XcdBarrier { unsigned* bar; unsigned x; volatile LAS unsigned* st; };
__device__ __forceinline__ XcdBarrier xcd_barrier_post(unsigned* bar, volatile LAS unsigned* st) {
    XcdBarrier b; b.bar = bar; b.x = xb_xcc_id(); b.st = st;
    if (threadIdx.x == 0) (void)xb_add(&bar[XB_XCNT(b.x)], 1u);
    return b;
}
__device__ __forceinline__ void xcd_barrier_complete(unsigned* bar, unsigned x, unsigned& nloc, unsigned& nx) {
    const unsigned G = gridDim.x * gridDim.y * gridDim.z;
    unsigned sum, cnt, mine, sp = 0u;
    for (;;) {
        sum = 0u; cnt = 0u; mine = 0u;
#pragma unroll
        for (unsigned j = 0; j < 16; ++j) { const unsigned c = xb_ld(&bar[XB_XCNT(j)]); sum += c; cnt += (c > 0u) ? 1u : 0u; mine = (j == x) ? c : mine; }
        if (sum == G) break;
        __builtin_amdgcn_s_sleep(1);
        if ((++sp & 255u) == 0u) { if (xb_ld(&bar[XB_TMO])) break; if (sp > XB_SPIN_CAP) { atomicAdd(&bar[XB_TMO], 1u); break; } }
    }
    nloc = mine > 0u ? mine : 1u; nx = cnt > 0u ? cnt : 1u;
}
__device__ __forceinline__ void xcd_barrier(const XcdBarrier& b) {
    asm volatile("s_waitcnt vmcnt(0)" ::: "memory");
    __syncthreads();
    if (threadIdx.x == 0) {
        unsigned* bar = b.bar;
        __builtin_amdgcn_s_waitcnt(0);
        unsigned nloc = b.st[0], nx = b.st[1];
        if (nloc == 0u) { xcd_barrier_complete(bar, b.x, nloc, nx); b.st[0] = nloc; b.st[1] = nx; }
        const unsigned old = xb_add(&bar[XB_XSUB(b.x)], 1u);
        const unsigned gen = old / nloc;
        if (old + 1u == (gen + 1u) * nloc) {
            __builtin_amdgcn_fence(__ATOMIC_RELEASE, "agent");
            asm volatile("s_waitcnt vmcnt(0)" ::: "memory");
            const unsigned og = xb_add(&bar[XB_TOP], 1u);
            const unsigned tg = og / nx;
            if (og + 1u == (tg + 1u) * nx) xb_add(&bar[XB_TOPGEN], 1u);
            else XB_SPIN(xb_ld(&bar[XB_TOPGEN]) == tg, bar);
            __builtin_amdgcn_fence(__ATOMIC_ACQUIRE, "agent");
            xb_add(&bar[XB_XGEN(b.x)], 1u);
            asm volatile("s_waitcnt vmcnt(0)" ::: "memory");
        } else {
            XB_SPIN(xb_ld(&bar[XB_XGEN(b.x)]) == gen, bar);
            __builtin_amdgcn_fence(__ATOMIC_ACQUIRE, "agent");
            asm volatile("s_waitcnt vmcnt(0)" ::: "memory");
        }
    }
    __syncthreads();
}
constexpr int CW_LATE = 7680;
constexpr int CW_BAR = 4096;
typedef const KAS Args* ArgsK;
__device__ __forceinline__ ArgsK launder(ArgsK p) { asm volatile("" : "+s"(p)); return p; }
__device__ __forceinline__ int vcu_of() { const int G = gridDim.x, bx = blockIdx.x; return (G % 8 == 0) ? (bx % 8) * (G / 8) + bx / 8 : bx; }
__device__ __forceinline__ Frame make_frame(LAS unsigned char* lds, PtrsK pp) { Frame F; F.lds = lds; F.tid = threadIdx.x; F.lane = F.tid & 63; F.wave = __builtin_amdgcn_readfirstlane(F.tid >> 6); F.G = gridDim.x; F.vcu = vcu_of(); F.PP = pp; return F; }
__global__ void __launch_bounds__(NTHR, 2) fwd(Args args_unused) {
    extern __shared__ __attribute__((aligned(16))) unsigned char lds_raw[];
    const ArgsK KA = (ArgsK)__builtin_amdgcn_kernarg_segment_ptr();
    volatile LAS unsigned* MISC = (volatile LAS unsigned*)((LAS unsigned char*)lds_raw + MISC_OFF);
    if (threadIdx.x < 4) MISC[threadIdx.x] = 0u;
    __syncthreads();
    XcdBarrier bar; bar.bar = nullptr; bar.x = 0; bar.st = MISC;
    { const ArgsK A = launder(KA); if (A->ph_hi - A->ph_lo > 1) bar = xcd_barrier_post((unsigned*)(A->P.ws + WS_CTL) + CW_BAR, MISC); }
#define SEAM(k) do { if (in_phase(KA, (k)) && in_phase(KA, (k) + 1)) xcd_barrier(bar); } while (0)
#ifndef PH_MASK
#define PH_MASK 0xFFFF
#endif
#define IN(k) (((PH_MASK >> (k)) & 1) && in_phase(KA, (k)))
#define LDSP ((LAS unsigned char*)lds_raw)
#define XLP (LDSP + pg8::STAGE_BYTES)
    if (IN(0)) { const ArgsK A = launder(KA); Frame F = make_frame(LDSP, &A->P); p0_prologue(F); }
    SEAM(0);
    if (IN(1)) {
        const ArgsK A = launder(KA); const PtrsK PP = &A->P; const int v = vcu_of();
        pg8::SchedP1 S{(const char*)PP->out, (const char*)PP->ws, v >> 5, v & 31};
        pg8::EpiP1 E{PP};
        pg8::gemm_phase(LDSP, XLP, D, S, E);
    }
    SEAM(1);
    if (IN(2)) { const ArgsK A = launder(KA); Frame F = make_frame(LDSP, &A->P); p2_conv_scan(F); }
    SEAM(2);
    if (IN(3)) {
        static_assert(attn_body::ATTN_LDS_BYTES <= RING_BYTES && ssd::LDS_BYTES <= RING_BYTES, "mixer LDS");
        { const int v = vcu_of(); const ArgsK A = launder(KA); if ((v & 1) == 0) { ssd::ssd_item(A->P, v >> 1, LDSP); __syncthreads();
            static_assert(I_DN == 128 * NWAVES, "one item per wave of the even CUs");
            const int w = __builtin_amdgcn_readfirstlane(threadIdx.x >> 6);
            p0_transpose_item<false>(A->P.w_down, FF, D, nullptr, 0, (bf16_t*)(A->P.ws + WS_WDN), (LAS float*)(LDSP + w * 16640), (v >> 1) * NWAVES + w, D / 64, threadIdx.x & 63);
            __syncthreads(); } }
        { const ArgsK A = launder(KA); unsigned char* ws = A->P.ws;
        const attn_body::AttnTensorsB AT{(const attn_body::bf16*)(ws + WS_Q), (const attn_body::bf16*)(ws + WS_K), (const attn_body::bf16*)(ws + WS_V), (attn_body::bf16*)(ws + WS_MIXED), (const float*)(ws + WS_CUMB)};
        const attn_body::StaticOrder S(vcu_of());
        attn_body::attn_phase<attn_body::StaticOrder>((char*)lds_raw, AT, S); }
        { __syncthreads(); const ArgsK A = launder(KA); Frame F = make_frame(LDSP, &A->P); p0_transposes_dyn(F, (unsigned*)(A->P.ws + WS_CTL) + CW_LATE); }
    }
    SEAM(3);
    if (IN(4)) {
        const ArgsK A = launder(KA); const PtrsK PP = &A->P; unsigned char* ws = PP->ws; const int v = vcu_of();
        pg8::SchedOne S{(const char*)(ws + WS_MIXED), (const char*)(ws + WS_WOUT), v >> 5, v & 31, 32, (size_t)256 * MIXW * 2};
        pg8::EpiRes<true, true> E{(const unsigned char*)PP->out + DO_XB, (bf16_t*)(ws + WS_X1B), (float*)(ws + WS_SSQ2), (const float*)(ws + WS_SSQ)};
        pg8::gemm_phase(LDSP, XLP, MIXW, S, E);
    }
    SEAM(4);
    if (IN(5)) {
        const ArgsK A = launder(KA); const PtrsK PP = &A->P; unsigned char* ws = PP->ws; const int v = vcu_of();
        pg8::SchedOne S{(const char*)(ws + WS_X1B), (const char*)(ws + WS_XQ), v >> 5, v & 31, 32, (size_t)256 * D * 2};
        pg8::EpiXq E{(const float*)(ws + WS_SSQ2), PP->xg_q, (bf16_t*)(ws + WS_QX)};
        pg8::gemm_phase(LDSP, XLP, D, S, E);
    }
    if (in_phase(KA, 5) && in_phase(KA, 6)) { if (threadIdx.x == 0) { __builtin_amdgcn_fence(__ATOMIC_ACQUIRE, "agent"); asm volatile("s_waitcnt vmcnt(0)" ::: "memory"); } __syncthreads(); }
    if (IN(6)) {
        static_assert(xattn::LDS_BYTES <= RING_BYTES, "xattn LDS");
        const ArgsK A = launder(KA); unsigned char* ws = A->P.ws;
        for (int u = vcu_of(); u < BATCH * XH * 8; u += (int)gridDim.x)
            xattn::xattn_unit((const bf16_t*)(ws + WS_QX), (const bf16_t*)(ws + WS_KX), (const bf16_t*)(ws + WS_VX), (bf16_t*)(ws + WS_OX), u >> 5, (u >> 3) & 3, u & 7, LDSP);
    }
    SEAM(6);
    if (IN(7)) {
        const ArgsK A = launder(KA); const PtrsK PP = &A->P; unsigned char* ws = PP->ws; const int v = vcu_of();
        pg8::SchedOne S{(const char*)(ws + WS_OX), (const char*)(ws + WS_XO), v >> 5, v & 31, 32, (size_t)256 * D * 2};
        pg8::EpiRes<false, true> E{ws + WS_X1B, (bf16_t*)(ws + WS_X2B), (float*)(ws + WS_SSQ3), nullptr};
        pg8::gemm_phase(LDSP, XLP, D, S, E);
    }
    SEAM(7);
    if (IN(8)) {
        const ArgsK A = launder(KA); const PtrsK PP = &A->P; unsigned char* ws = PP->ws; const int v = vcu_of();
        pg8::SchedOne S{(const char*)(ws + WS_X2B), (const char*)(ws + WS_WUP), v >> 5, v & 31, 128, (size_t)256 * D * 2};
        pg8::EpiUp E{(const float*)(ws + WS_SSQ3), (bf16_t*)(ws + WS_HB)};
        pg8::gemm_phase(LDSP, XLP, D, S, E);
    }
    SEAM(8);
    if (IN(9)) {
        const ArgsK A = launder(KA); const PtrsK PP = &A->P; unsigned char* ws = PP->ws; const int v = vcu_of();
        pg8::SchedOne S{(const char*)(ws + WS_HB), (const char*)(ws + WS_WDN), v >> 5, v & 31, 32, (size_t)256 * FF * 2};
        pg8::EpiDown E{(const bf16_t*)(ws + WS_X2B), PP->out};
        pg8::gemm_phase(LDSP, XLP, FF, S, E);
    }
#undef IN
#undef SEAM
#undef LDSP
#undef XLP
}

extern "C" void kernel_launch(void* const* d_in, const int* in_sizes, int n_in, void* d_out, int out_size, void* d_ws, size_t ws_size, hipStream_t stream) {
    static int ready = 0;
    if (!ready) {
        if (n_in != 24 || out_size != M * D || ws_size < WS_END) { fprintf(stderr, "kernel_launch: unexpected shapes (n_in %d out %d ws %zu)\n", n_in, out_size, ws_size); ready = -1; return; }
        if (hipFuncSetAttribute((const void*)fwd, hipFuncAttributeMaxDynamicSharedMemorySize, LDS_BYTES) != hipSuccess) { fprintf(stderr, "kernel_launch: hipFuncSetAttribute failed\n"); ready = -1; return; }
        int dev = 0, cus = 0, per_cu = 0;
        if (hipGetDevice(&dev) != hipSuccess || hipDeviceGetAttribute(&cus, hipDeviceAttributeMultiprocessorCount, dev) != hipSuccess) cus = 0;
        if (hipOccupancyMaxActiveBlocksPerMultiprocessor(&per_cu, (const void*)fwd, NTHR, LDS_BYTES) != hipSuccess) per_cu = 0;
        (void)hipGetLastError();
        ready = (cus * per_cu >= 256) ? 2 : 1;
    }
    if (ready < 0) return;
    Args a{};
    const float** pp = (const float**)&a.P;
    for (int i = 0; i < 24; ++i) pp[i] = (const float*)d_in[i];
    a.P.out = (float*)d_out; a.P.ws = (unsigned char*)d_ws;
    (void)hipMemsetAsync((char*)d_ws + WS_CTL, 0, CTL_ZERO_BYTES, stream);
    const int G = 256;
    auto PH = [&](int lo, int hi) { a.ph_lo = lo; a.ph_hi = hi; hipLaunchKernelGGL(fwd, dim3(G), dim3(NTHR), LDS_BYTES, stream, a); };
#ifndef N_LAUNCHES
#define N_LAUNCHES 1
#endif
    if (N_LAUNCHES == 1 && ready == 2) PH(0, 10);
    else for (int p = 0; p < 10; ++p) PH(p, p + 1);
}
```

```cpp
#include <hip/hip_runtime.h>
#include <hip/hip_bf16.h>
#include <cmath>
#include <cstdio>
#include <cstdint>

typedef unsigned short bf16_t;
#define GAS __attribute__((address_space(1)))
#define LAS __attribute__((address_space(3)))
typedef unsigned v4u __attribute__((ext_vector_type(4)));
typedef float f32x4 __attribute__((ext_vector_type(4)));

constexpr int D = 1024, BATCH = 8, SEQ = 2048, M = BATCH * SEQ, MEML = 256, MM = BATCH * MEML;
constexpr int NH = 16, HD = 64, NGRP = 2, NST = 128, CHUNK = 128, NCH = SEQ / CHUNK, CONVD = 1536, MIXW = 2048;
constexpr int IN_COLS = 5664, NIN = 5888;
constexpr int XH = 4, XHD = 256, FF = 4096;
constexpr float EPS = 1e-5f, LOG2E = 1.4426950408889634f;
constexpr float C2 = 0.125f * LOG2E;
constexpr float CX2 = 0.0625f * LOG2E;

__host__ __device__ __forceinline__ int win_src_col(int n) { if (n < 2560) return n; if (n < 5632) return n + 16; if (n < 5648) return n - 5632 + 2560; if (n < 5664) return n; return -1; }

constexpr int NWAVES = 8, NTHR = NWAVES * 64;
constexpr size_t MiB = 1u << 20;
constexpr size_t WS_CTL = 0, CTL_ZERO_BYTES = 32768;
constexpr size_t WS_WIN = 1 * MiB, WS_WOUT = 13 * MiB, WS_XQ = 17 * MiB, WS_XKV = 19 * MiB, WS_XO = 23 * MiB, WS_WUP = 25 * MiB, WS_WDN = 33 * MiB;
constexpr size_t WS_ZS = 41 * MiB;
constexpr size_t WS_X1B = WS_ZS;
constexpr size_t WS_BCR = 73 * MiB;
constexpr size_t WS_MIXED = WS_BCR;
constexpr size_t WS_XB = 89 * MiB;
constexpr size_t WS_Q = 137 * MiB, WS_K = 169 * MiB, WS_V = 201 * MiB;
constexpr size_t WS_QX = WS_Q, WS_OX = WS_K, WS_X2B = WS_V;
constexpr size_t WS_HB = 73 * MiB;
constexpr size_t WS_KX = 233 * MiB, WS_VX = 237 * MiB;
constexpr size_t WS_DT = 241 * MiB, WS_LF = 242 * MiB, WS_DTT = 243 * MiB, WS_ACS = 244 * MiB, WS_CUMB = 245 * MiB;
constexpr size_t WS_SSQ = 246 * MiB, WS_SSQ2 = 247 * MiB, WS_SSQ3 = 248 * MiB, WS_RSTD1 = 249 * MiB, WS_CBT = 250 * MiB, WS_MEMN = WS_CBT, WS_END = 255 * MiB;
constexpr size_t DO_XB = 0, DO_BCA = 0, DO_XRAW = 32 * MiB;

__device__ __forceinline__ float bf2f(bf16_t v) { return __uint_as_float((unsigned)v << 16); }
__device__ __forceinline__ unsigned f2bf(float f) { unsigned u = __float_as_uint(f); return (u + 0x7fffu + ((u >> 16) & 1u)) >> 16; }
__device__ __forceinline__ unsigned pk2(float lo, float hi) { return f2bf(lo) | (f2bf(hi) << 16); }
__device__ __forceinline__ float wave_sum(float v) {
#pragma unroll
    for (int o = 1; o < 64; o <<= 1) v += __shfl_xor(v, o);
    return v;
}
__device__ __forceinline__ float wave_max(float v) {
#pragma unroll
    for (int o = 1; o < 64; o <<= 1) v = fmaxf(v, __shfl_xor(v, o));
    return v;
}
__device__ __forceinline__ float silu_f(float x) { return x * __builtin_amdgcn_rcpf(1.f + __builtin_amdgcn_exp2f(-x * LOG2E)); }
__device__ __forceinline__ float softplus_f(float x) { return x > 20.f ? x : log1pf(expf(x)); }

#define KAS __attribute__((address_space(4)))
struct Ptrs {
    const float *x, *mem, *g_mix, *w_in, *conv_w, *conv_b, *dt_bias, *a_log, *d_skip, *ssm_norm_w, *g_q, *g_k, *f_bias, *w_out, *g_xattn, *g_mem,
        *xq_w, *xkv_w, *xg_q, *xg_k, *xo_w, *g_mlp, *w_up, *w_down;
    float* out; unsigned char* ws;
};
typedef const KAS Ptrs* PtrsK;

namespace pg8 {
typedef short bf16x8 __attribute__((ext_vector_type(8)));
typedef unsigned u32x4 __attribute__((ext_vector_type(4)));
constexpr int BM = 256, BK = 64, HALF = 128, HTB = HALF * BK * 2, STAGE_BYTES = 8 * HTB;
__host__ __device__ __forceinline__ int lds_byte(int r, int c) { const int st = (r >> 4) * 2 + (c >> 5), rr = r & 15, cc = c & 31, ob = rr * 64 + cc * 2; return st * 1024 + (ob ^ (((ob >> 9) & 1) << 5)); }
__host__ __device__ __forceinline__ void stage_rc(int b, int& R, int& C) { const int st = b / 1024, sb = b % 1024, swz = sb ^ (((sb >> 9) & 1) << 5); R = (st >> 1) * 16 + swz / 64; C = (st & 1) * 32 + (swz % 64) / 2; }
__host__ __device__ __forceinline__ int perm32(int rho) { const int n = rho >> 4, i = rho & 15; return 8 * (i >> 2) + 4 * n + (i & 3); }
struct Unit { int pm, pn, kind; const char* a; const char* b; };
typedef f32x4 Acc[2][2][4][2];
__device__ __forceinline__ unsigned cvt_pk_bf16(float lo, float hi) { unsigned r; asm volatile("v_cvt_pk_bf16_f32 %0, %1, %2" : "=v"(r) : "v"(lo), "v"(hi)); return r; }

template <class Epi, class Sched>
__device__ __forceinline__ void gemm_phase(LAS unsigned char* lds, LAS unsigned char* xl, const int K, const Sched& S, const Epi& E) {
    const int tid = threadIdx.x, wid = __builtin_amdgcn_readfirstlane(tid >> 6), lane = tid & 63, wr = wid >> 2, wc = wid & 3, fr = lane & 15, fq = lane >> 4;
    const int nt = K / BK;
    unsigned voffA[2], voffB[2];
#pragma unroll
    for (int i = 0; i < 2; ++i) { int R, C; stage_rc(tid * 16 + i * 8192, R, C); const int Rb = (R >> 5) * 64 + perm32(R & 31);
        voffA[i] = (unsigned)(R * K + C) * 2u; voffB[i] = (unsigned)(Rb * K + C) * 2u; }
    const size_t kstep = (size_t)(BK * 2);
    const size_t hstep = (size_t)HALF * K * 2;
    const size_t bstep = (size_t)32 * K * 2;
    const unsigned ldsw = (unsigned)wid * 1024u;
    const int aoff = lds_byte(wr * 64 + fr, fq * 8), boff = lds_byte(wc * 32 + fr, fq * 8);
#define PG8_SA(b, h) (((b) * 2 + (h)) * HTB)
#define PG8_SB(b, h) ((4 + (b) * 2 + (h)) * HTB)
#define PG8_STAGE(bufoff, gbase, voff) do { _Pragma("unroll") for (int _i = 0; _i < 2; ++_i) \
        __builtin_amdgcn_global_load_lds((const unsigned*)((const char*)(gbase) + (voff)[_i]), (LAS unsigned*)(lds + (bufoff) + ldsw + _i * 8192), 16, 0, 0); } while (0)
#define PG8_LDA(dst, b, h) do { _Pragma("unroll") for (int m = 0; m < 4; ++m) _Pragma("unroll") for (int k = 0; k < 2; ++k) dst[m][k] = *(const LAS bf16x8*)(lds + PG8_SA(b, h) + aoff + m * 2048 + k * 1024); } while (0)
#define PG8_LDB(dst, b, h) do { _Pragma("unroll") for (int n = 0; n < 2; ++n) _Pragma("unroll") for (int k = 0; k < 2; ++k) dst[n][k] = *(const LAS bf16x8*)(lds + PG8_SB(b, h) + boff + n * 2048 + k * 1024); } while (0)
#define PG8_MMA(ai, bj, At, Bt) do { __builtin_amdgcn_s_setprio(1); _Pragma("unroll") for (int m = 0; m < 4; ++m) _Pragma("unroll") for (int n = 0; n < 2; ++n) _Pragma("unroll") for (int k = 0; k < 2; ++k) \
        acc[ai][bj][m][n] = __builtin_amdgcn_mfma_f32_16x16x32_bf16(Bt[n][k], At[m][k], acc[ai][bj][m][n], 0, 0, 0); __builtin_amdgcn_s_setprio(0); } while (0)
#define PG8_WAIT_V(n) asm volatile("s_waitcnt vmcnt(" #n ")" ::: "memory")
#define PG8_WAIT_L(n) asm volatile("s_waitcnt lgkmcnt(" #n ")" ::: "memory")
#define PG8_BAR __builtin_amdgcn_s_barrier()
#define PG8_SCHED __builtin_amdgcn_sched_barrier(0)
    Unit cur, nxt; int ui = 0;
    if (!S.next(0, cur)) return;
    E.prepare(xl, cur, tid);
    asm volatile("s_waitcnt vmcnt(0) lgkmcnt(0)" ::: "memory"); __builtin_amdgcn_s_barrier(); asm volatile("" ::: "memory");
    Acc acc;
#pragma unroll
    for (int a = 0; a < 2; ++a)
#pragma unroll
        for (int b = 0; b < 2; ++b)
#pragma unroll
            for (int m = 0; m < 4; ++m)
#pragma unroll
                for (int n = 0; n < 2; ++n) acc[a][b][m][n] = (f32x4){0.f, 0.f, 0.f, 0.f};
    bf16x8 At[4][2], B0[2][2], B1[2][2];
    const char* cA = cur.a; const char* cB = cur.b;
    PG8_STAGE(PG8_SB(0, 0), cB, voffB); PG8_STAGE(PG8_SB(0, 1), cB + bstep, voffB); PG8_STAGE(PG8_SA(0, 0), cA, voffA); PG8_STAGE(PG8_SA(0, 1), cA + hstep, voffA);
    if (wr == 1) PG8_BAR;
    PG8_WAIT_V(2); PG8_BAR;
    PG8_STAGE(PG8_SB(1, 0), cB + kstep, voffB); PG8_STAGE(PG8_SA(1, 0), cA + kstep, voffA); PG8_STAGE(PG8_SB(1, 1), cB + bstep + kstep, voffB);
    PG8_WAIT_V(6); PG8_BAR;
    for (;;) {
        const bool has_next = S.next(ui + 1, nxt);
        const char* nA = has_next ? nxt.a : cA; const char* nB = has_next ? nxt.b : cB;
        for (int t = 0; t < nt; t += 2) {
            const bool last = (t == nt - 2);
            const char* a1 = cA + (size_t)(t + 1) * kstep;
            const char* a2 = last ? nA : cA + (size_t)(t + 2) * kstep; const char* b2 = last ? nB : cB + (size_t)(t + 2) * kstep;
            const char* a3 = a2 + kstep; const char* b3 = b2 + kstep;
            if constexpr (Epi::KSEG) { if (t == 8 || t == 16) E.kseg(acc, cur, t, wr, fr, xl); }
            PG8_LDB(B0, 0, 0); PG8_LDB(B1, 0, 1); PG8_SCHED; PG8_LDA(At, 0, 0); PG8_STAGE(PG8_SA(1, 1), a1 + hstep, voffA);
            PG8_WAIT_V(8); PG8_WAIT_L(0); PG8_BAR; PG8_MMA(0, 0, At, B0); PG8_MMA(0, 1, At, B1); PG8_BAR; PG8_SCHED;
            PG8_LDA(At, 0, 1); PG8_STAGE(PG8_SB(0, 0), b2, voffB); PG8_STAGE(PG8_SB(0, 1), b2 + bstep, voffB); PG8_STAGE(PG8_SA(0, 0), a2, voffA);
            PG8_WAIT_V(8); PG8_WAIT_L(0); PG8_BAR; PG8_MMA(1, 0, At, B0); PG8_MMA(1, 1, At, B1); PG8_BAR; PG8_SCHED;
            PG8_LDB(B0, 1, 0); PG8_LDB(B1, 1, 1); PG8_SCHED; PG8_LDA(At, 1, 0); PG8_STAGE(PG8_SA(0, 1), a2 + hstep, voffA);
            PG8_WAIT_V(8); PG8_WAIT_L(0); PG8_BAR; PG8_MMA(0, 0, At, B0); PG8_MMA(0, 1, At, B1); PG8_BAR; PG8_SCHED;
            PG8_LDA(At, 1, 1); PG8_STAGE(PG8_SB(1, 0), b3, voffB); PG8_STAGE(PG8_SB(1, 1), b3 + bstep, voffB); PG8_STAGE(PG8_SA(1, 0), a3, voffA);
            PG8_WAIT_V(8); PG8_WAIT_L(0); PG8_BAR; PG8_MMA(1, 0, At, B0); PG8_MMA(1, 1, At, B1); PG8_BAR; PG8_SCHED;
        }
        if (wr == 0) PG8_BAR;
        E.run(acc, cur, wr, wc, fr, fq, xl, lane);
        if (!has_next) break;
#pragma unroll
        for (int a = 0; a < 2; ++a)
#pragma unroll
            for (int b = 0; b < 2; ++b)
#pragma unroll
                for (int m = 0; m < 4; ++m)
#pragma unroll
                    for (int n = 0; n < 2; ++n) acc[a][b][m][n] = (f32x4){0.f, 0.f, 0.f, 0.f};
        cur = nxt; cA = nA; cB = nB; ++ui;
        if (wr == 1) PG8_BAR;
    }
    PG8_WAIT_V(0);
    PG8_BAR;
#undef PG8_SA
#undef PG8_SB
#undef PG8_STAGE
#undef PG8_LDA
#undef PG8_LDB
#undef PG8_MMA
#undef PG8_WAIT_V
#undef PG8_WAIT_L
#undef PG8_BAR
#undef PG8_SCHED
}

struct SchedOne {
    const char* A; const char* Bt; int x, c, ntile; size_t tstep;
    __device__ __forceinline__ bool next(int i, Unit& u) const { const int j = i * 32 + c; if (j >= ntile) return false; u.pm = 8 * x + (j & 7); u.pn = j >> 3; u.kind = 0; u.a = A + (size_t)u.pm * tstep; u.b = Bt + (size_t)u.pn * tstep; return true; }
};
struct SchedP1 {
    const char *outb, *ws; int x, c;
    __device__ __forceinline__ bool next(int i, Unit& u) const {
        const int j = i * 32 + c; if (j >= 192) return false; constexpr size_t tstep = (size_t)256 * D * 2;
        if (j < 184) { u.pm = 8 * x + (j & 7); u.pn = j >> 3; const int pn = u.pn; u.kind = pn < 4 ? 0 : pn < 10 ? 1 : pn < 14 ? 2 : pn < 18 ? 3 : pn < 22 ? 4 : 5; u.a = ws + WS_XB + (size_t)u.pm * tstep; u.b = ws + WS_WIN + (size_t)pn * tstep; }
        else { u.pm = x; u.pn = j - 184; u.kind = u.pn < 4 ? 6 : 7; u.a = ws + WS_MEMN + (size_t)u.pm * tstep; u.b = ws + WS_XKV + (size_t)u.pn * tstep; }
        return true;
    }
};

__device__ __forceinline__ float row_ssq64(const Acc& acc, int ai, int m) {
    float s = 0.f;
#pragma unroll
    for (int bj = 0; bj < 2; ++bj)
#pragma unroll
        for (int n = 0; n < 2; ++n) { const f32x4 v = acc[ai][bj][m][n]; s += (v[0] * v[0] + v[1] * v[1]) + (v[2] * v[2] + v[3] * v[3]); }
    s += __shfl_xor(s, 16); s += __shfl_xor(s, 32); return s;
}
__device__ __forceinline__ void row_ssq256(const Acc& acc, int wr, int wc, int fr, int fq, LAS unsigned char* xl, float (&tot)[2][4]) {
    LAS float* Pp = (LAS float*)xl;
#pragma unroll
    for (int ai = 0; ai < 2; ++ai)
#pragma unroll
        for (int m = 0; m < 4; ++m) { const float s = row_ssq64(acc, ai, m); if (fq == 0) Pp[(ai * HALF + wr * 64 + m * 16 + fr) * 4 + wc] = s; }
    asm volatile("s_waitcnt lgkmcnt(0)" ::: "memory"); __builtin_amdgcn_s_barrier(); asm volatile("" ::: "memory");
#pragma unroll
    for (int ai = 0; ai < 2; ++ai)
#pragma unroll
        for (int m = 0; m < 4; ++m) { const f32x4 p = *(const LAS f32x4*)(Pp + (ai * HALF + wr * 64 + m * 16 + fr) * 4); tot[ai][m] = (p[0] + p[1]) + (p[2] + p[3]); }
    asm volatile("s_waitcnt lgkmcnt(0)" ::: "memory"); __builtin_amdgcn_s_barrier(); asm volatile("" ::: "memory");
}
__device__ __forceinline__ u32x4 pack8(const f32x4 a, const f32x4 b) { u32x4 w; w.x = cvt_pk_bf16(a[0], a[1]); w.y = cvt_pk_bf16(a[2], a[3]); w.z = cvt_pk_bf16(b[0], b[1]); w.w = cvt_pk_bf16(b[2], b[3]); return w; }
__device__ __forceinline__ float sum16(const float* p) { const f32x4 a = *(const f32x4*)p, b = *(const f32x4*)(p + 4), c = *(const f32x4*)(p + 8), d = *(const f32x4*)(p + 12);
    return ((a[0] + a[1]) + (a[2] + a[3])) + ((b[0] + b[1]) + (b[2] + b[3])) + ((c[0] + c[1]) + (c[2] + c[3])) + ((d[0] + d[1]) + (d[2] + d[3])); }

__device__ __forceinline__ float softplus_fast(float x) {
    const float t = __builtin_amdgcn_exp2f(fminf(x, 60.f) * LOG2E);
    const float small = t * (1.f - t * (0.5f - t * 0.33333334f)), big = __builtin_amdgcn_logf(1.f + t) * 0.6931471805599453f;
    return x > 20.f ? x : (t < 0.015625f ? small : big);
}
struct EpiP1 {
    static constexpr bool KSEG = false;
    PtrsK PP;
    __device__ __forceinline__ void kseg(Acc&, const Unit&, int, int, int, LAS unsigned char*) const {}
    __device__ __forceinline__ void prepare(LAS unsigned char* xl, const Unit& u, int tid) const {
        if (tid < 256) ((LAS float*)(xl + 4096))[tid] = ((const float*)(PP->ws + WS_RSTD1))[u.pm * BM + tid]; }
    template <int KIND> __device__ __forceinline__ void body(Acc& acc, const Unit& u, int wr, int wc, int fr, int fq, LAS unsigned char* xl, bf16_t* base, int ldc, int colt, const float* gp) const {
        const int rowt = wr * 64 + fr, row0 = u.pm * BM + rowt, colw = wc * 64 + 8 * fq;
        const LAS float* RSC = (const LAS float*)(xl + 4096) + rowt;
        float tot[2][4];
        if (KIND == 6) row_ssq256(acc, wr, wc, fr, fq, xl, tot);
        f32x4 g[2][2];
        if (KIND == 2 || KIND == 3 || KIND == 6) {
#pragma unroll
            for (int bj = 0; bj < 2; ++bj)
#pragma unroll
                for (int n = 0; n < 2; ++n) g[bj][n] = *(const f32x4*)(gp + bj * 32 + n * 4);
        }
#pragma unroll
        for (int ai = 0; ai < 2; ++ai)
#pragma unroll
            for (int m = 0; m < 4; ++m) {
                const int row = row0 + ai * HALF + m * 16;
                float rs = KIND < 6 ? RSC[ai * HALF + m * 16] : 1.f;
                if (KIND == 2 || KIND == 3) { const float s2 = row_ssq64(acc, ai, m) * rs * rs; rs *= rsqrtf(s2 * (1.f / 64.f) + EPS); if (KIND == 2) rs *= C2; }
                if (KIND == 6) rs = rsqrtf(tot[ai][m] * (1.f / 256.f) + EPS);
                bf16_t* rowp = base + (size_t)row * ldc + colt + colw;
#pragma unroll
                for (int bj = 0; bj < 2; ++bj) {
                    f32x4 v0 = acc[ai][bj][m][0], v1 = acc[ai][bj][m][1];
                    if (KIND != 7) { v0 = v0 * rs; v1 = v1 * rs; }
                    if (KIND == 2 || KIND == 3 || KIND == 6) { v0 = v0 * g[bj][0]; v1 = v1 * g[bj][1]; }
                    if (KIND == 0) {
#pragma unroll
                        for (int e = 0; e < 4; ++e) { v0[e] = silu_f(v0[e]); v1[e] = silu_f(v1[e]); } }
                    *(u32x4*)(rowp + bj * 32) = pack8(v0, v1);
                }
            }
    }
    __device__ __forceinline__ void run(Acc& acc, const Unit& u, int wr, int wc, int fr, int fq, LAS unsigned char* xl, int lane) const {
        const int kind = u.kind; unsigned char* ws = PP->ws; const int colw = wc * 64 + 8 * fq;
        switch (kind) {
        case 0: body<0>(acc, u, wr, wc, fr, fq, xl, (bf16_t*)(ws + WS_ZS), 1024, u.pn * 256, nullptr); break;
        case 1: if (u.pn < 8) body<1>(acc, u, wr, wc, fr, fq, xl, (bf16_t*)((unsigned char*)PP->out + DO_XRAW), 1024, (u.pn - 4) * 256, nullptr);
                else body<1>(acc, u, wr, wc, fr, fq, xl, (bf16_t*)(ws + WS_BCR), 512, (u.pn - 8) * 256, nullptr); break;
        case 2: body<2>(acc, u, wr, wc, fr, fq, xl, (bf16_t*)(ws + WS_Q), 1024, (u.pn - 10) * 256, PP->g_q + 8 * fq); break;
        case 3: body<3>(acc, u, wr, wc, fr, fq, xl, (bf16_t*)(ws + WS_K), 1024, (u.pn - 14) * 256, PP->g_k + 8 * fq); break;
        case 4: body<1>(acc, u, wr, wc, fr, fq, xl, (bf16_t*)(ws + WS_V), 1024, (u.pn - 18) * 256, nullptr); break;
        case 6: body<6>(acc, u, wr, wc, fr, fq, xl, (bf16_t*)(ws + WS_KX), 1024, u.pn * 256, PP->xg_k + colw); break;
        case 7: body<7>(acc, u, wr, wc, fr, fq, xl, (bf16_t*)(ws + WS_VX), 1024, (u.pn - 4) * 256, nullptr); break;
        default: {
            if (wc == 0) {
                const int rowt = wr * 64 + fr, row0 = u.pm * BM + rowt; const LAS float* RSC = (const LAS float*)(xl + 4096) + rowt;
                const int c0 = 8 * fq; const bool isdt = fq < 2;
                const float* bias = isdt ? PP->dt_bias + c0 : PP->f_bias + (c0 - 16); float* dst = isdt ? (float*)(ws + WS_DT) + c0 : (float*)(ws + WS_LF) + (c0 - 16);
                const f32x4 b0 = *(const f32x4*)bias, b1 = *(const f32x4*)(bias + 4); const float sg = isdt ? 1.f : -1.f;
#pragma unroll
                for (int ai = 0; ai < 2; ++ai)
#pragma unroll
                    for (int m = 0; m < 4; ++m) { const int row = row0 + ai * HALF + m * 16; const float rs = RSC[ai * HALF + m * 16];
                        f32x4 v0 = acc[ai][0][m][0] * rs + b0, v1 = acc[ai][0][m][1] * rs + b1;
#pragma unroll
                        for (int e = 0; e < 4; ++e) { v0[e] = sg * softplus_fast(sg * v0[e]); v1[e] = sg * softplus_fast(sg * v1[e]); }
                        *(f32x4*)(dst + (size_t)row * 16) = v0; *(f32x4*)(dst + (size_t)row * 16 + 4) = v1; }
            } } break;
        }
    }
};
template <bool KSEG_, bool BASE_BF16> struct EpiRes {
    static constexpr bool KSEG = KSEG_;
    const void* base; bf16_t* XBo; float* SSQo; const float* SSQi;
    __device__ __forceinline__ void prepare(LAS unsigned char* xl, const Unit& u, int tid) const {
        if (KSEG_ && tid < 256) { const float* sp = SSQi + (size_t)(u.pm * BM + tid) * 16;
            const f32x4 a = *(const f32x4*)sp, b = *(const f32x4*)(sp + 4), c = *(const f32x4*)(sp + 8), d = *(const f32x4*)(sp + 12);
            const float q0 = ((a[0] + a[1]) + (a[2] + a[3])) + ((b[0] + b[1]) + (b[2] + b[3])), q1 = ((c[0] + c[1]) + (c[2] + c[3])) + ((d[0] + d[1]) + (d[2] + d[3]));
            const float r0 = rsqrtf(q0 * (1.f / 512.f) + EPS), r1 = rsqrtf(q1 * (1.f / 512.f) + EPS);
            ((LAS float*)(xl + 4096))[tid] = r0 / r1; ((LAS float*)(xl + 5120))[tid] = r1; } }
    __device__ __forceinline__ void kseg(Acc& acc, const Unit& u, int t, int wr, int fr, LAS unsigned char* xl) const {
        const LAS float* F = (const LAS float*)(xl + (t == 8 ? 4096 : 5120)) + wr * 64 + fr;
#pragma unroll
        for (int ai = 0; ai < 2; ++ai)
#pragma unroll
            for (int m = 0; m < 4; ++m) { const float f = F[ai * HALF + m * 16];
#pragma unroll
                for (int bj = 0; bj < 2; ++bj)
#pragma unroll
                    for (int n = 0; n < 2; ++n) acc[ai][bj][m][n] = acc[ai][bj][m][n] * f; }
    }
    __device__ __forceinline__ void run(Acc& acc, const Unit& u, int wr, int wc, int fr, int fq, LAS unsigned char* xl, int lane) const {
        const int row0 = u.pm * BM + wr * 64 + fr, col0 = u.pn * 256 + wc * 64 + 8 * fq;
#pragma unroll
        for (int ai = 0; ai < 2; ++ai) {
            f32x4 xr[4][2][2];
#pragma unroll
            for (int m = 0; m < 4; ++m) { const size_t off = (size_t)(row0 + ai * HALF + m * 16) * D + col0;
#pragma unroll
                for (int bj = 0; bj < 2; ++bj) {
                    if (BASE_BF16) { const u32x4 w = *(const u32x4*)((const bf16_t*)base + off + bj * 32);
                        xr[m][bj][0] = (f32x4){__uint_as_float(w.x << 16), __uint_as_float(w.x & 0xffff0000u), __uint_as_float(w.y << 16), __uint_as_float(w.y & 0xffff0000u)};
                        xr[m][bj][1] = (f32x4){__uint_as_float(w.z << 16), __uint_as_float(w.z & 0xffff0000u), __uint_as_float(w.w << 16), __uint_as_float(w.w & 0xffff0000u)}; }
                    else { xr[m][bj][0] = __builtin_nontemporal_load((const f32x4*)((const float*)base + off + bj * 32)); xr[m][bj][1] = __builtin_nontemporal_load((const f32x4*)((const float*)base + off + bj * 32 + 4)); } } }
            asm volatile("" ::: "memory");
#pragma unroll
            for (int m = 0; m < 4; ++m) { const int row = row0 + ai * HALF + m * 16; const size_t off = (size_t)row * D + col0; float s = 0.f;
#pragma unroll
                for (int bj = 0; bj < 2; ++bj) {
                    const f32x4 v0 = acc[ai][bj][m][0] + xr[m][bj][0], v1 = acc[ai][bj][m][1] + xr[m][bj][1];
                    *(u32x4*)(XBo + off + bj * 32) = pack8(v0, v1);
                    s += ((v0[0] * v0[0] + v0[1] * v0[1]) + (v0[2] * v0[2] + v0[3] * v0[3])) + ((v1[0] * v1[0] + v1[1] * v1[1]) + (v1[2] * v1[2] + v1[3] * v1[3])); }
                s += __shfl_xor(s, 16); s += __shfl_xor(s, 32);
                if (fq == 0) SSQo[(size_t)row * 16 + u.pn * 4 + wc] = s; }
            asm volatile("" ::: "memory"); }
    }
};
struct EpiXq {
    static constexpr bool KSEG = false;
    const float *SSQ2, *xg_q; bf16_t* QX;
    __device__ __forceinline__ void kseg(Acc&, const Unit&, int, int, int, LAS unsigned char*) const {}
    __device__ __forceinline__ void prepare(LAS unsigned char* xl, const Unit& u, int tid) const {
        if (tid < 256) ((LAS float*)(xl + 4096))[tid] = rsqrtf(sum16(SSQ2 + (size_t)(u.pm * BM + tid) * 16) * (1.f / 1024.f) + EPS); }
    __device__ __forceinline__ void run(Acc& acc, const Unit& u, int wr, int wc, int fr, int fq, LAS unsigned char* xl, int lane) const {
        const int row0 = u.pm * BM + wr * 64 + fr, colw = wc * 64 + 8 * fq;
        float tot[2][4];
        row_ssq256(acc, wr, wc, fr, fq, xl, tot);
        f32x4 g[2][2];
#pragma unroll
        for (int bj = 0; bj < 2; ++bj)
#pragma unroll
            for (int n = 0; n < 2; ++n) g[bj][n] = *(const f32x4*)(xg_q + colw + bj * 32 + n * 4);
#pragma unroll
        for (int ai = 0; ai < 2; ++ai)
#pragma unroll
            for (int m = 0; m < 4; ++m) { const int row = row0 + ai * HALF + m * 16;
                const float rs2 = ((const LAS float*)(xl + 4096))[wr * 64 + fr + ai * HALF + m * 16];
                const float rs = rs2 * rsqrtf(tot[ai][m] * rs2 * rs2 * (1.f / 256.f) + EPS) * CX2;
                bf16_t* rowp = QX + (size_t)row * D + u.pn * 256 + colw;
#pragma unroll
                for (int bj = 0; bj < 2; ++bj) *(u32x4*)(rowp + bj * 32) = pack8(acc[ai][bj][m][0] * rs * g[bj][0], acc[ai][bj][m][1] * rs * g[bj][1]); }
    }
};
struct EpiUp {
    static constexpr bool KSEG = false;
    const float* SSQ3; bf16_t* HB;
    __device__ __forceinline__ void kseg(Acc&, const Unit&, int, int, int, LAS unsigned char*) const {}
    __device__ __forceinline__ void prepare(LAS unsigned char* xl, const Unit& u, int tid) const {
        if (tid < 256) ((LAS float*)(xl + 4096))[tid] = rsqrtf(sum16(SSQ3 + (size_t)(u.pm * BM + tid) * 16) * (1.f / 1024.f) + EPS); }
    __device__ __forceinline__ void run(Acc& acc, const Unit& u, int wr, int wc, int fr, int fq, LAS unsigned char* xl, int lane) const {
        const int row0 = u.pm * BM + wr * 64 + fr, colw = wc * 64 + 8 * fq;
#pragma unroll
        for (int ai = 0; ai < 2; ++ai)
#pragma unroll
            for (int m = 0; m < 4; ++m) { const int row = row0 + ai * HALF + m * 16;
                const float rs = ((const LAS float*)(xl + 4096))[wr * 64 + fr + ai * HALF + m * 16];
                bf16_t* rowp = HB + (size_t)row * FF + u.pn * 256 + colw;
#pragma unroll
                for (int bj = 0; bj < 2; ++bj) { f32x4 v0 = acc[ai][bj][m][0] * rs, v1 = acc[ai][bj][m][1] * rs;
#pragma unroll
                    for (int e = 0; e < 4; ++e) { const float a = fmaxf(v0[e], 0.f), b = fmaxf(v1[e], 0.f); v0[e] = a * a; v1[e] = b * b; }
                    *(u32x4*)(rowp + bj * 32) = pack8(v0, v1); } }
    }
};
struct EpiDown {
    static constexpr bool KSEG = false;
    const bf16_t* X2B; float* out;
    __device__ __forceinline__ void kseg(Acc&, const Unit&, int, int, int, LAS unsigned char*) const {}
    __device__ __forceinline__ void prepare(LAS unsigned char*, const Unit&, int) const {}
    __device__ __forceinline__ void run(Acc& acc, const Unit& u, int wr, int wc, int fr, int fq, LAS unsigned char* xl, int lane) const {
        const int row0 = u.pm * BM + wr * 64 + fr, col0 = u.pn * 256 + wc * 64 + 8 * fq;
#pragma unroll
        for (int ai = 0; ai < 2; ++ai) {
            u32x4 w[4][2];
#pragma unroll
            for (int m = 0; m < 4; ++m)
#pragma unroll
                for (int bj = 0; bj < 2; ++bj) w[m][bj] = *(const u32x4*)(X2B + (size_t)(row0 + ai * HALF + m * 16) * D + col0 + bj * 32);
            asm volatile("" ::: "memory");
#pragma unroll
            for (int m = 0; m < 4; ++m) { const size_t off = (size_t)(row0 + ai * HALF + m * 16) * D + col0;
#pragma unroll
                for (int bj = 0; bj < 2; ++bj) { const u32x4 ww = w[m][bj];
                    const f32x4 x0 = (f32x4){__uint_as_float(ww.x << 16), __uint_as_float(ww.x & 0xffff0000u), __uint_as_float(ww.y << 16), __uint_as_float(ww.y & 0xffff0000u)};
                    const f32x4 x1 = (f32x4){__uint_as_float(ww.z << 16), __uint_as_float(ww.z & 0xffff0000u), __uint_as_float(ww.w << 16), __uint_as_float(ww.w & 0xffff0000u)};
                    *(f32x4*)(out + off + bj * 32) = acc[ai][bj][m][0] + x0; *(f32x4*)(out + off + bj * 32 + 4) = acc[ai][bj][m][1] + x1; } }
            asm volatile("" ::: "memory"); }
    }
};
}

namespace attn_body {
using bf16=__hip_bfloat16;
using bf16x8=__attribute__((ext_vector_type(8)))short;
using s16x4=__attribute__((ext_vector_type(4)))short;
using f32x16=__attribute__((ext_vector_type(16)))float;
using u32x4=__attribute__((ext_vector_type(4)))unsigned;
using f32x4_t=__attribute__((ext_vector_type(4)))float;
constexpr int BATCH=8,NHEAD=16,SEQ=2048,D=64,DM=NHEAD*D,OPITCH=2048,OCOL0=1024;
constexpr int NW=8,QBLK=32,QB=QBLK*NW,KVBLK=64,NQB=SEQ/QB;
constexpr int ATTN_PITCH=DM, ATTN_UNIT_ROWS=QB;
__device__ __forceinline__ int crow(int r,int hi){return (r&3)+8*(r>>2)+4*hi;}
#define SBAR() __builtin_amdgcn_sched_barrier(0)
__device__ __forceinline__ void cmask(f32x16&p0,f32x16&p1,int jb,int qrel,int hi){
  const float NEG=-INFINITY; int kb=64*jb+4*hi;
  #pragma unroll
  for(int r=0;r<16;++r){int kv=kb+(r&3)+8*(r>>2); if(kv>qrel)p0[r]=NEG; if(kv+32>qrel)p1[r]=NEG;}
}

constexpr int NSLOT=3, SLOTB=8192;
constexpr int LDS_K=0, LDS_V=NSLOT*SLOTB, LDS_WS=2*NSLOT*SLOTB, LDS_OST=LDS_WS+NW*64*4, LDS_CBL=LDS_OST+NW*4096, LDS_BYTES=LDS_CBL+SEQ*4;
__device__ __forceinline__ void glds16(const void*sbase,unsigned voff,unsigned lds_dst){unsigned keep;
  asm volatile("s_mov_b32 %0, m0\n\ts_mov_b32 m0, %2\n\ts_nop 4\n\tglobal_load_lds_dwordx4 %1, %3\n\ts_mov_b32 m0, %0":"=&s"(keep):"v"(voff),"s"(lds_dst),"s"(sbase):"memory");}
__device__ __forceinline__ float max3f(float a,float b,float c){float r;asm("v_max3_f32 %0, %1, %2, %3":"=v"(r):"v"(a),"v"(b),"v"(c));return r;}
__device__ __forceinline__ float max2f(float a,float b){float r;asm("v_max_f32_e32 %0, %1, %2":"=v"(r):"v"(a),"v"(b));return r;}
__device__ __forceinline__ float fadd_s(float a,float b){float r;asm("v_add_f32_e32 %0, %1, %2":"=v"(r):"v"(a),"v"(b));return r;}
__device__ __forceinline__ float fsub_s(float a,float b){float r;asm("v_sub_f32_e32 %0, %1, %2":"=v"(r):"v"(a),"v"(b));return r;}
typedef float f32x2_t __attribute__((ext_vector_type(2))); typedef __bf16 bf16x2_t __attribute__((ext_vector_type(2)));
__device__ __forceinline__ unsigned cvtpk_s(float lo,float hi){f32x2_t v={lo,hi};bf16x2_t b=__builtin_convertvector(v,bf16x2_t);return __builtin_bit_cast(unsigned,b);}
#define WAIT_BAR(N) asm volatile("s_waitcnt vmcnt(" #N ") lgkmcnt(0)\n\ts_barrier":::"memory")

__device__ __forceinline__ void qkt(f32x16&p0,f32x16&p1,const char*Kslot,const bf16x8*qr,int r32,int hi){
  const char*kb=Kslot+hi*1024+r32*16;
  #pragma unroll
  for(int d0=0;d0<4;++d0){
    const bf16x8 b0=*reinterpret_cast<const bf16x8*>(kb+d0*2048);
    const bf16x8 b1=*reinterpret_cast<const bf16x8*>(kb+d0*2048+512);
    p0=__builtin_amdgcn_mfma_f32_32x32x16_bf16(b0,qr[d0],p0,0,0,0);p1=__builtin_amdgcn_mfma_f32_32x32x16_bf16(b1,qr[d0],p1,0,0,0);}
}
typedef __attribute__((address_space(3))) const char* lds_cptr;
typedef short v4i16_t __attribute__((ext_vector_type(4)));
__device__ __forceinline__ void kload8(bf16x8*kf,lds_cptr kp){
  kf[0]=*(const __attribute__((address_space(3))) bf16x8*)(kp);      kf[1]=*(const __attribute__((address_space(3))) bf16x8*)(kp+512);
  kf[2]=*(const __attribute__((address_space(3))) bf16x8*)(kp+2048); kf[3]=*(const __attribute__((address_space(3))) bf16x8*)(kp+2560);
  kf[4]=*(const __attribute__((address_space(3))) bf16x8*)(kp+4096); kf[5]=*(const __attribute__((address_space(3))) bf16x8*)(kp+4608);
  kf[6]=*(const __attribute__((address_space(3))) bf16x8*)(kp+6144); kf[7]=*(const __attribute__((address_space(3))) bf16x8*)(kp+6656);
}
__device__ __forceinline__ void kload2(bf16x8*kf,lds_cptr kp,int j){ kf[2*j]=*(const __attribute__((address_space(3))) bf16x8*)(kp+j*2048); kf[2*j+1]=*(const __attribute__((address_space(3))) bf16x8*)(kp+j*2048+512); }
__device__ __forceinline__ s16x4 vtr(lds_cptr p){ return __builtin_bit_cast(s16x4,__builtin_amdgcn_ds_read_tr16_b64_v4i16((__attribute__((address_space(3))) v4i16_t*)p)); }
__device__ __forceinline__ float rowmax(const f32x16&p0,const f32x16&p1){
  float a=max3f(p0[0],p0[1],p1[0]),b=max3f(p0[2],p0[3],p1[1]);a=max3f(a,p1[2],p1[3]);
  #pragma unroll
  for(int r=4;r<16;r+=4){a=max3f(a,p0[r],p0[r+1]);b=max3f(b,p0[r+2],p0[r+3]);a=max3f(a,p1[r],p1[r+1]);b=max3f(b,p1[r+2],p1[r+3]);}
  const float m=max2f(a,b);
  auto rr=__builtin_amdgcn_permlane32_swap(__float_as_uint(m),__float_as_uint(m),false,false);
  return max2f(__uint_as_float(rr[0]),__uint_as_float(rr[1]));
}
__device__ __forceinline__ void pv(f32x16*o,int vb,bf16x8 pa0,bf16x8 pa1,bf16x8 pa2,bf16x8 pa3){
  #pragma unroll
  for(int d0=0;d0<2;++d0){s16x4 lo[4],hi[4];
    #pragma unroll
    for(int ks=0;ks<4;++ks){
      asm volatile("ds_read_b64_tr_b16 %0,%1 offset:%c2":"=&v"(lo[ks]):"v"(vb),"i"(d0*4096+ks*1024):"memory");
      asm volatile("ds_read_b64_tr_b16 %0,%1 offset:%c2":"=&v"(hi[ks]):"v"(vb),"i"(d0*4096+ks*1024+512):"memory");}
    asm volatile("s_waitcnt lgkmcnt(0)":::"memory");SBAR();
    #define PK(k) (bf16x8){lo[k][0],lo[k][1],lo[k][2],lo[k][3],hi[k][0],hi[k][1],hi[k][2],hi[k][3]}
    o[d0]=__builtin_amdgcn_mfma_f32_32x32x16_bf16(pa0,PK(0),o[d0],0,0,0);
    o[d0]=__builtin_amdgcn_mfma_f32_32x32x16_bf16(pa1,PK(1),o[d0],0,0,0);
    o[d0]=__builtin_amdgcn_mfma_f32_32x32x16_bf16(pa2,PK(2),o[d0],0,0,0);
    o[d0]=__builtin_amdgcn_mfma_f32_32x32x16_bf16(pa3,PK(3),o[d0],0,0,0);
    #undef PK
  }
}

#ifndef ATTN_STORE16
#define ATTN_STORE16(p,v) (*(u32x4*)(p)=(v))
#endif
template<int THRL> __device__ __forceinline__ void attn_unit(int b,int h,int qb,const bf16*Q,const bf16*__restrict__ K,const bf16*__restrict__ V,bf16*O,char*shm,int&r0,const bool pre,const bool pre_next){
  const int tid=threadIdx.x,lane=tid&63,r32=lane&31,hi=lane>>5; const int wid=__builtin_amdgcn_readfirstlane(tid>>6);
  const long rowbase=(long)b*SEQ; const int q0=qb*QB;
  const bf16*Qw=Q+(rowbase+q0+wid*QBLK)*DM+h*D;
  const bf16*Kh=K+rowbase*DM+h*D,*Vh=V+rowbase*DM+h*D;
  const unsigned lds0=(unsigned)(uintptr_t)shm;
  float*wsf=(float*)(shm+LDS_WS)+wid*64;
  const unsigned koff=(unsigned)((lane*DM+wid*8)*2);
  const unsigned voff=(unsigned)(((16*(wid&3)+(lane>>2))*DM+(wid>>2)*32+(lane&3)*8)*2);
  const unsigned kdst=lds0+LDS_K+wid*1024, vdst=lds0+LDS_V+wid*1024;
  #define DMA_K(t,slot) glds16(Kh+(long)(t)*KVBLK*DM,koff,(unsigned)__builtin_amdgcn_readfirstlane(kdst+(slot)))
  #define DMA_V(t,slot) glds16(Vh+(long)(t)*KVBLK*DM,voff,(unsigned)__builtin_amdgcn_readfirstlane(vdst+(slot)))
  const int vb0=(int)(lds0+LDS_V)+((lane>>4)&1)*32+(lane&3)*8+(4*hi+((lane&15)>>2))*64;
  const char*Kbase=shm+LDS_K; bf16x8 kf[8];
  const lds_cptr shm3=(lds_cptr)shm; const lds_cptr kp0=shm3+LDS_K+hi*1024+r32*16; const lds_cptr vp0=shm3+LDS_V+((lane>>4)&1)*32+(lane&3)*8+(4*hi+((lane&15)>>2))*64;
  const int NT=(q0+QB)/KVBLK;
  const int s0=r0*SLOTB, s1=(r0==2?0:r0+1)*SLOTB, s2=(r0==0?2:r0-1)*SLOTB;
  if(!pre){ DMA_K(0,s0);DMA_V(0,s0);DMA_K(1,s1); }
  bf16x8 qr[4];
  #pragma unroll
  for(int d0=0;d0<4;++d0)qr[d0]=*reinterpret_cast<const bf16x8*>(&Qw[(long)r32*DM+d0*16+hi*8]);
  float mhat=0.f,l_reg=0.f;f32x16 o[2];o[0]=f32x16{};o[1]=f32x16{};
  const int qrel=wid*QBLK+r32;
  #define CMASK(P0,P1,t) do{int jb_=(t)-(NT-4); if(jb_>=0)cmask(P0,P1,jb_,qrel,hi);}while(0)
  typedef __attribute__((address_space(3))) const f32x4_t* lds_f4p;
  #define CIN(C0,C1,t) do{ const float nm_=-mhat; const lds_f4p cp_=(lds_f4p)(shm3+LDS_CBL+(t)*256+hi*16); \
    const f32x4_t b0_=cp_[0],b1_=cp_[2],b2_=cp_[4],b3_=cp_[6],b4_=cp_[8],b5_=cp_[10],b6_=cp_[12],b7_=cp_[14]; \
    _Pragma("unroll") for(int e_=0;e_<4;++e_){ C0[e_]=nm_-b0_[e_]; C0[4+e_]=nm_-b1_[e_]; C0[8+e_]=nm_-b2_[e_]; C0[12+e_]=nm_-b3_[e_]; C1[e_]=nm_-b4_[e_]; C1[4+e_]=nm_-b5_[e_]; C1[8+e_]=nm_-b6_[e_]; C1[12+e_]=nm_-b7_[e_]; } \
    asm volatile("":"+v"(C0),"+v"(C1)); }while(0)
  bool resc=false;
  #define START(P0,P1) do{ const float rm=rowmax(P0,P1); resc=false; \
    { const float dl=rm; mhat=fadd_s(mhat,dl); \
      _Pragma("unroll") for(int r=0;r<16;++r){P0[r]=fsub_s(P0[r],dl);P1[r]=fsub_s(P1[r],dl);} } \
    _Pragma("unroll") for(int r=0;r<16;++r)P0[r]=__builtin_amdgcn_exp2f(P0[r]); }while(0)
  #define RESC() do{ if(resc){ asm volatile("s_waitcnt lgkmcnt(0)":::"memory"); \
      _Pragma("unroll") for(int d_=0;d_<2;++d_) _Pragma("unroll") for(int r=0;r<16;++r)o[d_][r]*=wsf[crow(r,hi)]; } }while(0)
  f32x16 pA0,pA1,pB0,pB1;
  int sl_prev=s0,sl_cur=s0,sl_next=s1;
  #define ROT() do{sl_prev=sl_cur;sl_cur=sl_next;sl_next=(sl_next==(NSLOT-1)*SLOTB)?0:sl_next+SLOTB;}while(0)
  if(!pre){ DMA_K(2,s2); }
  WAIT_BAR(3);
  CIN(pA0,pA1,0);
  qkt(pA0,pA1,Kbase+s0,qr,r32,hi);asm volatile("s_nop 15\n\ts_nop 7":"+v"(pA0),"+v"(pA1));CMASK(pA0,pA1,0);
  START(pA0,pA1);
  _Pragma("unroll") for(int r=0;r<16;++r)pA1[r]=__builtin_amdgcn_exp2f(pA1[r]);
  WAIT_BAR(0);
  DMA_K(3,s0);DMA_V(1,s1);
  ROT();
  kload8(kf,kp0+sl_cur);
  WAIT_BAR(2);
  s16x4 vlo[8],vhi[8]; u32x4 pw0,pw1,pw2,pw3;
  #define PKW(P,B) cvtpk_s(P[B],P[B+1])
  #define PAF(k) __builtin_bit_cast(bf16x8,pw##k)
  #define VFR(i) (bf16x8){vlo[i][0],vlo[i][1],vlo[i][2],vlo[i][3],vhi[i][0],vhi[i][1],vhi[i][2],vhi[i][3]}
  #define PIN(x) asm volatile("":"+v"(x))
  #define MX3(a,b,c) __builtin_fmaxf(__builtin_fmaxf((a),(b)),(c))
  #define GAPA(MF,A0,A1,A2,A3,W0,W1,PW) do{ MF; sacc+=A0; sacc+=A1; sacc+=A2; sacc+=A3; PIN(sacc); W0; W1; PIN(PW); SBAR(); }while(0)
  #define EX(v) __builtin_amdgcn_exp2f(v)
  #define GAPB(MF,X,B) do{ MF; X[B]=EX(X[B]); X[B+1]=EX(X[B+1]); X[B+2]=EX(X[B+2]); X[B+3]=EX(X[B+3]); PIN(X); SBAR(); }while(0)
  #define VRD(i) do{ vlo[i]=vtr(vp_+(((i)>>2)*4096+((i)&3)*1024)); vhi[i]=vtr(vp_+(((i)>>2)*4096+((i)&3)*1024+512)); }while(0)
  #define KRD(G,j) do{ if(G){ kload2(kf,kp0+sl_next,j); SBAR(); } }while(0)
  #define STEP(C0,C1,P0,P1,t,GK,GV,GL) do{ SBAR(); CIN(C0,C1,t); SBAR(); \
    const lds_cptr vp_=vp0+sl_prev; \
    VRD(0); SBAR(); float sacc=(P0[0]+P0[1]); \
    GAPA(C0=__builtin_amdgcn_mfma_f32_32x32x16_bf16(kf[0],qr[0],C0,0,0,0), P0[2],P0[3],P0[4],P0[5],     pw0[0]=PKW(P0,0), pw0[1]=PKW(P0,2), pw0); \
    VRD(4); SBAR(); GAPA(C1=__builtin_amdgcn_mfma_f32_32x32x16_bf16(kf[1],qr[0],C1,0,0,0), P0[6],P0[7],P0[8],P0[9],     pw0[2]=PKW(P0,4), pw0[3]=PKW(P0,6), pw0); \
    VRD(1); SBAR(); GAPA(C0=__builtin_amdgcn_mfma_f32_32x32x16_bf16(kf[2],qr[1],C0,0,0,0),   P0[10],P0[11],P0[12],P0[13], pw1[0]=PKW(P0,8), pw1[1]=PKW(P0,10), pw1); \
    VRD(5); SBAR(); GAPA(C1=__builtin_amdgcn_mfma_f32_32x32x16_bf16(kf[3],qr[1],C1,0,0,0),   P0[14],P0[15],P1[0],P1[1],   pw1[2]=PKW(P0,12),pw1[3]=PKW(P0,14), pw1); \
    VRD(2); SBAR(); GAPA(C0=__builtin_amdgcn_mfma_f32_32x32x16_bf16(kf[4],qr[2],C0,0,0,0),   P1[2],P1[3],P1[4],P1[5],     pw2[0]=PKW(P1,0), pw2[1]=PKW(P1,2), pw2); \
    VRD(6); SBAR(); GAPA(C1=__builtin_amdgcn_mfma_f32_32x32x16_bf16(kf[5],qr[2],C1,0,0,0),   P1[6],P1[7],P1[8],P1[9],     pw2[2]=PKW(P1,4), pw2[3]=PKW(P1,6), pw2); \
    VRD(3); SBAR(); GAPA(C0=__builtin_amdgcn_mfma_f32_32x32x16_bf16(kf[6],qr[3],C0,0,0,0),   P1[10],P1[11],P1[12],P1[13], pw3[0]=PKW(P1,8), pw3[1]=PKW(P1,10), pw3); \
    VRD(7); SBAR(); GAPA(C1=__builtin_amdgcn_mfma_f32_32x32x16_bf16(kf[7],qr[3],C1,0,0,0),   P1[14],P1[15],0.f,0.f,       pw3[2]=PKW(P1,12),pw3[3]=PKW(P1,14), pw3); \
    l_reg+=sacc; \
    if(GK){DMA_K((t)+3,sl_cur);} if(GV){DMA_V((t)+1,sl_next);} \
    CMASK(C0,C1,t); \
    { float a=MX3(C0[0],C0[1],C1[0]),b=MX3(C0[2],C0[3],C1[1]); a=MX3(a,C1[2],C1[3]); \
      _Pragma("unroll") for(int r=4;r<16;r+=4){a=MX3(a,C0[r],C0[r+1]);b=MX3(b,C0[r+2],C0[r+3]);a=MX3(a,C1[r],C1[r+1]);b=MX3(b,C1[r+2],C1[r+3]);} \
      float rm=__builtin_fmaxf(a,b); { auto rr=__builtin_amdgcn_permlane32_swap(__float_as_uint(rm),__float_as_uint(rm),false,false); rm=__builtin_fmaxf(__uint_as_float(rr[0]),__uint_as_float(rr[1])); } \
      resc=false; \
      if(__builtin_expect(__any(rm>(float)THRL),0)){ const float dl=__builtin_fmaxf(rm,0.f); mhat+=dl; \
        _Pragma("unroll") for(int r=0;r<16;++r){C0[r]-=dl;C1[r]-=dl;} \
        const float f=__builtin_amdgcn_exp2f(-dl); l_reg*=f; if(hi==0)wsf[r32]=f; resc=true; } } \
    SBAR(); \
    GAPB(o[0]=__builtin_amdgcn_mfma_f32_32x32x16_bf16(PAF(0),VFR(0),o[0],0,0,0), C0,0); \
    GAPB(o[1]=__builtin_amdgcn_mfma_f32_32x32x16_bf16(PAF(0),VFR(4),o[1],0,0,0), C0,4); \
    KRD(GL,0); GAPB(o[0]=__builtin_amdgcn_mfma_f32_32x32x16_bf16(PAF(1),VFR(1),o[0],0,0,0), C0,8); \
    KRD(GL,1); GAPB(o[1]=__builtin_amdgcn_mfma_f32_32x32x16_bf16(PAF(1),VFR(5),o[1],0,0,0), C0,12); \
    KRD(GL,2); GAPB(o[0]=__builtin_amdgcn_mfma_f32_32x32x16_bf16(PAF(2),VFR(2),o[0],0,0,0), C1,0); \
    KRD(GL,3); GAPB(o[1]=__builtin_amdgcn_mfma_f32_32x32x16_bf16(PAF(2),VFR(6),o[1],0,0,0), C1,4); \
    GAPB(o[0]=__builtin_amdgcn_mfma_f32_32x32x16_bf16(PAF(3),VFR(3),o[0],0,0,0), C1,8); \
    GAPB(o[1]=__builtin_amdgcn_mfma_f32_32x32x16_bf16(PAF(3),VFR(7),o[1],0,0,0), C1,12); \
    }while(0)
  int t=1;
  #undef CMASK
  #define CMASK(P0,P1,t) do{}while(0)
  for(;t+5<NT;t+=2){
    STEP(pB0,pB1,pA0,pA1,t,true,true,true);     WAIT_BAR(2); RESC(); ROT();
    STEP(pA0,pA1,pB0,pB1,t+1,true,true,true);   WAIT_BAR(2); RESC(); ROT();
  }
  #undef CMASK
  #define CMASK(P0,P1,t) do{int jb_=(t)-(NT-4); if(jb_>=0)cmask(P0,P1,jb_,qrel,hi);}while(0)
  #define ENDW(tt) do{ if((tt)+3<NT){WAIT_BAR(2);} else if((tt)+2<NT){WAIT_BAR(1);} else {WAIT_BAR(0);} }while(0)
  for(;t+1<NT;t+=2){
    STEP(pB0,pB1,pA0,pA1,t,(t+3<NT),(t+1<NT),(t+1<NT));       ENDW(t);   RESC(); ROT();
    STEP(pA0,pA1,pB0,pB1,t+1,(t+4<NT),(t+2<NT),(t+2<NT));     ENDW(t+1); RESC(); ROT();
  }
  STEP(pB0,pB1,pA0,pA1,NT-1,false,false,false); RESC();
  { const int rn=(r0+NT)%3;
    if(pre_next){ const int n0=rn*SLOTB, n1=(rn==2?0:rn+1)*SLOTB, n2=(rn==0?2:rn-1)*SLOTB;
      DMA_K(0,n0);DMA_V(0,n0);DMA_K(1,n1);DMA_K(2,n2); }
    r0=rn; }
  { float sacc=pB0[0]+pB0[1]; _Pragma("unroll") for(int r=2;r<16;++r)sacc+=pB0[r]; _Pragma("unroll") for(int r=0;r<16;++r)sacc+=pB1[r]; l_reg+=sacc;
    pw0=(u32x4){PKW(pB0,0),PKW(pB0,2),PKW(pB0,4),PKW(pB0,6)};pw1=(u32x4){PKW(pB0,8),PKW(pB0,10),PKW(pB0,12),PKW(pB0,14)};pw2=(u32x4){PKW(pB1,0),PKW(pB1,2),PKW(pB1,4),PKW(pB1,6)};pw3=(u32x4){PKW(pB1,8),PKW(pB1,10),PKW(pB1,12),PKW(pB1,14)};
    SBAR(); pv(o,vb0+sl_cur,PAF(0),PAF(1),PAF(2),PAF(3)); }
  #undef PKW
  #undef PAF
  #undef VFR
  #undef PIN
  #undef MX3
  #undef GAPA
  #undef GAPB
  #undef EX
  #undef VRD
  #undef KRD
  #undef STEP
  #undef ENDW
  {auto rr=__builtin_amdgcn_permlane32_swap(__float_as_uint(l_reg),__float_as_uint(l_reg),false,false);l_reg=__uint_as_float(rr[0])+__uint_as_float(rr[1]);}
  if(hi==0)wsf[32+r32]=l_reg;asm volatile("s_waitcnt lgkmcnt(0)":::"memory");
  float rli[16];
  #pragma unroll
  for(int r=0;r<16;++r)rli[r]=__builtin_amdgcn_rcpf(wsf[32+crow(r,hi)]);
  bf16*Ow=O+(rowbase+q0+wid*QBLK)*OPITCH+OCOL0+h*D;
  { bf16*stg=(bf16*)(shm+LDS_OST)+wid*2048;
    #pragma unroll
    for(int r=0;r<16;++r){const int orow=crow(r,hi);
      #pragma unroll
      for(int d0=0;d0<2;++d0)stg[orow*64+d0*32+r32]=__float2bfloat16(o[d0][r]*rli[r]);}
    asm volatile("s_waitcnt lgkmcnt(0)":::"memory");
    #pragma unroll
    for(int i=0;i<4;++i){const int row=i*8+(lane>>3),ch=lane&7; const u32x4 v=*(const u32x4*)(stg+row*64+ch*8); ATTN_STORE16(Ow+(long)row*OPITCH+ch*8,v);} }
  asm volatile("s_waitcnt lgkmcnt(0)\n\ts_barrier":::"memory");
  #undef DMA_K
  #undef DMA_V
  #undef CMASK
  #undef START
  #undef RESC
  #undef ROT
  #undef CIN
}
constexpr int ATTN_LDS_BYTES=LDS_BYTES;
struct AttnTensors { const bf16* Q; const bf16* K; const bf16* V; bf16* O; };
struct AttnUnit { int bh; int qb; };
struct StaticOrder {
  int vcu;
  __device__ __forceinline__ explicit StaticOrder(int v):vcu(v){}
  __device__ __forceinline__ bool next(int i,AttnUnit&u)const{ u.bh=vcu>>1;
    if((vcu&1)==0){ if(i>=2)return false; u.qb=(i==0)?6:2; }
    else { if(i>=6)return false; u.qb=(i==0)?7:(i==1)?5:(i==2)?4:(i==3)?3:(i==4)?1:0; }
    return true; }
  __device__ __forceinline__ void a_ready(const AttnUnit&)const{}
  __device__ __forceinline__ void done(const AttnUnit&)const{}
};
struct AttnTensorsB { const bf16* Q; const bf16* K; const bf16* V; bf16* O; const float* CB; };
template<class Sched,int THRL=20> __device__ __forceinline__ void attn_phase(char*lds,const AttnTensorsB&T,const Sched&S){
  AttnUnit u; int cur_bh=-1; int r0=0; bool pre=false;
  for(int i=0;S.next(i,u);++i){ S.a_ready(u);
    if(u.bh!=cur_bh){ cur_bh=u.bh; float*cbl=(float*)(lds+LDS_CBL); const float*src=T.CB+(size_t)u.bh*SEQ;
      int j0=threadIdx.x; asm volatile("":"+v"(j0));
      for(int j=j0;j<SEQ/4;j+=NW*64) ((f32x4_t*)cbl)[j]=((const f32x4_t*)src)[j];
      __syncthreads(); }
    AttnUnit un; const bool has_next=S.next(i+1,un)&&un.bh==u.bh;
    attn_unit<THRL>(u.bh/NHEAD,u.bh%NHEAD,u.qb,T.Q,T.K,T.V,T.O,lds,r0,pre,has_next); pre=has_next; S.done(u); }
}
#undef SBAR
#undef WAIT_BAR
}

namespace xattn {
typedef short bf16x8 __attribute__((ext_vector_type(8)));
typedef short s16x4 __attribute__((ext_vector_type(4)));
typedef short v4i16_t __attribute__((ext_vector_type(4)));
typedef float f32x16 __attribute__((ext_vector_type(16)));
typedef unsigned u32x4 __attribute__((ext_vector_type(4)));
constexpr int LDS_KV = 0, LDS_OST = 131072, LDS_WSF = LDS_OST + 8 * 2048, LDS_BYTES = LDS_WSF + 8 * 256;
__device__ __forceinline__ int crow(int r, int hi) { return (r & 3) + 8 * (r >> 2) + 4 * hi; }
__device__ __forceinline__ unsigned cvtpk(float lo, float hi) { typedef float f2 __attribute__((ext_vector_type(2))); typedef __bf16 b2 __attribute__((ext_vector_type(2))); f2 v = {lo, hi}; b2 b = __builtin_convertvector(v, b2); return __builtin_bit_cast(unsigned, b); }
__device__ __forceinline__ void xattn_unit(const bf16_t* QX, const bf16_t* KX, const bf16_t* VX, bf16_t* OX, int b, int h, int qb, LAS unsigned char* lds) {
    const int tid = threadIdx.x, lane = tid & 63, r32 = lane & 31, hi = lane >> 5, wid = __builtin_amdgcn_readfirstlane(tid >> 6);
#pragma unroll
    for (int i = 0; i < 16; ++i) { const int p = wid * 16 + i, c = p >> 2, rg = p & 3;
        __builtin_amdgcn_global_load_lds((const unsigned*)(KX + (size_t)(b * MEML + rg * 64 + lane) * D + h * XHD + c * 8), (LAS unsigned*)(lds + LDS_KV + c * 4096 + rg * 1024), 16, 0, 0); }
    const size_t qrow0 = (size_t)b * SEQ + qb * 256 + wid * 32;
    bf16x8 qf[8];
#pragma unroll
    for (int s_ = 0; s_ < 8; ++s_) qf[s_] = *(const bf16x8*)(QX + (qrow0 + r32) * D + h * XHD + 16 * s_ + 8 * hi);
    asm volatile("s_waitcnt vmcnt(0)" ::: "memory"); __builtin_amdgcn_s_barrier(); asm volatile("" ::: "memory");
    f32x16 S[8];
#pragma unroll
    for (int kb = 0; kb < 8; ++kb) S[kb] = f32x16{};
#pragma unroll
    for (int half = 0; half < 2; ++half) {
        if (half == 1) {
#pragma unroll
            for (int s_ = 0; s_ < 8; ++s_) qf[s_] = *(const bf16x8*)(QX + (qrow0 + r32) * D + h * XHD + 16 * (8 + s_) + 8 * hi);
        }
#pragma unroll
        for (int s_ = 0; s_ < 8; ++s_) { bf16x8 kf[8];
#pragma unroll
            for (int kb = 0; kb < 8; ++kb) kf[kb] = *(const LAS bf16x8*)(lds + LDS_KV + (2 * (8 * half + s_) + hi) * 4096 + (32 * kb + r32) * 16);
            __builtin_amdgcn_sched_barrier(0);
#pragma unroll
            for (int kb = 0; kb < 8; ++kb) S[kb] = __builtin_amdgcn_mfma_f32_32x32x16_bf16(kf[kb], qf[s_], S[kb], 0, 0, 0);
            __builtin_amdgcn_sched_barrier(0); }
        asm volatile("" ::: "memory");
    }
    float mx = S[0][0];
#pragma unroll
    for (int kb = 0; kb < 8; ++kb)
#pragma unroll
        for (int r = 0; r < 16; ++r) mx = fmaxf(mx, S[kb][r]);
    { auto rr = __builtin_amdgcn_permlane32_swap(__float_as_uint(mx), __float_as_uint(mx), false, false); mx = fmaxf(__uint_as_float(rr[0]), __uint_as_float(rr[1])); }
    float l = 0.f;
#pragma unroll
    for (int kb = 0; kb < 8; ++kb)
#pragma unroll
        for (int r = 0; r < 16; ++r) { const float p = __builtin_amdgcn_exp2f(S[kb][r] - mx); S[kb][r] = p; l += p; }
    { auto rr = __builtin_amdgcn_permlane32_swap(__float_as_uint(l), __float_as_uint(l), false, false); l = __uint_as_float(rr[0]) + __uint_as_float(rr[1]); }
    u32x4 pw[16];
#pragma unroll
    for (int kb = 0; kb < 8; ++kb)
#pragma unroll
        for (int sp = 0; sp < 2; ++sp) { u32x4 w; w.x = cvtpk(S[kb][8 * sp + 0], S[kb][8 * sp + 1]); w.y = cvtpk(S[kb][8 * sp + 2], S[kb][8 * sp + 3]); w.z = cvtpk(S[kb][8 * sp + 4], S[kb][8 * sp + 5]); w.w = cvtpk(S[kb][8 * sp + 6], S[kb][8 * sp + 7]); pw[2 * kb + sp] = w; }
    asm volatile("s_waitcnt lgkmcnt(0)" ::: "memory"); __builtin_amdgcn_s_barrier(); asm volatile("" ::: "memory");
#pragma unroll
    for (int i = 0; i < 16; ++i) { const int p = wid * 16 + i, dblk = p >> 4, kg = p & 15;
        __builtin_amdgcn_global_load_lds((const unsigned*)(VX + (size_t)(b * MEML + kg * 16 + (lane >> 2)) * D + h * XHD + dblk * 32 + (lane & 3) * 8), (LAS unsigned*)(lds + LDS_KV + dblk * 16384 + kg * 1024), 16, 0, 0); }
    LAS float* wsf = (LAS float*)(lds + LDS_WSF) + wid * 64;
    if (hi == 0) wsf[r32] = l;
    asm volatile("s_waitcnt vmcnt(0) lgkmcnt(0)" ::: "memory"); __builtin_amdgcn_s_barrier(); asm volatile("" ::: "memory");
    float rli[16];
#pragma unroll
    for (int r = 0; r < 16; ++r) rli[r] = __builtin_amdgcn_rcpf(wsf[crow(r, hi)]);
    const LAS unsigned char* vb = lds + LDS_KV + ((lane >> 4) & 1) * 32 + (lane & 3) * 8 + (4 * hi + ((lane & 15) >> 2)) * 64;
    LAS bf16_t* stg = (LAS bf16_t*)(lds + LDS_OST + wid * 2048);
#pragma unroll 1
    for (int dblk = 0; dblk < 8; ++dblk) {
        f32x16 o = f32x16{};
#pragma unroll
        for (int kh = 0; kh < 2; ++kh) { bf16x8 vf[8];
#pragma unroll
            for (int k8 = 0; k8 < 8; ++k8) { const int ks = 8 * kh + k8;
                const s16x4 lo = __builtin_bit_cast(s16x4, __builtin_amdgcn_ds_read_tr16_b64_v4i16((LAS v4i16_t*)(vb + dblk * 16384 + ks * 1024)));
                const s16x4 hh = __builtin_bit_cast(s16x4, __builtin_amdgcn_ds_read_tr16_b64_v4i16((LAS v4i16_t*)(vb + dblk * 16384 + ks * 1024 + 512)));
                vf[k8] = (bf16x8){lo[0], lo[1], lo[2], lo[3], hh[0], hh[1], hh[2], hh[3]}; }
            __builtin_amdgcn_sched_barrier(0);
#pragma unroll
            for (int k8 = 0; k8 < 8; ++k8) o = __builtin_amdgcn_mfma_f32_32x32x16_bf16(__builtin_bit_cast(bf16x8, pw[8 * kh + k8]), vf[k8], o, 0, 0, 0);
            __builtin_amdgcn_sched_barrier(0); }
#pragma unroll
        for (int r = 0; r < 16; ++r) stg[crow(r, hi) * 32 + r32] = (bf16_t)f2bf(o[r] * rli[r]);
        asm volatile("s_waitcnt lgkmcnt(0)" ::: "memory");
#pragma unroll
        for (int i = 0; i < 2; ++i) { const int idx = lane + 64 * i, row = idx >> 2, ch = idx & 3; const u32x4 v = *(const LAS u32x4*)(stg + row * 32 + ch * 8);
            *(u32x4*)(OX + (qrow0 + row) * D + h * XHD + dblk * 32 + ch * 8) = v; }
        asm volatile("s_waitcnt lgkmcnt(0)" ::: "memory");
    }
    asm volatile("s_waitcnt lgkmcnt(0)" ::: "memory"); __builtin_amdgcn_s_barrier(); asm volatile("" ::: "memory");
}
}

namespace ssd {
typedef short bf16x8 __attribute__((ext_vector_type(8)));
typedef short s16x4 __attribute__((ext_vector_type(4)));
typedef short v4i16_t __attribute__((ext_vector_type(4)));
typedef float f32x16 __attribute__((ext_vector_type(16)));
typedef unsigned u32x4 __attribute__((ext_vector_type(4)));
typedef unsigned u32x2 __attribute__((ext_vector_type(2)));
constexpr int L_B = 0, L_C = 32768, L_XD = 65536, L_XDD = 81920, L_SIN = 98304, L_Y = 114688, L_A2 = 147456, L_FL = 147968  , L_DT = 150528, L_CW = 151040, LDS_BYTES = 152320;
__device__ __forceinline__ int crow(int r, int hi) { return (r & 3) + 8 * (r >> 2) + 4 * hi; }
__device__ __forceinline__ unsigned cvtpk(float lo, float hi) { typedef float f2 __attribute__((ext_vector_type(2))); typedef __bf16 b2 __attribute__((ext_vector_type(2))); f2 v = {lo, hi}; b2 b = __builtin_convertvector(v, b2); return __builtin_bit_cast(unsigned, b); }
__device__ __forceinline__ bf16x8 trpair(const LAS unsigned char* p, int second_off) {
    const s16x4 lo = __builtin_bit_cast(s16x4, __builtin_amdgcn_ds_read_tr16_b64_v4i16((LAS v4i16_t*)(p)));
    const s16x4 hh = __builtin_bit_cast(s16x4, __builtin_amdgcn_ds_read_tr16_b64_v4i16((LAS v4i16_t*)(p + second_off)));
    return (bf16x8){lo[0], lo[1], lo[2], lo[3], hh[0], hh[1], hh[2], hh[3]};
}
#define SSD_BAR() do { asm volatile("s_waitcnt lgkmcnt(0)" ::: "memory"); __builtin_amdgcn_s_barrier(); asm volatile("" ::: "memory"); } while (0)
__device__ __forceinline__ void ssd_item(const KAS Ptrs& P, int bh, LAS unsigned char* lds) {
    const int tid = threadIdx.x, lane = tid & 63, r32 = lane & 31, hi = lane >> 5, wid = __builtin_amdgcn_readfirstlane(tid >> 6);
    const int lb = wid < 4 ? (wid >> 1) : 3 - ((wid - 4) >> 1), pb = wid & 1, par = pb;
    const int b = bh / NH, h = bh % NH, g = h / 8;
    unsigned char* ws = P.ws;
    const bf16_t* XA = (const bf16_t*)((const unsigned char*)P.out + DO_BCA) + (size_t)b * SEQ * 512;
    const bf16_t* XRh = (const bf16_t*)((const unsigned char*)P.out + DO_XRAW) + (size_t)b * SEQ * 1024 + h * 64;
    const bf16_t* ZS = (const bf16_t*)(ws + WS_ZS) + (size_t)b * SEQ * 1024 + h * 64;
    const float* DTT = (const float*)(ws + WS_DTT) + (size_t)bh * SEQ; const float* ACS = (const float*)(ws + WS_ACS) + (size_t)bh * SEQ;
    bf16_t* MX = (bf16_t*)(ws + WS_MIXED) + (size_t)b * SEQ * MIXW + h * 64; float* SSQ = (float*)(ws + WS_SSQ) + (size_t)b * SEQ * 16 + h;
    const bf16_t* CBTw = (const bf16_t*)(ws + WS_CBT) + ((size_t)(b * NCH * NGRP + g) * 10 + lb * (lb + 1) / 2) * 64 * 16 + lane * 16;
    const float Dk = P.d_skip[h];
    f32x16 sacc = f32x16{};
    for (int i = tid; i < 16384 / 16; i += NTHR) ((LAS u32x4*)(lds + L_SIN))[i] = (u32x4){0u, 0u, 0u, 0u};
    if (tid < 320) ((LAS float*)(lds + L_CW))[tid] = tid < 256 ? P.conv_w[(tid >> 6) * CONVD + h * 64 + (tid & 63)] : P.conv_b[h * 64 + (tid & 63)];
    const int brow = tid & 127, bch0 = tid >> 7;
    const int srow0 = tid >> 4, sch = tid & 15;
#define SSD_IMG(row, ch) ((row) * 256 + ((((ch) ^ (row)) & 15) << 4))
    const int xr2 = tid >> 3, xpc = tid & 7;
    u32x4 pB[4], pC[4], pXr[5]; float pdt[2], pac[2], pa127 = 0.f, pas = 0.f, pdtb = 0.f;
    u32x4 ez0, ez1;
    const int el = tid >> 2, ep0 = (tid & 3) * 16;
#define SSD_PREFETCH(c) do { const int t0_ = (c) * CHUNK; \
        _Pragma("unroll") for (int i = 0; i < 4; ++i) { const bf16_t* rp = XA + (size_t)(t0_ + srow0 + 32 * i) * 512 + g * 128 + sch * 8; pB[i] = *(const u32x4*)rp; pC[i] = *(const u32x4*)(rp + 256); } \
        _Pragma("unroll") for (int j = 0; j < 5; ++j) { const int tr_ = t0_ + 2 * xr2 - 3 + j; pXr[j] = (u32x4){0u, 0u, 0u, 0u}; if (tr_ >= 0) pXr[j] = *(const u32x4*)(XRh + (size_t)tr_ * 1024 + xpc * 8); } \
        _Pragma("unroll") for (int i = 0; i < 2; ++i) { pdt[i] = DTT[t0_ + 2 * xr2 + i]; pac[i] = ACS[t0_ + 2 * xr2 + i]; } \
        pa127 = ACS[t0_ + 127]; pas = ACS[t0_ + brow]; pdtb = DTT[t0_ + brow]; } while (0)
#define SSD_WRITE() do { \
        _Pragma("unroll") for (int i = 0; i < 4; ++i) { const int off_ = SSD_IMG(srow0 + 32 * i, sch); *(LAS u32x4*)(lds + L_B + off_) = pB[i]; *(LAS u32x4*)(lds + L_C + off_) = pC[i]; } \
        { float xf_[5][8];   \
          _Pragma("unroll") for (int j = 0; j < 5; ++j) { const unsigned w_[4] = {pXr[j].x, pXr[j].y, pXr[j].z, pXr[j].w}; \
              _Pragma("unroll") for (int k = 0; k < 4; ++k) { xf_[j][2 * k] = __uint_as_float(w_[k] << 16); xf_[j][2 * k + 1] = __uint_as_float(w_[k] & 0xffff0000u); } } \
          float cw_[5][8]; _Pragma("unroll") for (int j = 0; j < 5; ++j) { const f32x4 a_ = *(const LAS f32x4*)(lds + L_CW + (j * 64 + xpc * 8) * 4), b_ = *(const LAS f32x4*)(lds + L_CW + (j * 64 + xpc * 8 + 4) * 4); \
              _Pragma("unroll") for (int k = 0; k < 4; ++k) { cw_[j][k] = a_[k]; cw_[j][4 + k] = b_[k]; } } \
          _Pragma("unroll") for (int i = 0; i < 2; ++i) { const int row = 2 * xr2 + i; const float s1 = pdt[i], s2 = s1 * __builtin_amdgcn_exp2f((pa127 - pac[i]) * LOG2E); \
            float xc_[8]; _Pragma("unroll") for (int k = 0; k < 8; ++k) xc_[k] = silu_f(cw_[4][k] + cw_[0][k] * xf_[i][k] + cw_[1][k] * xf_[i + 1][k] + cw_[2][k] * xf_[i + 2][k] + cw_[3][k] * xf_[i + 3][k]); \
            u32x4 o1, o2; unsigned r1[4], r2[4]; \
            _Pragma("unroll") for (int k = 0; k < 4; ++k) { r1[k] = cvtpk(xc_[2 * k] * s1, xc_[2 * k + 1] * s1); r2[k] = cvtpk(xc_[2 * k] * s2, xc_[2 * k + 1] * s2); } \
            o1 = (u32x4){r1[0], r1[1], r1[2], r1[3]}; o2 = (u32x4){r2[0], r2[1], r2[2], r2[3]}; \
            const int off = (xpc >> 2) * 8192 + (row >> 4) * 1024 + (row & 15) * 64 + (xpc & 3) * 16; \
            *(LAS u32x4*)(lds + L_XD + off) = o1; *(LAS u32x4*)(lds + L_XDD + off) = o2; } } \
        if (bch0 == (brow >> 5)) { ((LAS float*)(lds + L_A2))[brow] = pas * LOG2E; ((LAS float*)(lds + L_FL))[brow] = __builtin_amdgcn_exp2f(pas * LOG2E); ((LAS float*)(lds + L_DT))[brow] = pdtb; } } while (0)
    u32x4 pcb[2][2];
#pragma unroll
    for (int jb = 0; jb < 2; ++jb) { pcb[jb][0] = (u32x4){0u, 0u, 0u, 0u}; pcb[jb][1] = pcb[jb][0]; if (par + 2 * jb <= lb) { const bf16_t* cp = CBTw + (par + 2 * jb) * 64 * 16; pcb[jb][0] = *(const u32x4*)cp; pcb[jb][1] = *(const u32x4*)(cp + 8); } }
    SSD_BAR();
    SSD_PREFETCH(0); SSD_WRITE(); SSD_BAR();
    const int trbase = (4 * hi + ((lane & 15) >> 2)) * 64 + ((lane >> 4) & 1) * 32 + (lane & 3) * 8;
    const int nb = lb;
    const int btr_n = 32 * nb + 16 * ((lane >> 4) & 1) + 4 * (lane & 3);
    const int btr_l = 4 * hi + ((lane & 15) >> 2);
    const int btrb0 = SSD_IMG(btr_l, btr_n >> 3) + (btr_n & 7) * 2, btrb1 = SSD_IMG(btr_l + 8, btr_n >> 3) + (btr_n & 7) * 2;
#pragma unroll 1
    for (int c = 0; c < NCH; ++c) {
        if (c + 1 < NCH) SSD_PREFETCH(c + 1);
        { const size_t t = (size_t)c * CHUNK + el;
          ez0 = *(const u32x4*)(ZS + t * 1024 + ep0); ez1 = *(const u32x4*)(ZS + t * 1024 + ep0 + 8); }
        f32x16 yacc[2]; yacc[0] = f32x16{}; yacc[1] = f32x16{};
        { bf16x8 cfr[4], sfr[2][4];
#pragma unroll
          for (int k4 = 0; k4 < 4; ++k4) { const int kn = 4 * par + k4; cfr[k4] = *(const LAS bf16x8*)(lds + L_C + SSD_IMG(32 * lb + r32, 2 * kn + hi));
#pragma unroll
              for (int q = 0; q < 2; ++q) sfr[q][k4] = *(const LAS bf16x8*)(lds + L_SIN + (2 * kn + hi) * 1024 + (32 * q + r32) * 16); }
          __builtin_amdgcn_sched_barrier(0);
#pragma unroll
          for (int k4 = 0; k4 < 4; ++k4)
#pragma unroll
              for (int q = 0; q < 2; ++q) yacc[q] = __builtin_amdgcn_mfma_f32_32x32x16_bf16(cfr[k4], sfr[q][k4], yacc[q], 0, 0, 0);
#pragma unroll
          for (int g4 = 0; g4 < 4; ++g4) { const f32x4 ea = *(const LAS f32x4*)(lds + L_FL + (32 * lb + 8 * g4 + 4 * hi) * 4);
#pragma unroll
              for (int e_ = 0; e_ < 4; ++e_)
#pragma unroll
                  for (int q = 0; q < 2; ++q) yacc[q][4 * g4 + e_] *= ea[e_]; } }
        const float a2l = *(const LAS float*)(lds + L_A2 + (32 * lb + r32) * 4);
#pragma unroll
        for (int jb = 0; jb < 2; ++jb) { const int sb = par + 2 * jb; if (sb <= lb) {
            f32x4 gv[4];
#pragma unroll
            for (int g4 = 0; g4 < 4; ++g4) gv[g4] = *(const LAS f32x4*)(lds + L_A2 + (32 * sb + 8 * g4 + 4 * hi) * 4);
            const LAS unsigned char* xp = lds + L_XD + (2 * sb) * 1024 + trbase;
            const bf16x8 xv00 = trpair(xp, 512), xv01 = trpair(xp + 1024, 512), xv10 = trpair(xp + 8192, 512), xv11 = trpair(xp + 8192 + 1024, 512);
            const unsigned cw[8] = {pcb[jb][0].x, pcb[jb][0].y, pcb[jb][0].z, pcb[jb][0].w, pcb[jb][1].x, pcb[jb][1].y, pcb[jb][1].z, pcb[jb][1].w};
            float cbt[16];
#pragma unroll
            for (int k = 0; k < 8; ++k) { cbt[2 * k] = __uint_as_float(cw[k] << 16); cbt[2 * k + 1] = __uint_as_float(cw[k] & 0xffff0000u); }
            const bool diag = (sb == lb);
            const float dd = diag ? Dk * __builtin_amdgcn_rcpf(fmaxf(*(const LAS float*)(lds + L_DT + (32 * lb + r32) * 4), 1e-30f)) : 0.f;
#pragma unroll
            for (int g4 = 0; g4 < 4; ++g4)
#pragma unroll
                for (int e_ = 0; e_ < 4; ++e_) { const int r = 4 * g4 + e_; float v = (cbt[r] + (crow(r, hi) == r32 ? dd : 0.f)) * __builtin_amdgcn_exp2f(fminf(a2l - gv[g4][e_], 0.f)); if (diag && crow(r, hi) > r32) v = 0.f; cbt[r] = v; }
            u32x4 pw0, pw1;
            pw0.x = cvtpk(cbt[0], cbt[1]); pw0.y = cvtpk(cbt[2], cbt[3]); pw0.z = cvtpk(cbt[4], cbt[5]); pw0.w = cvtpk(cbt[6], cbt[7]);
            pw1.x = cvtpk(cbt[8], cbt[9]); pw1.y = cvtpk(cbt[10], cbt[11]); pw1.z = cvtpk(cbt[12], cbt[13]); pw1.w = cvtpk(cbt[14], cbt[15]);
            yacc[0] = __builtin_amdgcn_mfma_f32_32x32x16_bf16(__builtin_bit_cast(bf16x8, pw0), xv00, yacc[0], 0, 0, 0);
            yacc[1] = __builtin_amdgcn_mfma_f32_32x32x16_bf16(__builtin_bit_cast(bf16x8, pw0), xv10, yacc[1], 0, 0, 0);
            yacc[0] = __builtin_amdgcn_mfma_f32_32x32x16_bf16(__builtin_bit_cast(bf16x8, pw1), xv01, yacc[0], 0, 0, 0);
            yacc[1] = __builtin_amdgcn_mfma_f32_32x32x16_bf16(__builtin_bit_cast(bf16x8, pw1), xv11, yacc[1], 0, 0, 0);
        } }
        if (c + 1 < NCH) {
#pragma unroll
            for (int jb = 0; jb < 2; ++jb) if (par + 2 * jb <= lb) { const bf16_t* cp = CBTw + (size_t)(c + 1) * (NGRP * 10 * 64 * 16) + (par + 2 * jb) * 64 * 16; pcb[jb][0] = *(const u32x4*)cp; pcb[jb][1] = *(const u32x4*)(cp + 8); } }
#pragma unroll
        for (int g4 = 0; g4 < 4; ++g4)
#pragma unroll
            for (int e_ = 0; e_ < 4; ++e_)
#pragma unroll
                for (int q = 0; q < 2; ++q) ((LAS bf16_t*)(lds + L_Y + par * 16384))[(32 * lb + 8 * g4 + 4 * hi + e_) * 64 + 32 * q + r32] = (bf16_t)(cvtpk(yacc[q][4 * g4 + e_], 0.f) & 0xffffu);
        { const float cd = __builtin_amdgcn_exp2f(*(const LAS float*)(lds + L_A2 + 127 * 4));
#pragma unroll
          for (int r = 0; r < 16; ++r) sacc[r] *= cd;
#pragma unroll
          for (int kh = 0; kh < 2; ++kh) { bf16x8 af[4], bfq[4];
#pragma unroll
              for (int k4 = 0; k4 < 4; ++k4) { const int ks = 4 * kh + k4; af[k4] = trpair(lds + L_B + btrb0 + ks * 4096, btrb1 - btrb0); bfq[k4] = trpair(lds + L_XDD + pb * 8192 + ks * 1024 + trbase, 512); }
              __builtin_amdgcn_sched_barrier(0);
#pragma unroll
              for (int k4 = 0; k4 < 4; ++k4) sacc = __builtin_amdgcn_mfma_f32_32x32x16_bf16(af[k4], bfq[k4], sacc, 0, 0, 0); } }
        SSD_BAR();
        { const int l = el, p0 = ep0; const size_t t = (size_t)c * CHUNK + l;
          const u32x4 z0 = ez0, z1 = ez1;
          const unsigned zw[8] = {z0.x, z0.y, z0.z, z0.w, z1.x, z1.y, z1.z, z1.w};
          unsigned ow[8]; float ss = 0.f;
          const LAS bf16_t* ya = (const LAS bf16_t*)(lds + L_Y) + l * 64 + p0; const LAS bf16_t* yb = (const LAS bf16_t*)(lds + L_Y + 16384) + l * 64 + p0;
          const u32x4 a0 = *(const LAS u32x4*)ya, a1 = *(const LAS u32x4*)(ya + 8), b0 = *(const LAS u32x4*)yb, b1 = *(const LAS u32x4*)(yb + 8);
          const unsigned aw[8] = {a0.x, a0.y, a0.z, a0.w, a1.x, a1.y, a1.z, a1.w}, bw[8] = {b0.x, b0.y, b0.z, b0.w, b1.x, b1.y, b1.z, b1.w};
#pragma unroll
          for (int wi = 0; wi < 8; ++wi) {
              const float ya_ = (__uint_as_float(aw[wi] << 16) + __uint_as_float(bw[wi] << 16)) * __uint_as_float(zw[wi] << 16), yb_ = (__uint_as_float(aw[wi] & 0xffff0000u) + __uint_as_float(bw[wi] & 0xffff0000u)) * __uint_as_float(zw[wi] & 0xffff0000u);
              const unsigned w = cvtpk(ya_, yb_); ow[wi] = w; const float ra = __uint_as_float(w << 16), rb = __uint_as_float(w & 0xffff0000u); ss += ra * ra + rb * rb; }
          *(u32x4*)(MX + t * MIXW + p0) = (u32x4){ow[0], ow[1], ow[2], ow[3]}; *(u32x4*)(MX + t * MIXW + p0 + 8) = (u32x4){ow[4], ow[5], ow[6], ow[7]};
          ss += __shfl_xor(ss, 1); ss += __shfl_xor(ss, 2);
          if ((tid & 3) == 0) SSQ[t * 16] = ss; }
#pragma unroll
        for (int g4 = 0; g4 < 4; ++g4) { const int n0 = 32 * nb + 8 * g4 + 4 * hi; u32x2 w; w.x = cvtpk(sacc[4 * g4], sacc[4 * g4 + 1]); w.y = cvtpk(sacc[4 * g4 + 2], sacc[4 * g4 + 3]);
            *(LAS u32x2*)(lds + L_SIN + (n0 >> 3) * 1024 + (32 * pb + r32) * 16 + (n0 & 7) * 2) = w; }
        if (c + 1 < NCH) SSD_WRITE();
        SSD_BAR();
    }
#undef SSD_PREFETCH
#undef SSD_WRITE
#undef SSD_IMG
}
#undef SSD_BAR
}

constexpr int LDS_BYTES = 160 * 1024;
constexpr int RING_BYTES = 156 * 1024;
constexpr int MISC_OFF = RING_BYTES;

struct Frame {
    LAS unsigned char* lds; int tid, lane, wave, vcu, G; PtrsK PP;
};

template <bool MAPCOL> __device__ __forceinline__ void p0_transpose_item(const float* W, int K, int N, const float* gk, int gklen, bf16_t* WT, LAS float* scr, int item, int nblk, int lane) {
    const int kb = item / nblk, nb = item % nblk, k0 = 64 * kb, n0 = 64 * nb;
    const int c4 = lane & 15, kr = lane >> 4, ncol = n0 + 4 * c4, sc = MAPCOL ? win_src_col(ncol) : ncol;
    f32x4 v[16];
#pragma unroll
    for (int i = 0; i < 16; ++i) { const int kk = 4 * i + kr; v[i] = (f32x4){0.f, 0.f, 0.f, 0.f}; if (sc >= 0) v[i] = __builtin_nontemporal_load((const f32x4*)(W + (size_t)(k0 + kk) * N + sc)); }
#pragma unroll
    for (int i = 0; i < 16; ++i) { const int kk = 4 * i + kr; f32x4 t = v[i]; if (gk && k0 + kk < gklen) t = t * gk[k0 + kk];
        LAS float* d = scr + kk * 65 + 4 * c4; d[0] = t[0]; d[1] = t[1]; d[2] = t[2]; d[3] = t[3]; }
    asm volatile("s_waitcnt lgkmcnt(0)" ::: "memory");
    const int c = lane & 7;
#pragma unroll
    for (int j = 0; j < 8; ++j) { const int n = (lane >> 3) + 8 * j; const LAS float* sp = scr + (8 * c) * 65 + n;
        v4u o; o.x = pk2(sp[0 * 65], sp[1 * 65]); o.y = pk2(sp[2 * 65], sp[3 * 65]); o.z = pk2(sp[4 * 65], sp[5 * 65]); o.w = pk2(sp[6 * 65], sp[7 * 65]);
        *(GAS v4u*)(WT + (size_t)(n0 + n) * K + k0 + 8 * c) = o; }
    asm volatile("s_waitcnt lgkmcnt(0)" ::: "memory");
}
constexpr int I_IN = (D / 64) * (NIN / 64), I_XKV = (D / 64) * (2 * D / 64), I_OUT = (MIXW / 64) * (D / 64), I_XQ = (D / 64) * (D / 64), I_XO = I_XQ, I_UP = (D / 64) * (FF / 64), I_DN = (FF / 64) * (D / 64);
constexpr int I_EARLY = I_IN + I_XKV, I_ALL = I_EARLY + I_OUT + I_XQ + I_XO + I_UP + I_DN;
__device__ __forceinline__ void p0_transposes(Frame& F, const int lo, const int hi) {
    const PtrsK PPk = F.PP; const KAS Ptrs& P = *PPk; unsigned char* ws = P.ws;
    LAS float* scr = (LAS float*)(F.lds + F.wave * 16640);
    const int gw = F.vcu * NWAVES + F.wave, NGW = F.G * NWAVES;
    for (int it = lo + gw; it < hi; it += NGW) {
        int r = it;
        if (r < I_IN) { p0_transpose_item<true>(P.w_in, D, IN_COLS, P.g_mix, D, (bf16_t*)(ws + WS_WIN), scr, r, NIN / 64, F.lane); continue; } r -= I_IN;
        if (r < I_XKV) { p0_transpose_item<false>(P.xkv_w, D, 2 * D, nullptr, 0, (bf16_t*)(ws + WS_XKV), scr, r, 2 * D / 64, F.lane); continue; } r -= I_XKV;
        if (r < I_OUT) { p0_transpose_item<false>(P.w_out, MIXW, D, P.ssm_norm_w, 1024, (bf16_t*)(ws + WS_WOUT), scr, r, D / 64, F.lane); continue; } r -= I_OUT;
        if (r < I_XQ) { p0_transpose_item<false>(P.xq_w, D, D, P.g_xattn, D, (bf16_t*)(ws + WS_XQ), scr, r, D / 64, F.lane); continue; } r -= I_XQ;
        if (r < I_XO) { p0_transpose_item<false>(P.xo_w, D, D, nullptr, 0, (bf16_t*)(ws + WS_XO), scr, r, D / 64, F.lane); continue; } r -= I_XO;
        if (r < I_UP) { p0_transpose_item<false>(P.w_up, D, FF, P.g_mlp, D, (bf16_t*)(ws + WS_WUP), scr, r, FF / 64, F.lane); continue; } r -= I_UP;
        p0_transpose_item<false>(P.w_down, FF, D, nullptr, 0, (bf16_t*)(ws + WS_WDN), scr, r, D / 64, F.lane);
    }
}
__device__ __forceinline__ void p0_transposes_dyn(Frame& F, unsigned* ctr) {
    const PtrsK PPk = F.PP; const KAS Ptrs& P = *PPk; unsigned char* ws = P.ws;
    LAS float* scr = (LAS float*)(F.lds + F.wave * 16640);
    constexpr int NLATE = I_ALL - I_EARLY - I_DN, PER = NLATE / 8;
    static_assert(NLATE % 16 == 0, "late items split evenly over 8 counters, pulled two at a time");
    const int grp = F.vcu >> 5; unsigned* myctr = ctr + 64 * grp;
    for (;;) {
        unsigned it0 = 0; if (F.lane == 0) it0 = __hip_atomic_fetch_add(myctr, 2u, __ATOMIC_RELAXED, __HIP_MEMORY_SCOPE_AGENT);
        it0 = (unsigned)__builtin_amdgcn_readfirstlane((int)it0);
        if (it0 >= (unsigned)PER) break;
      for (int sub = 0; sub < 2; ++sub) {
        int r = grp * PER + (int)it0 + sub;
        if (r < I_OUT) { p0_transpose_item<false>(P.w_out, MIXW, D, P.ssm_norm_w, 1024, (bf16_t*)(ws + WS_WOUT), scr, r, D / 64, F.lane); continue; } r -= I_OUT;
        if (r < I_XQ) { p0_transpose_item<false>(P.xq_w, D, D, P.g_xattn, D, (bf16_t*)(ws + WS_XQ), scr, r, D / 64, F.lane); continue; } r -= I_XQ;
        if (r < I_XO) { p0_transpose_item<false>(P.xo_w, D, D, nullptr, 0, (bf16_t*)(ws + WS_XO), scr, r, D / 64, F.lane); continue; } r -= I_XO;
        if (r < I_UP) { p0_transpose_item<false>(P.w_up, D, FF, P.g_mlp, D, (bf16_t*)(ws + WS_WUP), scr, r, FF / 64, F.lane); continue; } r -= I_UP;
        p0_transpose_item<false>(P.w_down, FF, D, nullptr, 0, (bf16_t*)(ws + WS_WDN), scr, r, D / 64, F.lane);
      }
    }
}
__device__ __forceinline__ void p0_prologue(Frame& F) {
    const PtrsK PPk = F.PP; const KAS Ptrs& P = *PPk; unsigned char* ws = P.ws;
    const int gw = F.vcu * NWAVES + F.wave, NGW = F.G * NWAVES;
    bf16_t* XB = (bf16_t*)(ws + WS_XB); float* RS = (float*)(ws + WS_RSTD1);
    for (int m0 = 8 * gw; m0 < 8 * gw + 8 && m0 < M; m0 += 4) {
        f32x4 v[4][4]; float s2[4];
#pragma unroll
        for (int q = 0; q < 4; ++q) { const int m = m0 + q; const GAS f32x4* xr = (const GAS f32x4*)(P.x + (size_t)(m < M ? m : 0) * D) + F.lane;
#pragma unroll
            for (int j = 0; j < 4; ++j) v[q][j] = __builtin_nontemporal_load(xr + 64 * j); }
#pragma unroll
        for (int q = 0; q < 4; ++q) { float a = 0.f;
#pragma unroll
            for (int j = 0; j < 4; ++j) a += (v[q][j].x * v[q][j].x + v[q][j].y * v[q][j].y) + (v[q][j].z * v[q][j].z + v[q][j].w * v[q][j].w);
            s2[q] = wave_sum(a); }
#pragma unroll
        for (int q = 0; q < 4; ++q) { const int m = m0 + q; if (m < M) {
            if (F.lane == 0) RS[m] = rsqrtf(s2[q] * (1.f / D) + EPS);
            GAS unsigned long long* o8 = (GAS unsigned long long*)(XB + (size_t)m * D) + F.lane;
#pragma unroll
            for (int j = 0; j < 4; ++j) o8[64 * j] = (unsigned long long)pk2(v[q][j].x, v[q][j].y) | ((unsigned long long)pk2(v[q][j].z, v[q][j].w) << 32); } }
    }
    bf16_t* MN = (bf16_t*)(ws + WS_MEMN);
    for (int m = gw; m < MM; m += NGW) {
        const GAS f32x4* xr = (const GAS f32x4*)(P.mem + (size_t)m * D) + F.lane;
        f32x4 v[4]; float s2 = 0.f;
#pragma unroll
        for (int j = 0; j < 4; ++j) { v[j] = __builtin_nontemporal_load(xr + 64 * j); s2 += (v[j].x * v[j].x + v[j].y * v[j].y) + (v[j].z * v[j].z + v[j].w * v[j].w); }
        const float rs = rsqrtf(wave_sum(s2) * (1.f / D) + EPS);
        GAS unsigned long long* o8 = (GAS unsigned long long*)(MN + (size_t)m * D) + F.lane;
#pragma unroll
        for (int j = 0; j < 4; ++j) { const f32x4 g = ((const GAS f32x4*)P.g_mem)[F.lane + 64 * j];
            o8[64 * j] = (unsigned long long)pk2(v[j].x * rs * g.x, v[j].y * rs * g.y) | ((unsigned long long)pk2(v[j].z * rs * g.z, v[j].w * rs * g.w) << 32); }
    }
    p0_transposes(F, 0, I_EARLY);
}

__device__ __forceinline__ void p2_conv_scan(Frame& F) {
    const PtrsK PPk = F.PP; const KAS Ptrs& P = *PPk; unsigned char* ws = P.ws;
    const bf16_t* XR = (const bf16_t*)(ws + WS_BCR); bf16_t* XA = (bf16_t*)((unsigned char*)P.out + DO_BCA);
    for (int item = F.vcu; item < BATCH * NCH * NGRP; item += F.G) {
        typedef short bf16x8 __attribute__((ext_vector_type(8))); typedef float f32x16 __attribute__((ext_vector_type(16)));
        const int b = item >> 5, c = (item >> 1) & 15, g = item & 1, tid = F.tid, lane = F.lane, r32 = lane & 31, hi = lane >> 5;
        const size_t t0 = (size_t)b * SEQ + c * CHUNK;
        { const int ch8 = tid & 31, run = tid >> 5, isC = ch8 >> 4, c0 = 1024 + isC * 256 + g * 128 + (ch8 & 15) * 8, cb0 = c0 - 1024;
          float w[4][8], bb[8];
#pragma unroll
          for (int j = 0; j < 4; ++j)
#pragma unroll
              for (int i = 0; i < 8; ++i) w[j][i] = P.conv_w[j * CONVD + c0 + i];
#pragma unroll
          for (int i = 0; i < 8; ++i) bb[i] = P.conv_b[c0 + i];
          float h0[8], h1[8], h2[8];
          { v4u r0 = {0, 0, 0, 0}, r1 = r0, r2 = r0; const size_t tr = t0 + run * 8;
            if (!(c == 0 && run == 0)) { r0 = *(const v4u*)(XR + (tr - 3) * 512 + cb0); r1 = *(const v4u*)(XR + (tr - 2) * 512 + cb0); r2 = *(const v4u*)(XR + (tr - 1) * 512 + cb0); }
            const unsigned a0[4] = {r0.x, r0.y, r0.z, r0.w}, a1[4] = {r1.x, r1.y, r1.z, r1.w}, a2[4] = {r2.x, r2.y, r2.z, r2.w};
#pragma unroll
            for (int i = 0; i < 4; ++i) { h0[2 * i] = __uint_as_float(a0[i] << 16); h0[2 * i + 1] = __uint_as_float(a0[i] & 0xffff0000u);
                h1[2 * i] = __uint_as_float(a1[i] << 16); h1[2 * i + 1] = __uint_as_float(a1[i] & 0xffff0000u);
                h2[2 * i] = __uint_as_float(a2[i] << 16); h2[2 * i + 1] = __uint_as_float(a2[i] & 0xffff0000u); } }
#pragma unroll
          for (int r = 0; r < 8; ++r) { const int row = run * 8 + r;
              const v4u cv = *(const v4u*)(XR + (t0 + row) * 512 + cb0); const unsigned cw[4] = {cv.x, cv.y, cv.z, cv.w};
              float cur[8], o[8];
#pragma unroll
              for (int i = 0; i < 4; ++i) { cur[2 * i] = __uint_as_float(cw[i] << 16); cur[2 * i + 1] = __uint_as_float(cw[i] & 0xffff0000u); }
#pragma unroll
              for (int i = 0; i < 8; ++i) { o[i] = silu_f(bb[i] + w[0][i] * h0[i] + w[1][i] * h1[i] + w[2][i] * h2[i] + w[3][i] * cur[i]); h0[i] = h1[i]; h1[i] = h2[i]; h2[i] = cur[i]; }
              v4u ov; ov.x = pk2(o[0], o[1]); ov.y = pk2(o[2], o[3]); ov.z = pk2(o[4], o[5]); ov.w = pk2(o[6], o[7]);
              *(v4u*)(XA + (t0 + row) * 512 + cb0) = ov;
              *(LAS v4u*)(F.lds + isC * 32768 + (ch8 & 15) * 2048 + row * 16) = ov; } }
        asm volatile("s_waitcnt lgkmcnt(0)" ::: "memory"); __builtin_amdgcn_s_barrier(); asm volatile("" ::: "memory");
        bf16_t* CBT = (bf16_t*)(ws + WS_CBT) + (size_t)item * 10 * 64 * 16;
#pragma unroll 1
        for (int blk = F.wave; blk < 10; blk += NWAVES) {
            const int lb = blk < 1 ? 0 : blk < 3 ? 1 : blk < 6 ? 2 : 3, sb = blk - lb * (lb + 1) / 2;
            bf16x8 bfr[8], cfr[8];
#pragma unroll
            for (int kn = 0; kn < 8; ++kn) { bfr[kn] = *(const LAS bf16x8*)(F.lds + (2 * kn + hi) * 2048 + (32 * sb + r32) * 16); cfr[kn] = *(const LAS bf16x8*)(F.lds + 32768 + (2 * kn + hi) * 2048 + (32 * lb + r32) * 16); }
            __builtin_amdgcn_sched_barrier(0);
            f32x16 cbt = f32x16{};
#pragma unroll
            for (int kn = 0; kn < 8; ++kn) cbt = __builtin_amdgcn_mfma_f32_32x32x16_bf16(bfr[kn], cfr[kn], cbt, 0, 0, 0);
            v4u o0, o1;
            o0.x = pk2(cbt[0], cbt[1]); o0.y = pk2(cbt[2], cbt[3]); o0.z = pk2(cbt[4], cbt[5]); o0.w = pk2(cbt[6], cbt[7]);
            o1.x = pk2(cbt[8], cbt[9]); o1.y = pk2(cbt[10], cbt[11]); o1.z = pk2(cbt[12], cbt[13]); o1.w = pk2(cbt[14], cbt[15]);
            *(v4u*)(CBT + ((size_t)blk * 64 + lane) * 16) = o0; *(v4u*)(CBT + ((size_t)blk * 64 + lane) * 16 + 8) = o1;
        }
        asm volatile("s_waitcnt lgkmcnt(0)" ::: "memory"); __builtin_amdgcn_s_barrier(); asm volatile("" ::: "memory");
    }
    if (F.vcu < BATCH * NH) {
        const int bh = F.vcu, b = bh / NH, h = bh % NH, lane = F.lane, p0 = 256 * F.wave + 4 * lane;
        const float* DT = (const float*)(ws + WS_DT); const float* LF = (const float*)(ws + WS_LF);
        float* DTT = (float*)(ws + WS_DTT) + (size_t)bh * SEQ; float* ACS = (float*)(ws + WS_ACS) + (size_t)bh * SEQ; float* CB = (float*)(ws + WS_CUMB) + (size_t)bh * SEQ;
        const float A = -expf(P.a_log[h]);
        float dt[4], da[4], lf[4];
#pragma unroll
        for (int j4 = 0; j4 < 4; ++j4) { const size_t m = (size_t)b * SEQ + p0 + j4; dt[j4] = DT[m * 16 + h]; lf[j4] = LF[m * 16 + h]; }
        da[0] = dt[0] * A;
#pragma unroll
        for (int j4 = 1; j4 < 4; ++j4) { da[j4] = da[j4 - 1] + dt[j4] * A; lf[j4] += lf[j4 - 1]; }
        float pa = da[3], pf = lf[3];
#pragma unroll
        for (int o = 1; o < 32; o <<= 1) { const float t = __shfl_up(pa, o); if ((lane & 31) >= o) pa += t; }
#pragma unroll
        for (int o = 1; o < 64; o <<= 1) { const float t = __shfl_up(pf, o); if (lane >= o) pf += t; }
        LAS float* wt = (LAS float*)(F.lds + 140 * 1024);
        if (lane == 63) wt[F.wave] = pf;
        asm volatile("s_waitcnt lgkmcnt(0)" ::: "memory"); __builtin_amdgcn_s_barrier(); asm volatile("" ::: "memory");
        float base = 0.f;
        for (int w = 0; w < F.wave; ++w) base += wt[w];
        const float ea = pa - da[3], ef = pf - lf[3] + base;
        *(f32x4*)(DTT + p0) = (f32x4){dt[0], dt[1], dt[2], dt[3]};
        *(f32x4*)(ACS + p0) = (f32x4){da[0] + ea, da[1] + ea, da[2] + ea, da[3] + ea};
        *(f32x4*)(CB + p0) = (f32x4){(lf[0] + ef) * LOG2E, (lf[1] + ef) * LOG2E, (lf[2] + ef) * LOG2E, (lf[3] + ef) * LOG2E};
    }
}

struct Args { Ptrs P; int ph_lo, ph_hi, flags, pad; };
__device__ __forceinline__ bool in_phase(const KAS Args* ka, int k) { asm volatile("" : "+s"(ka)); return ka->ph_lo <= k && k < ka->ph_hi; }
__device__ __forceinline__ PtrsK launder(PtrsK p) { asm volatile("" : "+s"(p)); return p; }

typedef GAS unsigned gu32;
#define XB_TMO      128
#define XB_XCNT(j)  (256  + 64 * (j))
#define XB_XSUB(j)  (1280 + 64 * (j))
#define XB_XGEN(j)  (2304 + 64 * (j))
#define XB_TOP      3328
#define XB_TOPGEN   3392
#define XCD_BAR_WORDS 3456
#define XB_SPIN_CAP (1u << 18)
__device__ __forceinline__ unsigned xb_ld(unsigned* p)              { return __hip_atomic_load(p, __ATOMIC_RELAXED, __HIP_MEMORY_SCOPE_AGENT); }
__device__ __forceinline__ unsigned xb_add(unsigned* p, unsigned v) { return __hip_atomic_fetch_add(p, v, __ATOMIC_RELAXED, __HIP_MEMORY_SCOPE_AGENT); }
__device__ __forceinline__ unsigned xb_xcc_id() { return (unsigned)__builtin_amdgcn_s_getreg((3 << 11) | 20) & 0xFu; }
#define XB_SPIN(cond, bar) do { unsigned _sp = 0; while (cond) { __builtin_amdgcn_s_sleep(1); \
    if ((++_sp & 255u) == 0u) { if (xb_ld(&(bar)[XB_TMO])) break; if (_sp > XB_SPIN_CAP) { atomicAdd(&(bar)[XB_TMO], 1u); break; } } } } while (0)
struct XcdBarrier { unsigned* bar; unsigned x; volatile LAS unsigned* st; };
__device__ __forceinline__ XcdBarrier xcd_barrier_post(unsigned* bar, volatile LAS unsigned* st) {
    XcdBarrier b; b.bar = bar; b.x = xb_xcc_id(); b.st = st;
    if (threadIdx.x == 0) (void)xb_add(&bar[XB_XCNT(b.x)], 1u);
    return b;
}
__device__ __forceinline__ void xcd_barrier_complete(unsigned* bar, unsigned x, unsigned& nloc, unsigned& nx) {
    const unsigned G = gridDim.x * gridDim.y * gridDim.z;
    unsigned sum, cnt, mine, sp = 0u;
    for (;;) {
        sum = 0u; cnt = 0u; mine = 0u;
#pragma unroll
        for (unsigned j = 0; j < 16; ++j) { const unsigned c = xb_ld(&bar[XB_XCNT(j)]); sum += c; cnt += (c > 0u) ? 1u : 0u; mine = (j == x) ? c : mine; }
        if (sum == G) break;
        __builtin_amdgcn_s_sleep(1);
        if ((++sp & 255u) == 0u) { if (xb_ld(&bar[XB_TMO])) break; if (sp > XB_SPIN_CAP) { atomicAdd(&bar[XB_TMO], 1u); break; } }
    }
    nloc = mine > 0u ? mine : 1u; nx = cnt > 0u ? cnt : 1u;
}
__device__ __forceinline__ void xcd_barrier(const XcdBarrier& b) {
    asm volatile("s_waitcnt vmcnt(0)" ::: "memory");
    __syncthreads();
    if (threadIdx.x == 0) {
        unsigned* bar = b.bar;
        __builtin_amdgcn_s_waitcnt(0);
        unsigned nloc = b.st[0], nx = b.st[1];
        if (nloc == 0u) { xcd_barrier_complete(bar, b.x, nloc, nx); b.st[0] = nloc; b.st[1] = nx; }
        const unsigned old = xb_add(&bar[XB_XSUB(b.x)], 1u);
        const unsigned gen = old / nloc;
        if (old + 1u == (gen + 1u) * nloc) {
            __builtin_amdgcn_fence(__ATOMIC_RELEASE, "agent");
            asm volatile("s_waitcnt vmcnt(0)" ::: "memory");
            const unsigned og = xb_add(&bar[XB_TOP], 1u);
            const unsigned tg = og / nx;
            if (og + 1u == (tg + 1u) * nx) xb_add(&bar[XB_TOPGEN], 1u);
            else XB_SPIN(xb_ld(&bar[XB_TOPGEN]) == tg, bar);
            __builtin_amdgcn_fence(__ATOMIC_ACQUIRE, "agent");
            xb_add(&bar[XB_XGEN(b.x)], 1u);
            asm volatile("s_waitcnt vmcnt(0)" ::: "memory");
        } else {
            XB_SPIN(xb_ld(&bar[XB_XGEN(b.x)]) == gen, bar);
            __builtin_amdgcn_fence(__ATOMIC_ACQUIRE, "agent");
            asm volatile("s_waitcnt vmcnt(0)" ::: "memory");
        }
    }
    __syncthreads();
}
constexpr int CW_LATE = 7680;
constexpr int CW_BAR = 4096;
typedef const KAS Args* ArgsK;
__device__ __forceinline__ ArgsK launder(ArgsK p) { asm volatile("" : "+s"(p)); return p; }
__device__ __forceinline__ int vcu_of() { const int G = gridDim.x, bx = blockIdx.x; return (G % 8 == 0) ? (bx % 8) * (G / 8) + bx / 8 : bx; }
__device__ __forceinline__ Frame make_frame(LAS unsigned char* lds, PtrsK pp) { Frame F; F.lds = lds; F.tid = threadIdx.x; F.lane = F.tid & 63; F.wave = __builtin_amdgcn_readfirstlane(F.tid >> 6); F.G = gridDim.x; F.vcu = vcu_of(); F.PP = pp; return F; }
__global__ void __launch_bounds__(NTHR, 2) fwd(Args args_unused) {
    extern __shared__ __attribute__((aligned(16))) unsigned char lds_raw[];
    const ArgsK KA = (ArgsK)__builtin_amdgcn_kernarg_segment_ptr();
    volatile LAS unsigned* MISC = (volatile LAS unsigned*)((LAS unsigned char*)lds_raw + MISC_OFF);
    if (threadIdx.x < 4) MISC[threadIdx.x] = 0u;
    __syncthreads();
    XcdBarrier bar; bar.bar = nullptr; bar.x = 0; bar.st = MISC;
    { const ArgsK A = launder(KA); if (A->ph_hi - A->ph_lo > 1) bar = xcd_barrier_post((unsigned*)(A->P.ws + WS_CTL) + CW_BAR, MISC); }
#define SEAM(k) do { if (in_phase(KA, (k)) && in_phase(KA, (k) + 1)) xcd_barrier(bar); } while (0)
#ifndef PH_MASK
#define PH_MASK 0xFFFF
#endif
#define IN(k) (((PH_MASK >> (k)) & 1) && in_phase(KA, (k)))
#define LDSP ((LAS unsigned char*)lds_raw)
#define XLP (LDSP + pg8::STAGE_BYTES)
    if (IN(0)) { const ArgsK A = launder(KA); Frame F = make_frame(LDSP, &A->P); p0_prologue(F); }
    SEAM(0);
    if (IN(1)) {
        const ArgsK A = launder(KA); const PtrsK PP = &A->P; const int v = vcu_of();
        pg8::SchedP1 S{(const char*)PP->out, (const char*)PP->ws, v >> 5, v & 31};
        pg8::EpiP1 E{PP};
        pg8::gemm_phase(LDSP, XLP, D, S, E);
    }
    SEAM(1);
    if (IN(2)) { const ArgsK A = launder(KA); Frame F = make_frame(LDSP, &A->P); p2_conv_scan(F); }
    SEAM(2);
    if (IN(3)) {
        static_assert(attn_body::ATTN_LDS_BYTES <= RING_BYTES && ssd::LDS_BYTES <= RING_BYTES, "mixer LDS");
        { const int v = vcu_of(); const ArgsK A = launder(KA); if ((v & 1) == 0) { ssd::ssd_item(A->P, v >> 1, LDSP); __syncthreads();
            static_assert(I_DN == 128 * NWAVES, "one item per wave of the even CUs");
            const int w = __builtin_amdgcn_readfirstlane(threadIdx.x >> 6);
            p0_transpose_item<false>(A->P.w_down, FF, D, nullptr, 0, (bf16_t*)(A->P.ws + WS_WDN), (LAS float*)(LDSP + w * 16640), (v >> 1) * NWAVES + w, D / 64, threadIdx.x & 63);
            __syncthreads(); } }
        { const ArgsK A = launder(KA); unsigned char* ws = A->P.ws;
        const attn_body::AttnTensorsB AT{(const attn_body::bf16*)(ws + WS_Q), (const attn_body::bf16*)(ws + WS_K), (const attn_body::bf16*)(ws + WS_V), (attn_body::bf16*)(ws + WS_MIXED), (const float*)(ws + WS_CUMB)};
        const attn_body::StaticOrder S(vcu_of());
        attn_body::attn_phase<attn_body::StaticOrder>((char*)lds_raw, AT, S); }
        { __syncthreads(); const ArgsK A = launder(KA); Frame F = make_frame(LDSP, &A->P); p0_transposes_dyn(F, (unsigned*)(A->P.ws + WS_CTL) + CW_LATE); }
    }
    SEAM(3);
    if (IN(4)) {
        const ArgsK A = launder(KA); const PtrsK PP = &A->P; unsigned char* ws = PP->ws; const int v = vcu_of();
        pg8::SchedOne S{(const char*)(ws + WS_MIXED), (const char*)(ws + WS_WOUT), v >> 5, v & 31, 32, (size_t)256 * MIXW * 2};
        pg8::EpiRes<true, false> E{PP->x, (bf16_t*)(ws + WS_X1B), (float*)(ws + WS_SSQ2), (const float*)(ws + WS_SSQ)};
        pg8::gemm_phase(LDSP, XLP, MIXW, S, E);
    }
    SEAM(4);
    if (IN(5)) {
        const ArgsK A = launder(KA); const PtrsK PP = &A->P; unsigned char* ws = PP->ws; const int v = vcu_of();
        pg8::SchedOne S{(const char*)(ws + WS_X1B), (const char*)(ws + WS_XQ), v >> 5, v & 31, 32, (size_t)256 * D * 2};
        pg8::EpiXq E{(const float*)(ws + WS_SSQ2), PP->xg_q, (bf16_t*)(ws + WS_QX)};
        pg8::gemm_phase(LDSP, XLP, D, S, E);
    }
    if (in_phase(KA, 5) && in_phase(KA, 6)) { if (threadIdx.x == 0) { __builtin_amdgcn_fence(__ATOMIC_ACQUIRE, "agent"); asm volatile("s_waitcnt vmcnt(0)" ::: "memory"); } __syncthreads(); }
    if (IN(6)) {
        static_assert(xattn::LDS_BYTES <= RING_BYTES, "xattn LDS");
        const ArgsK A = launder(KA); unsigned char* ws = A->P.ws;
        for (int u = vcu_of(); u < BATCH * XH * 8; u += (int)gridDim.x)
            xattn::xattn_unit((const bf16_t*)(ws + WS_QX), (const bf16_t*)(ws + WS_KX), (const bf16_t*)(ws + WS_VX), (bf16_t*)(ws + WS_OX), u >> 5, (u >> 3) & 3, u & 7, LDSP);
    }
    SEAM(6);
    if (IN(7)) {
        const ArgsK A = launder(KA); const PtrsK PP = &A->P; unsigned char* ws = PP->ws; const int v = vcu_of();
        pg8::SchedOne S{(const char*)(ws + WS_OX), (const char*)(ws + WS_XO), v >> 5, v & 31, 32, (size_t)256 * D * 2};
        pg8::EpiRes<false, true> E{ws + WS_X1B, (bf16_t*)(ws + WS_X2B), (float*)(ws + WS_SSQ3), nullptr};
        pg8::gemm_phase(LDSP, XLP, D, S, E);
    }
    SEAM(7);
    if (IN(8)) {
        const ArgsK A = launder(KA); const PtrsK PP = &A->P; unsigned char* ws = PP->ws; const int v = vcu_of();
        pg8::SchedOne S{(const char*)(ws + WS_X2B), (const char*)(ws + WS_WUP), v >> 5, v & 31, 128, (size_t)256 * D * 2};
        pg8::EpiUp E{(const float*)(ws + WS_SSQ3), (bf16_t*)(ws + WS_HB)};
        pg8::gemm_phase(LDSP, XLP, D, S, E);
    }
    SEAM(8);
    if (IN(9)) {
        const ArgsK A = launder(KA); const PtrsK PP = &A->P; unsigned char* ws = PP->ws; const int v = vcu_of();
        pg8::SchedOne S{(const char*)(ws + WS_HB), (const char*)(ws + WS_WDN), v >> 5, v & 31, 32, (size_t)256 * FF * 2};
        pg8::EpiDown E{(const bf16_t*)(ws + WS_X2B), PP->out};
        pg8::gemm_phase(LDSP, XLP, FF, S, E);
    }
#undef IN
#undef SEAM
#undef LDSP
#undef XLP
}

extern "C" void kernel_launch(void* const* d_in, const int* in_sizes, int n_in, void* d_out, int out_size, void* d_ws, size_t ws_size, hipStream_t stream) {
    static int ready = 0;
    if (!ready) {
        if (n_in != 24 || out_size != M * D || ws_size < WS_END) { fprintf(stderr, "kernel_launch: unexpected shapes (n_in %d out %d ws %zu)\n", n_in, out_size, ws_size); ready = -1; return; }
        if (hipFuncSetAttribute((const void*)fwd, hipFuncAttributeMaxDynamicSharedMemorySize, LDS_BYTES) != hipSuccess) { fprintf(stderr, "kernel_launch: hipFuncSetAttribute failed\n"); ready = -1; return; }
        int dev = 0, cus = 0, per_cu = 0;
        if (hipGetDevice(&dev) != hipSuccess || hipDeviceGetAttribute(&cus, hipDeviceAttributeMultiprocessorCount, dev) != hipSuccess) cus = 0;
        if (hipOccupancyMaxActiveBlocksPerMultiprocessor(&per_cu, (const void*)fwd, NTHR, LDS_BYTES) != hipSuccess) per_cu = 0;
        (void)hipGetLastError();
        ready = (cus * per_cu >= 256) ? 2 : 1;
    }
    if (ready < 0) return;
    Args a{};
    const float** pp = (const float**)&a.P;
    for (int i = 0; i < 24; ++i) pp[i] = (const float*)d_in[i];
    a.P.out = (float*)d_out; a.P.ws = (unsigned char*)d_ws;
    (void)hipMemsetAsync((char*)d_ws + WS_CTL, 0, CTL_ZERO_BYTES, stream);
    const int G = 256;
    auto PH = [&](int lo, int hi) { a.ph_lo = lo; a.ph_hi = hi; hipLaunchKernelGGL(fwd, dim3(G), dim3(NTHR), LDS_BYTES, stream, a); };
#ifndef N_LAUNCHES
#define N_LAUNCHES 1
#endif
    if (N_LAUNCHES == 1 && ready == 2) PH(0, 10);
    else for (int p = 0; p < 10; ++p) PH(p, p + 1);
}
```

```cpp
#include <hip/hip_runtime.h>
#include <hip/hip_bf16.h>
#include <cmath>
#include <cstdio>
#include <cstdint>

typedef unsigned short bf16_t;
#define GAS __attribute__((address_space(1)))
#define LAS __attribute__((address_space(3)))
typedef unsigned v4u __attribute__((ext_vector_type(4)));
typedef float f32x4 __attribute__((ext_vector_type(4)));

constexpr int D = 1024, BATCH = 8, SEQ = 2048, M = BATCH * SEQ, MEML = 256, MM = BATCH * MEML;
constexpr int NH = 16, HD = 64, NGRP = 2, NST = 128, CHUNK = 128, NCH = SEQ / CHUNK, CONVD = 1536, MIXW = 2048;
constexpr int IN_COLS = 5664, NIN = 5888;
constexpr int XH = 4, XHD = 256, FF = 4096;
constexpr float EPS = 1e-5f, LOG2E = 1.4426950408889634f;
constexpr float C2 = 0.125f * LOG2E;
constexpr float CX2 = 0.0625f * LOG2E;

__host__ __device__ __forceinline__ int win_src_col(int n) { if (n < 2560) return n; if (n < 5632) return n + 16; if (n < 5648) return n - 5632 + 2560; if (n < 5664) return n; return -1; }

constexpr int NWAVES = 8, NTHR = NWAVES * 64;
constexpr size_t MiB = 1u << 20;
constexpr size_t WS_CTL = 0, CTL_ZERO_BYTES = 32768;
constexpr size_t WS_WIN = 1 * MiB, WS_XKV = 13 * MiB, WS_WOUT = 17 * MiB, WS_XQ = 21 * MiB, WS_XO = 23 * MiB, WS_WUP = 25 * MiB, WS_WDN = 33 * MiB;
constexpr size_t WS_BCA = 1 * MiB;
constexpr size_t WS_ZS = 41 * MiB;
constexpr size_t WS_X1B = WS_ZS;
constexpr size_t WS_BCR = 73 * MiB;
constexpr size_t WS_MIXED = WS_BCR;
constexpr size_t WS_XB = 89 * MiB;
constexpr size_t WS_Q = 137 * MiB, WS_K = 169 * MiB, WS_V = 201 * MiB;
constexpr size_t WS_QX = WS_Q, WS_OX = WS_K, WS_X2B = WS_V;
constexpr size_t WS_HB = 73 * MiB;
constexpr size_t WS_KX = 233 * MiB, WS_VX = 237 * MiB;
constexpr size_t WS_DT = 241 * MiB, WS_LF = 242 * MiB, WS_DTT = 243 * MiB, WS_ACS = 244 * MiB, WS_CUMB = 245 * MiB;
constexpr size_t WS_SSQ = 246 * MiB, WS_SSQ2 = 247 * MiB, WS_SSQ3 = 248 * MiB, WS_RSTD1 = 249 * MiB, WS_CBT = 250 * MiB, WS_MEMN = WS_CBT, WS_END = 255 * MiB;
constexpr size_t DO_XB = 0, DO_BCA = 0, DO_XRAW = 32 * MiB;

__device__ __forceinline__ float bf2f(bf16_t v) { return __uint_as_float((unsigned)v << 16); }
__device__ __forceinline__ unsigned f2bf(float f) { unsigned u = __float_as_uint(f); return (u + 0x7fffu + ((u >> 16) & 1u)) >> 16; }
__device__ __forceinline__ unsigned pk2(float lo, float hi) { return f2bf(lo) | (f2bf(hi) << 16); }
__device__ __forceinline__ float wave_sum(float v) {
#pragma unroll
    for (int o = 1; o < 64; o <<= 1) v += __shfl_xor(v, o);
    return v;
}
__device__ __forceinline__ float wave_max(float v) {
#pragma unroll
    for (int o = 1; o < 64; o <<= 1) v = fmaxf(v, __shfl_xor(v, o));
    return v;
}
__device__ __forceinline__ float silu_f(float x) { return x * __builtin_amdgcn_rcpf(1.f + __builtin_amdgcn_exp2f(-x * LOG2E)); }
__device__ __forceinline__ float softplus_f(float x) { return x > 20.f ? x : log1pf(expf(x)); }

#define KAS __attribute__((address_space(4)))
struct Ptrs {
    const float *x, *mem, *g_mix, *w_in, *conv_w, *conv_b, *dt_bias, *a_log, *d_skip, *ssm_norm_w, *g_q, *g_k, *f_bias, *w_out, *g_xattn, *g_mem,
        *xq_w, *xkv_w, *xg_q, *xg_k, *xo_w, *g_mlp, *w_up, *w_down;
    float* out; unsigned char* ws;
};
typedef const KAS Ptrs* PtrsK;

namespace pg8 {
typedef short bf16x8 __attribute__((ext_vector_type(8)));
typedef unsigned u32x4 __attribute__((ext_vector_type(4)));
constexpr int BM = 256, BK = 64, HALF = 128, HTB = HALF * BK * 2, STAGE_BYTES = 8 * HTB;
__host__ __device__ __forceinline__ int lds_byte(int r, int c) { const int st = (r >> 4) * 2 + (c >> 5), rr = r & 15, cc = c & 31, ob = rr * 64 + cc * 2; return st * 1024 + (ob ^ (((ob >> 9) & 1) << 5)); }
__host__ __device__ __forceinline__ void stage_rc(int b, int& R, int& C) { const int st = b / 1024, sb = b % 1024, swz = sb ^ (((sb >> 9) & 1) << 5); R = (st >> 1) * 16 + swz / 64; C = (st & 1) * 32 + (swz % 64) / 2; }
__host__ __device__ __forceinline__ int perm32(int rho) { const int n = rho >> 4, i = rho & 15; return 8 * (i >> 2) + 4 * n + (i & 3); }
struct Unit { int pm, pn, kind; const char* a; const char* b; };
typedef f32x4 Acc[2][2][4][2];
__device__ __forceinline__ unsigned cvt_pk_bf16(float lo, float hi) { unsigned r; asm volatile("v_cvt_pk_bf16_f32 %0, %1, %2" : "=v"(r) : "v"(lo), "v"(hi)); return r; }

template <class Epi, class Sched>
__device__ __forceinline__ void gemm_phase(LAS unsigned char* lds, LAS unsigned char* xl, const int K, const Sched& S, const Epi& E) {
    const int tid = threadIdx.x, wid = __builtin_amdgcn_readfirstlane(tid >> 6), lane = tid & 63, wr = wid >> 2, wc = wid & 3, fr = lane & 15, fq = lane >> 4;
    const int nt = K / BK;
    unsigned voffA[2], voffB[2];
#pragma unroll
    for (int i = 0; i < 2; ++i) { int R, C; stage_rc(tid * 16 + i * 8192, R, C); const int Rb = (R >> 5) * 64 + perm32(R & 31);
        voffA[i] = (unsigned)(R * K + C) * 2u; voffB[i] = (unsigned)(Rb * K + C) * 2u; }
    const size_t kstep = (size_t)(BK * 2);
    const size_t hstep = (size_t)HALF * K * 2;
    const size_t bstep = (size_t)32 * K * 2;
    const unsigned ldsw = (unsigned)wid * 1024u;
    const int aoff = lds_byte(wr * 64 + fr, fq * 8), boff = lds_byte(wc * 32 + fr, fq * 8);
#define PG8_SA(b, h) (((b) * 2 + (h)) * HTB)
#define PG8_SB(b, h) ((4 + (b) * 2 + (h)) * HTB)
#define PG8_STAGE(bufoff, gbase, voff) do { _Pragma("unroll") for (int _i = 0; _i < 2; ++_i) \
        __builtin_amdgcn_global_load_lds((const unsigned*)((const char*)(gbase) + (voff)[_i]), (LAS unsigned*)(lds + (bufoff) + ldsw + _i * 8192), 16, 0, 0); } while (0)
#define PG8_LDA(dst, b, h) do { _Pragma("unroll") for (int m = 0; m < 4; ++m) _Pragma("unroll") for (int k = 0; k < 2; ++k) dst[m][k] = *(const LAS bf16x8*)(lds + PG8_SA(b, h) + aoff + m * 2048 + k * 1024); } while (0)
#define PG8_LDB(dst, b, h) do { _Pragma("unroll") for (int n = 0; n < 2; ++n) _Pragma("unroll") for (int k = 0; k < 2; ++k) dst[n][k] = *(const LAS bf16x8*)(lds + PG8_SB(b, h) + boff + n * 2048 + k * 1024); } while (0)
#define PG8_MMA(ai, bj, At, Bt) do { __builtin_amdgcn_s_setprio(1); _Pragma("unroll") for (int m = 0; m < 4; ++m) _Pragma("unroll") for (int n = 0; n < 2; ++n) _Pragma("unroll") for (int k = 0; k < 2; ++k) \
        acc[ai][bj][m][n] = __builtin_amdgcn_mfma_f32_16x16x32_bf16(Bt[n][k], At[m][k], acc[ai][bj][m][n], 0, 0, 0); __builtin_amdgcn_s_setprio(0); } while (0)
#define PG8_WAIT_V(n) asm volatile("s_waitcnt vmcnt(" #n ")" ::: "memory")
#define PG8_WAIT_L(n) asm volatile("s_waitcnt lgkmcnt(" #n ")" ::: "memory")
#define PG8_BAR __builtin_amdgcn_s_barrier()
#define PG8_SCHED __builtin_amdgcn_sched_barrier(0)
    Unit cur, nxt; int ui = 0;
    if (!S.next(0, cur)) return;
    E.prepare(xl, cur, tid);
    asm volatile("s_waitcnt vmcnt(0) lgkmcnt(0)" ::: "memory"); __builtin_amdgcn_s_barrier(); asm volatile("" ::: "memory");
    Acc acc;
#pragma unroll
    for (int a = 0; a < 2; ++a)
#pragma unroll
        for (int b = 0; b < 2; ++b)
#pragma unroll
            for (int m = 0; m < 4; ++m)
#pragma unroll
                for (int n = 0; n < 2; ++n) acc[a][b][m][n] = (f32x4){0.f, 0.f, 0.f, 0.f};
    bf16x8 At[4][2], B0[2][2], B1[2][2];
    const char* cA = cur.a; const char* cB = cur.b;
    PG8_STAGE(PG8_SB(0, 0), cB, voffB); PG8_STAGE(PG8_SB(0, 1), cB + bstep, voffB); PG8_STAGE(PG8_SA(0, 0), cA, voffA); PG8_STAGE(PG8_SA(0, 1), cA + hstep, voffA);
    if (wr == 1) PG8_BAR;
    PG8_WAIT_V(2); PG8_BAR;
    PG8_STAGE(PG8_SB(1, 0), cB + kstep, voffB); PG8_STAGE(PG8_SA(1, 0), cA + kstep, voffA); PG8_STAGE(PG8_SB(1, 1), cB + bstep + kstep, voffB);
    PG8_WAIT_V(6); PG8_BAR;
    for (;;) {
        const bool has_next = S.next(ui + 1, nxt);
        const char* nA = has_next ? nxt.a : cA; const char* nB = has_next ? nxt.b : cB;
        for (int t = 0; t < nt; t += 2) {
            const bool last = (t == nt - 2);
            const char* a1 = cA + (size_t)(t + 1) * kstep;
            const char* a2 = last ? nA : cA + (size_t)(t + 2) * kstep; const char* b2 = last ? nB : cB + (size_t)(t + 2) * kstep;
            const char* a3 = a2 + kstep; const char* b3 = b2 + kstep;
            if constexpr (Epi::KSEG) { if (t == 8 || t == 16) E.kseg(acc, cur, t, wr, fr, xl); }
            PG8_LDB(B0, 0, 0); PG8_LDB(B1, 0, 1); PG8_SCHED; PG8_LDA(At, 0, 0); PG8_STAGE(PG8_SA(1, 1), a1 + hstep, voffA);
            PG8_WAIT_V(8); PG8_WAIT_L(0); PG8_BAR; PG8_MMA(0, 0, At, B0); PG8_MMA(0, 1, At, B1); PG8_BAR; PG8_SCHED;
            PG8_LDA(At, 0, 1); PG8_STAGE(PG8_SB(0, 0), b2, voffB); PG8_STAGE(PG8_SB(0, 1), b2 + bstep, voffB); PG8_STAGE(PG8_SA(0, 0), a2, voffA);
            PG8_WAIT_V(8); PG8_WAIT_L(0); PG8_BAR; PG8_MMA(1, 0, At, B0); PG8_MMA(1, 1, At, B1); PG8_BAR; PG8_SCHED;
            PG8_LDB(B0, 1, 0); PG8_LDB(B1, 1, 1); PG8_SCHED; PG8_LDA(At, 1, 0); PG8_STAGE(PG8_SA(0, 1), a2 + hstep, voffA);
            PG8_WAIT_V(8); PG8_WAIT_L(0); PG8_BAR; PG8_MMA(0, 0, At, B0); PG8_MMA(0, 1, At, B1); PG8_BAR; PG8_SCHED;
            PG8_LDA(At, 1, 1); PG8_STAGE(PG8_SB(1, 0), b3, voffB); PG8_STAGE(PG8_SB(1, 1), b3 + bstep, voffB); PG8_STAGE(PG8_SA(1, 0), a3, voffA);
            PG8_WAIT_V(8); PG8_WAIT_L(0); PG8_BAR; PG8_MMA(1, 0, At, B0); PG8_MMA(1, 1, At, B1); PG8_BAR; PG8_SCHED;
        }
        if (wr == 0) PG8_BAR;
        E.run(acc, cur, wr, wc, fr, fq, xl, lane);
        if (!has_next) break;
#pragma unroll
        for (int a = 0; a < 2; ++a)
#pragma unroll
            for (int b = 0; b < 2; ++b)
#pragma unroll
                for (int m = 0; m < 4; ++m)
#pragma unroll
                    for (int n = 0; n < 2; ++n) acc[a][b][m][n] = (f32x4){0.f, 0.f, 0.f, 0.f};
        cur = nxt; cA = nA; cB = nB; ++ui;
        if (wr == 1) PG8_BAR;
    }
    PG8_WAIT_V(0);
    PG8_BAR;
#undef PG8_SA
#undef PG8_SB
#undef PG8_STAGE
#undef PG8_LDA
#undef PG8_LDB
#undef PG8_MMA
#undef PG8_WAIT_V
#undef PG8_WAIT_L
#undef PG8_BAR
#undef PG8_SCHED
}

struct SchedOne {
    const char* A; const char* Bt; int x, c, ntile; size_t tstep;
    __device__ __forceinline__ bool next(int i, Unit& u) const { const int j = i * 32 + c; if (j >= ntile) return false; u.pm = 8 * x + (j & 7); u.pn = j >> 3; u.kind = 0; u.a = A + (size_t)u.pm * tstep; u.b = Bt + (size_t)u.pn * tstep; return true; }
};
struct SchedP1 {
    const char *outb, *ws; int x, c;
    __device__ __forceinline__ bool next(int i, Unit& u) const {
        const int j = i * 32 + c; if (j >= 192) return false; constexpr size_t tstep = (size_t)256 * D * 2;
        if (j < 184) { u.pm = 8 * x + (j & 7); u.pn = j >> 3; const int pn = u.pn; u.kind = pn < 4 ? 0 : pn < 10 ? 1 : pn < 14 ? 2 : pn < 18 ? 3 : pn < 22 ? 4 : 5; u.a = ws + WS_XB + (size_t)u.pm * tstep; u.b = ws + WS_WIN + (size_t)pn * tstep; }
        else { u.pm = x; u.pn = j - 184; u.kind = u.pn < 4 ? 6 : 7; u.a = ws + WS_MEMN + (size_t)u.pm * tstep; u.b = ws + WS_XKV + (size_t)u.pn * tstep; }
        return true;
    }
};

__device__ __forceinline__ float row_ssq64(const Acc& acc, int ai, int m) {
    float s = 0.f;
#pragma unroll
    for (int bj = 0; bj < 2; ++bj)
#pragma unroll
        for (int n = 0; n < 2; ++n) { const f32x4 v = acc[ai][bj][m][n]; s += (v[0] * v[0] + v[1] * v[1]) + (v[2] * v[2] + v[3] * v[3]); }
    s += __shfl_xor(s, 16); s += __shfl_xor(s, 32); return s;
}
__device__ __forceinline__ void row_ssq256(const Acc& acc, int wr, int wc, int fr, int fq, LAS unsigned char* xl, float (&tot)[2][4]) {
    LAS float* Pp = (LAS float*)xl;
#pragma unroll
    for (int ai = 0; ai < 2; ++ai)
#pragma unroll
        for (int m = 0; m < 4; ++m) { const float s = row_ssq64(acc, ai, m); if (fq == 0) Pp[(ai * HALF + wr * 64 + m * 16 + fr) * 4 + wc] = s; }
    asm volatile("s_waitcnt lgkmcnt(0)" ::: "memory"); __builtin_amdgcn_s_barrier(); asm volatile("" ::: "memory");
#pragma unroll
    for (int ai = 0; ai < 2; ++ai)
#pragma unroll
        for (int m = 0; m < 4; ++m) { const f32x4 p = *(const LAS f32x4*)(Pp + (ai * HALF + wr * 64 + m * 16 + fr) * 4); tot[ai][m] = (p[0] + p[1]) + (p[2] + p[3]); }
    asm volatile("s_waitcnt lgkmcnt(0)" ::: "memory"); __builtin_amdgcn_s_barrier(); asm volatile("" ::: "memory");
}
__device__ __forceinline__ u32x4 pack8(const f32x4 a, const f32x4 b) { u32x4 w; w.x = cvt_pk_bf16(a[0], a[1]); w.y = cvt_pk_bf16(a[2], a[3]); w.z = cvt_pk_bf16(b[0], b[1]); w.w = cvt_pk_bf16(b[2], b[3]); return w; }
__device__ __forceinline__ float sum16(const float* p) { const f32x4 a = *(const f32x4*)p, b = *(const f32x4*)(p + 4), c = *(const f32x4*)(p + 8), d = *(const f32x4*)(p + 12);
    return ((a[0] + a[1]) + (a[2] + a[3])) + ((b[0] + b[1]) + (b[2] + b[3])) + ((c[0] + c[1]) + (c[2] + c[3])) + ((d[0] + d[1]) + (d[2] + d[3])); }

__device__ __forceinline__ float softplus_fast(float x) {
    const float t = __builtin_amdgcn_exp2f(fminf(x, 60.f) * LOG2E);
    const float small = t * (1.f - t * (0.5f - t * 0.33333334f)), big = __builtin_amdgcn_logf(1.f + t) * 0.6931471805599453f;
    return x > 20.f ? x : (t < 0.015625f ? small : big);
}
struct EpiP1 {
    static constexpr bool KSEG = false;
    PtrsK PP;
    __device__ __forceinline__ void kseg(Acc&, const Unit&, int, int, int, LAS unsigned char*) const {}
    __device__ __forceinline__ void prepare(LAS unsigned char* xl, const Unit& u, int tid) const {
        if (tid < 256) ((LAS float*)(xl + 4096))[tid] = ((const float*)(PP->ws + WS_RSTD1))[u.pm * BM + tid]; }
    template <int KIND> __device__ __forceinline__ void body(Acc& acc, const Unit& u, int wr, int wc, int fr, int fq, LAS unsigned char* xl, bf16_t* base, int ldc, int colt, const float* gp) const {
        const int rowt = wr * 64 + fr, row0 = u.pm * BM + rowt, colw = wc * 64 + 8 * fq;
        const LAS float* RSC = (const LAS float*)(xl + 4096) + rowt;
        float tot[2][4];
        if (KIND == 6) row_ssq256(acc, wr, wc, fr, fq, xl, tot);
        f32x4 g[2][2];
        if (KIND == 2 || KIND == 3 || KIND == 6) {
#pragma unroll
            for (int bj = 0; bj < 2; ++bj)
#pragma unroll
                for (int n = 0; n < 2; ++n) g[bj][n] = *(const f32x4*)(gp + bj * 32 + n * 4);
        }
#pragma unroll
        for (int ai = 0; ai < 2; ++ai)
#pragma unroll
            for (int m = 0; m < 4; ++m) {
                const int row = row0 + ai * HALF + m * 16;
                float rs = KIND < 6 ? RSC[ai * HALF + m * 16] : 1.f;
                if (KIND == 2 || KIND == 3) { const float s2 = row_ssq64(acc, ai, m) * rs * rs; rs *= rsqrtf(s2 * (1.f / 64.f) + EPS); if (KIND == 2) rs *= C2; }
                if (KIND == 6) rs = rsqrtf(tot[ai][m] * (1.f / 256.f) + EPS);
                bf16_t* rowp = base + (size_t)row * ldc + colt + colw;
#pragma unroll
                for (int bj = 0; bj < 2; ++bj) {
                    f32x4 v0 = acc[ai][bj][m][0], v1 = acc[ai][bj][m][1];
                    if (KIND != 7) { v0 = v0 * rs; v1 = v1 * rs; }
                    if (KIND == 2 || KIND == 3 || KIND == 6) { v0 = v0 * g[bj][0]; v1 = v1 * g[bj][1]; }
                    if (KIND == 0) {
#pragma unroll
                        for (int e = 0; e < 4; ++e) { v0[e] = silu_f(v0[e]); v1[e] = silu_f(v1[e]); } }
                    *(u32x4*)(rowp + bj * 32) = pack8(v0, v1);
                }
            }
    }
    __device__ __forceinline__ void run(Acc& acc, const Unit& u, int wr, int wc, int fr, int fq, LAS unsigned char* xl, int lane) const {
        const int kind = u.kind; unsigned char* ws = PP->ws; const int colw = wc * 64 + 8 * fq;
        switch (kind) {
        case 0: body<0>(acc, u, wr, wc, fr, fq, xl, (bf16_t*)(ws + WS_ZS), 1024, u.pn * 256, nullptr); break;
        case 1: if (u.pn < 8) body<1>(acc, u, wr, wc, fr, fq, xl, (bf16_t*)((unsigned char*)PP->out + DO_XRAW), 1024, (u.pn - 4) * 256, nullptr);
                else body<1>(acc, u, wr, wc, fr, fq, xl, (bf16_t*)(ws + WS_BCR), 512, (u.pn - 8) * 256, nullptr); break;
        case 2: body<2>(acc, u, wr, wc, fr, fq, xl, (bf16_t*)(ws + WS_Q), 1024, (u.pn - 10) * 256, PP->g_q + 8 * fq); break;
        case 3: body<3>(acc, u, wr, wc, fr, fq, xl, (bf16_t*)(ws + WS_K), 1024, (u.pn - 14) * 256, PP->g_k + 8 * fq); break;
        case 4: body<1>(acc, u, wr, wc, fr, fq, xl, (bf16_t*)(ws + WS_V), 1024, (u.pn - 18) * 256, nullptr); break;
        case 6: body<6>(acc, u, wr, wc, fr, fq, xl, (bf16_t*)(ws + WS_KX), 1024, u.pn * 256, PP->xg_k + colw); break;
        case 7: body<7>(acc, u, wr, wc, fr, fq, xl, (bf16_t*)(ws + WS_VX), 1024, (u.pn - 4) * 256, nullptr); break;
        default: {
            if (wc == 0) {
                const int rowt = wr * 64 + fr, row0 = u.pm * BM + rowt; const LAS float* RSC = (const LAS float*)(xl + 4096) + rowt;
                const int c0 = 8 * fq; const bool isdt = fq < 2;
                const float* bias = isdt ? PP->dt_bias + c0 : PP->f_bias + (c0 - 16); float* dst = isdt ? (float*)(ws + WS_DT) + c0 : (float*)(ws + WS_LF) + (c0 - 16);
                const f32x4 b0 = *(const f32x4*)bias, b1 = *(const f32x4*)(bias + 4); const float sg = isdt ? 1.f : -1.f;
#pragma unroll
                for (int ai = 0; ai < 2; ++ai)
#pragma unroll
                    for (int m = 0; m < 4; ++m) { const int row = row0 + ai * HALF + m * 16; const float rs = RSC[ai * HALF + m * 16];
                        f32x4 v0 = acc[ai][0][m][0] * rs + b0, v1 = acc[ai][0][m][1] * rs + b1;
#pragma unroll
                        for (int e = 0; e < 4; ++e) { v0[e] = sg * softplus_fast(sg * v0[e]); v1[e] = sg * softplus_fast(sg * v1[e]); }
                        *(f32x4*)(dst + (size_t)row * 16) = v0; *(f32x4*)(dst + (size_t)row * 16 + 4) = v1; }
            } } break;
        }
    }
};
template <bool KSEG_, bool BASE_BF16> struct EpiRes {
    static constexpr bool KSEG = KSEG_;
    const void* base; bf16_t* XBo; float* SSQo; const float* SSQi;
    __device__ __forceinline__ void prepare(LAS unsigned char* xl, const Unit& u, int tid) const {
        if (KSEG_ && tid < 256) { const float* sp = SSQi + (size_t)(u.pm * BM + tid) * 16;
            const f32x4 a = *(const f32x4*)sp, b = *(const f32x4*)(sp + 4), c = *(const f32x4*)(sp + 8), d = *(const f32x4*)(sp + 12);
            const float q0 = ((a[0] + a[1]) + (a[2] + a[3])) + ((b[0] + b[1]) + (b[2] + b[3])), q1 = ((c[0] + c[1]) + (c[2] + c[3])) + ((d[0] + d[1]) + (d[2] + d[3]));
            const float r0 = rsqrtf(q0 * (1.f / 512.f) + EPS), r1 = rsqrtf(q1 * (1.f / 512.f) + EPS);
            ((LAS float*)(xl + 4096))[tid] = r0 / r1; ((LAS float*)(xl + 5120))[tid] = r1; } }
    __device__ __forceinline__ void kseg(Acc& acc, const Unit& u, int t, int wr, int fr, LAS unsigned char* xl) const {
        const LAS float* F = (const LAS float*)(xl + (t == 8 ? 4096 : 5120)) + wr * 64 + fr;
#pragma unroll
        for (int ai = 0; ai < 2; ++ai)
#pragma unroll
            for (int m = 0; m < 4; ++m) { const float f = F[ai * HALF + m * 16];
#pragma unroll
                for (int bj = 0; bj < 2; ++bj)
#pragma unroll
                    for (int n = 0; n < 2; ++n) acc[ai][bj][m][n] = acc[ai][bj][m][n] * f; }
    }
    __device__ __forceinline__ void run(Acc& acc, const Unit& u, int wr, int wc, int fr, int fq, LAS unsigned char* xl, int lane) const {
        const int row0 = u.pm * BM + wr * 64 + fr, col0 = u.pn * 256 + wc * 64 + 8 * fq;
#pragma unroll
        for (int ai = 0; ai < 2; ++ai) {
            f32x4 xr[4][2][2];
#pragma unroll
            for (int m = 0; m < 4; ++m) { const size_t off = (size_t)(row0 + ai * HALF + m * 16) * D + col0;
#pragma unroll
                for (int bj = 0; bj < 2; ++bj) {
                    if (BASE_BF16) { const u32x4 w = *(const u32x4*)((const bf16_t*)base + off + bj * 32);
                        xr[m][bj][0] = (f32x4){__uint_as_float(w.x << 16), __uint_as_float(w.x & 0xffff0000u), __uint_as_float(w.y << 16), __uint_as_float(w.y & 0xffff0000u)};
                        xr[m][bj][1] = (f32x4){__uint_as_float(w.z << 16), __uint_as_float(w.z & 0xffff0000u), __uint_as_float(w.w << 16), __uint_as_float(w.w & 0xffff0000u)}; }
                    else { xr[m][bj][0] = __builtin_nontemporal_load((const f32x4*)((const float*)base + off + bj * 32)); xr[m][bj][1] = __builtin_nontemporal_load((const f32x4*)((const float*)base + off + bj * 32 + 4)); } } }
            asm volatile("" ::: "memory");
#pragma unroll
            for (int m = 0; m < 4; ++m) { const int row = row0 + ai * HALF + m * 16; const size_t off = (size_t)row * D + col0; float s = 0.f;
#pragma unroll
                for (int bj = 0; bj < 2; ++bj) {
                    const f32x4 v0 = acc[ai][bj][m][0] + xr[m][bj][0], v1 = acc[ai][bj][m][1] + xr[m][bj][1];
                    *(u32x4*)(XBo + off + bj * 32) = pack8(v0, v1);
                    s += ((v0[0] * v0[0] + v0[1] * v0[1]) + (v0[2] * v0[2] + v0[3] * v0[3])) + ((v1[0] * v1[0] + v1[1] * v1[1]) + (v1[2] * v1[2] + v1[3] * v1[3])); }
                s += __shfl_xor(s, 16); s += __shfl_xor(s, 32);
                if (fq == 0) SSQo[(size_t)row * 16 + u.pn * 4 + wc] = s; }
            asm volatile("" ::: "memory"); }
    }
};
struct EpiXq {
    static constexpr bool KSEG = false;
    const float *SSQ2, *xg_q; bf16_t* QX;
    __device__ __forceinline__ void kseg(Acc&, const Unit&, int, int, int, LAS unsigned char*) const {}
    __device__ __forceinline__ void prepare(LAS unsigned char* xl, const Unit& u, int tid) const {
        if (tid < 256) ((LAS float*)(xl + 4096))[tid] = rsqrtf(sum16(SSQ2 + (size_t)(u.pm * BM + tid) * 16) * (1.f / 1024.f) + EPS); }
    __device__ __forceinline__ void run(Acc& acc, const Unit& u, int wr, int wc, int fr, int fq, LAS unsigned char* xl, int lane) const {
        const int row0 = u.pm * BM + wr * 64 + fr, colw = wc * 64 + 8 * fq;
        float tot[2][4];
        row_ssq256(acc, wr, wc, fr, fq, xl, tot);
        f32x4 g[2][2];
#pragma unroll
        for (int bj = 0; bj < 2; ++bj)
#pragma unroll
            for (int n = 0; n < 2; ++n) g[bj][n] = *(const f32x4*)(xg_q + colw + bj * 32 + n * 4);
#pragma unroll
        for (int ai = 0; ai < 2; ++ai)
#pragma unroll
            for (int m = 0; m < 4; ++m) { const int row = row0 + ai * HALF + m * 16;
                const float rs2 = ((const LAS float*)(xl + 4096))[wr * 64 + fr + ai * HALF + m * 16];
                const float rs = rs2 * rsqrtf(tot[ai][m] * rs2 * rs2 * (1.f / 256.f) + EPS) * CX2;
                bf16_t* rowp = QX + (size_t)row * D + u.pn * 256 + colw;
#pragma unroll
                for (int bj = 0; bj < 2; ++bj) *(u32x4*)(rowp + bj * 32) = pack8(acc[ai][bj][m][0] * rs * g[bj][0], acc[ai][bj][m][1] * rs * g[bj][1]); }
    }
};
struct EpiUp {
    static constexpr bool KSEG = false;
    const float* SSQ3; bf16_t* HB;
    __device__ __forceinline__ void kseg(Acc&, const Unit&, int, int, int, LAS unsigned char*) const {}
    __device__ __forceinline__ void prepare(LAS unsigned char* xl, const Unit& u, int tid) const {
        if (tid < 256) ((LAS float*)(xl + 4096))[tid] = rsqrtf(sum16(SSQ3 + (size_t)(u.pm * BM + tid) * 16) * (1.f / 1024.f) + EPS); }
    __device__ __forceinline__ void run(Acc& acc, const Unit& u, int wr, int wc, int fr, int fq, LAS unsigned char* xl, int lane) const {
        const int row0 = u.pm * BM + wr * 64 + fr, colw = wc * 64 + 8 * fq;
#pragma unroll
        for (int ai = 0; ai < 2; ++ai)
#pragma unroll
            for (int m = 0; m < 4; ++m) { const int row = row0 + ai * HALF + m * 16;
                const float rs = ((const LAS float*)(xl + 4096))[wr * 64 + fr + ai * HALF + m * 16];
                bf16_t* rowp = HB + (size_t)row * FF + u.pn * 256 + colw;
#pragma unroll
                for (int bj = 0; bj < 2; ++bj) { f32x4 v0 = acc[ai][bj][m][0] * rs, v1 = acc[ai][bj][m][1] * rs;
#pragma unroll
                    for (int e = 0; e < 4; ++e) { const float a = fmaxf(v0[e], 0.f), b = fmaxf(v1[e], 0.f); v0[e] = a * a; v1[e] = b * b; }
                    *(u32x4*)(rowp + bj * 32) = pack8(v0, v1); } }
    }
};
struct EpiDown {
    static constexpr bool KSEG = false;
    const bf16_t* X2B; float* out;
    __device__ __forceinline__ void kseg(Acc&, const Unit&, int, int, int, LAS unsigned char*) const {}
    __device__ __forceinline__ void prepare(LAS unsigned char*, const Unit&, int) const {}
    __device__ __forceinline__ void run(Acc& acc, const Unit& u, int wr, int wc, int fr, int fq, LAS unsigned char* xl, int lane) const {
        const int row0 = u.pm * BM + wr * 64 + fr, col0 = u.pn * 256 + wc * 64 + 8 * fq;
#pragma unroll
        for (int ai = 0; ai < 2; ++ai) {
            u32x4 w[4][2];
#pragma unroll
            for (int m = 0; m < 4; ++m)
#pragma unroll
                for (int bj = 0; bj < 2; ++bj) w[m][bj] = *(const u32x4*)(X2B + (size_t)(row0 + ai * HALF + m * 16) * D + col0 + bj * 32);
            asm volatile("" ::: "memory");
#pragma unroll
            for (int m = 0; m < 4; ++m) { const size_t off = (size_t)(row0 + ai * HALF + m * 16) * D + col0;
#pragma unroll
                for (int bj = 0; bj < 2; ++bj) { const u32x4 ww = w[m][bj];
                    const f32x4 x0 = (f32x4){__uint_as_float(ww.x << 16), __uint_as_float(ww.x & 0xffff0000u), __uint_as_float(ww.y << 16), __uint_as_float(ww.y & 0xffff0000u)};
                    const f32x4 x1 = (f32x4){__uint_as_float(ww.z << 16), __uint_as_float(ww.z & 0xffff0000u), __uint_as_float(ww.w << 16), __uint_as_float(ww.w & 0xffff0000u)};
                    *(f32x4*)(out + off + bj * 32) = acc[ai][bj][m][0] + x0; *(f32x4*)(out + off + bj * 32 + 4) = acc[ai][bj][m][1] + x1; } }
            asm volatile("" ::: "memory"); }
    }
};
}

namespace attn_body {
using bf16=__hip_bfloat16;
using bf16x8=__attribute__((ext_vector_type(8)))short;
using s16x4=__attribute__((ext_vector_type(4)))short;
using f32x16=__attribute__((ext_vector_type(16)))float;
using u32x4=__attribute__((ext_vector_type(4)))unsigned;
using f32x4_t=__attribute__((ext_vector_type(4)))float;
constexpr int BATCH=8,NHEAD=16,SEQ=2048,D=64,DM=NHEAD*D,OPITCH=2048,OCOL0=1024;
constexpr int NW=8,QBLK=32,QB=QBLK*NW,KVBLK=64,NQB=SEQ/QB;
constexpr int ATTN_PITCH=DM, ATTN_UNIT_ROWS=QB;
__device__ __forceinline__ int crow(int r,int hi){return (r&3)+8*(r>>2)+4*hi;}
#define SBAR() __builtin_amdgcn_sched_barrier(0)
__device__ __forceinline__ void cmask(f32x16&p0,f32x16&p1,int jb,int qrel,int hi){
  const float NEG=-INFINITY; int kb=64*jb+4*hi;
  #pragma unroll
  for(int r=0;r<16;++r){int kv=kb+(r&3)+8*(r>>2); if(kv>qrel)p0[r]=NEG; if(kv+32>qrel)p1[r]=NEG;}
}

constexpr int NSLOT=3, SLOTB=8192;
constexpr int LDS_K=0, LDS_V=NSLOT*SLOTB, LDS_WS=2*NSLOT*SLOTB, LDS_OST=LDS_WS+NW*64*4, LDS_CBL=LDS_OST+NW*4096, LDS_BYTES=LDS_CBL+SEQ*4;
__device__ __forceinline__ void glds16(const void*sbase,unsigned voff,unsigned lds_dst){unsigned keep;
  asm volatile("s_mov_b32 %0, m0\n\ts_mov_b32 m0, %2\n\ts_nop 4\n\tglobal_load_lds_dwordx4 %1, %3\n\ts_mov_b32 m0, %0":"=&s"(keep):"v"(voff),"s"(lds_dst),"s"(sbase):"memory");}
__device__ __forceinline__ float max3f(float a,float b,float c){float r;asm("v_max3_f32 %0, %1, %2, %3":"=v"(r):"v"(a),"v"(b),"v"(c));return r;}
__device__ __forceinline__ float max2f(float a,float b){float r;asm("v_max_f32_e32 %0, %1, %2":"=v"(r):"v"(a),"v"(b));return r;}
__device__ __forceinline__ float fadd_s(float a,float b){float r;asm("v_add_f32_e32 %0, %1, %2":"=v"(r):"v"(a),"v"(b));return r;}
__device__ __forceinline__ float fsub_s(float a,float b){float r;asm("v_sub_f32_e32 %0, %1, %2":"=v"(r):"v"(a),"v"(b));return r;}
typedef float f32x2_t __attribute__((ext_vector_type(2))); typedef __bf16 bf16x2_t __attribute__((ext_vector_type(2)));
__device__ __forceinline__ unsigned cvtpk_s(float lo,float hi){f32x2_t v={lo,hi};bf16x2_t b=__builtin_convertvector(v,bf16x2_t);return __builtin_bit_cast(unsigned,b);}
#define WAIT_BAR(N) asm volatile("s_waitcnt vmcnt(" #N ") lgkmcnt(0)\n\ts_barrier":::"memory")

__device__ __forceinline__ void qkt(f32x16&p0,f32x16&p1,const char*Kslot,const bf16x8*qr,int r32,int hi){
  const char*kb=Kslot+hi*1024+r32*16;
  #pragma unroll
  for(int d0=0;d0<4;++d0){
    const bf16x8 b0=*reinterpret_cast<const bf16x8*>(kb+d0*2048);
    const bf16x8 b1=*reinterpret_cast<const bf16x8*>(kb+d0*2048+512);
    p0=__builtin_amdgcn_mfma_f32_32x32x16_bf16(b0,qr[d0],p0,0,0,0);p1=__builtin_amdgcn_mfma_f32_32x32x16_bf16(b1,qr[d0],p1,0,0,0);}
}
typedef __attribute__((address_space(3))) const char* lds_cptr;
typedef short v4i16_t __attribute__((ext_vector_type(4)));
__device__ __forceinline__ void kload8(bf16x8*kf,lds_cptr kp){
  kf[0]=*(const __attribute__((address_space(3))) bf16x8*)(kp);      kf[1]=*(const __attribute__((address_space(3))) bf16x8*)(kp+512);
  kf[2]=*(const __attribute__((address_space(3))) bf16x8*)(kp+2048); kf[3]=*(const __attribute__((address_space(3))) bf16x8*)(kp+2560);
  kf[4]=*(const __attribute__((address_space(3))) bf16x8*)(kp+4096); kf[5]=*(const __attribute__((address_space(3))) bf16x8*)(kp+4608);
  kf[6]=*(const __attribute__((address_space(3))) bf16x8*)(kp+6144); kf[7]=*(const __attribute__((address_space(3))) bf16x8*)(kp+6656);
}
__device__ __forceinline__ void kload2(bf16x8*kf,lds_cptr kp,int j){ kf[2*j]=*(const __attribute__((address_space(3))) bf16x8*)(kp+j*2048); kf[2*j+1]=*(const __attribute__((address_space(3))) bf16x8*)(kp+j*2048+512); }
__device__ __forceinline__ s16x4 vtr(lds_cptr p){ return __builtin_bit_cast(s16x4,__builtin_amdgcn_ds_read_tr16_b64_v4i16((__attribute__((address_space(3))) v4i16_t*)p)); }
__device__ __forceinline__ float rowmax(const f32x16&p0,const f32x16&p1){
  float a=max3f(p0[0],p0[1],p1[0]),b=max3f(p0[2],p0[3],p1[1]);a=max3f(a,p1[2],p1[3]);
  #pragma unroll
  for(int r=4;r<16;r+=4){a=max3f(a,p0[r],p0[r+1]);b=max3f(b,p0[r+2],p0[r+3]);a=max3f(a,p1[r],p1[r+1]);b=max3f(b,p1[r+2],p1[r+3]);}
  const float m=max2f(a,b);
  auto rr=__builtin_amdgcn_permlane32_swap(__float_as_uint(m),__float_as_uint(m),false,false);
  return max2f(__uint_as_float(rr[0]),__uint_as_float(rr[1]));
}
__device__ __forceinline__ void pv(f32x16*o,int vb,bf16x8 pa0,bf16x8 pa1,bf16x8 pa2,bf16x8 pa3){
  #pragma unroll
  for(int d0=0;d0<2;++d0){s16x4 lo[4],hi[4];
    #pragma unroll
    for(int ks=0;ks<4;++ks){
      asm volatile("ds_read_b64_tr_b16 %0,%1 offset:%c2":"=&v"(lo[ks]):"v"(vb),"i"(d0*4096+ks*1024):"memory");
      asm volatile("ds_read_b64_tr_b16 %0,%1 offset:%c2":"=&v"(hi[ks]):"v"(vb),"i"(d0*4096+ks*1024+512):"memory");}
    asm volatile("s_waitcnt lgkmcnt(0)":::"memory");SBAR();
    #define PK(k) (bf16x8){lo[k][0],lo[k][1],lo[k][2],lo[k][3],hi[k][0],hi[k][1],hi[k][2],hi[k][3]}
    o[d0]=__builtin_amdgcn_mfma_f32_32x32x16_bf16(pa0,PK(0),o[d0],0,0,0);
    o[d0]=__builtin_amdgcn_mfma_f32_32x32x16_bf16(pa1,PK(1),o[d0],0,0,0);
    o[d0]=__builtin_amdgcn_mfma_f32_32x32x16_bf16(pa2,PK(2),o[d0],0,0,0);
    o[d0]=__builtin_amdgcn_mfma_f32_32x32x16_bf16(pa3,PK(3),o[d0],0,0,0);
    #undef PK
  }
}

#ifndef ATTN_STORE16
#define ATTN_STORE16(p,v) (*(u32x4*)(p)=(v))
#endif
template<int THRL> __device__ __forceinline__ void attn_unit(int b,int h,int qb,const bf16*Q,const bf16*__restrict__ K,const bf16*__restrict__ V,bf16*O,char*shm,int&r0,const bool pre,const bool pre_next){
  const int tid=threadIdx.x,lane=tid&63,r32=lane&31,hi=lane>>5; const int wid=__builtin_amdgcn_readfirstlane(tid>>6);
  const long rowbase=(long)b*SEQ; const int q0=qb*QB;
  const bf16*Qw=Q+(rowbase+q0+wid*QBLK)*DM+h*D;
  const bf16*Kh=K+rowbase*DM+h*D,*Vh=V+rowbase*DM+h*D;
  const unsigned lds0=(unsigned)(uintptr_t)shm;
  float*wsf=(float*)(shm+LDS_WS)+wid*64;
  const unsigned koff=(unsigned)((lane*DM+wid*8)*2);
  const unsigned voff=(unsigned)(((16*(wid&3)+(lane>>2))*DM+(wid>>2)*32+(lane&3)*8)*2);
  const unsigned kdst=lds0+LDS_K+wid*1024, vdst=lds0+LDS_V+wid*1024;
  #define DMA_K(t,slot) glds16(Kh+(long)(t)*KVBLK*DM,koff,(unsigned)__builtin_amdgcn_readfirstlane(kdst+(slot)))
  #define DMA_V(t,slot) glds16(Vh+(long)(t)*KVBLK*DM,voff,(unsigned)__builtin_amdgcn_readfirstlane(vdst+(slot)))
  const int vb0=(int)(lds0+LDS_V)+((lane>>4)&1)*32+(lane&3)*8+(4*hi+((lane&15)>>2))*64;
  const char*Kbase=shm+LDS_K; bf16x8 kf[8];
  const lds_cptr shm3=(lds_cptr)shm; const lds_cptr kp0=shm3+LDS_K+hi*1024+r32*16; const lds_cptr vp0=shm3+LDS_V+((lane>>4)&1)*32+(lane&3)*8+(4*hi+((lane&15)>>2))*64;
  const int NT=(q0+QB)/KVBLK;
  const int s0=r0*SLOTB, s1=(r0==2?0:r0+1)*SLOTB, s2=(r0==0?2:r0-1)*SLOTB;
  if(!pre){ DMA_K(0,s0);DMA_V(0,s0);DMA_K(1,s1); }
  bf16x8 qr[4];
  #pragma unroll
  for(int d0=0;d0<4;++d0)qr[d0]=*reinterpret_cast<const bf16x8*>(&Qw[(long)r32*DM+d0*16+hi*8]);
  float mhat=0.f,l_reg=0.f;f32x16 o[2];o[0]=f32x16{};o[1]=f32x16{};
  const int qrel=wid*QBLK+r32;
  #define CMASK(P0,P1,t) do{int jb_=(t)-(NT-4); if(jb_>=0)cmask(P0,P1,jb_,qrel,hi);}while(0)
  typedef __attribute__((address_space(3))) const f32x4_t* lds_f4p;
  #define CIN(C0,C1,t) do{ const float nm_=-mhat; const lds_f4p cp_=(lds_f4p)(shm3+LDS_CBL+(t)*256+hi*16); \
    const f32x4_t b0_=cp_[0],b1_=cp_[2],b2_=cp_[4],b3_=cp_[6],b4_=cp_[8],b5_=cp_[10],b6_=cp_[12],b7_=cp_[14]; \
    _Pragma("unroll") for(int e_=0;e_<4;++e_){ C0[e_]=nm_-b0_[e_]; C0[4+e_]=nm_-b1_[e_]; C0[8+e_]=nm_-b2_[e_]; C0[12+e_]=nm_-b3_[e_]; C1[e_]=nm_-b4_[e_]; C1[4+e_]=nm_-b5_[e_]; C1[8+e_]=nm_-b6_[e_]; C1[12+e_]=nm_-b7_[e_]; } \
    asm volatile("":"+v"(C0),"+v"(C1)); }while(0)
  bool resc=false;
  #define START(P0,P1) do{ const float rm=rowmax(P0,P1); resc=false; \
    { const float dl=rm; mhat=fadd_s(mhat,dl); \
      _Pragma("unroll") for(int r=0;r<16;++r){P0[r]=fsub_s(P0[r],dl);P1[r]=fsub_s(P1[r],dl);} } \
    _Pragma("unroll") for(int r=0;r<16;++r)P0[r]=__builtin_amdgcn_exp2f(P0[r]); }while(0)
  #define RESC() do{ if(resc){ asm volatile("s_waitcnt lgkmcnt(0)":::"memory"); \
      _Pragma("unroll") for(int d_=0;d_<2;++d_) _Pragma("unroll") for(int r=0;r<16;++r)o[d_][r]*=wsf[crow(r,hi)]; } }while(0)
  f32x16 pA0,pA1,pB0,pB1;
  int sl_prev=s0,sl_cur=s0,sl_next=s1;
  #define ROT() do{sl_prev=sl_cur;sl_cur=sl_next;sl_next=(sl_next==(NSLOT-1)*SLOTB)?0:sl_next+SLOTB;}while(0)
  if(!pre){ DMA_K(2,s2); }
  WAIT_BAR(3);
  CIN(pA0,pA1,0);
  qkt(pA0,pA1,Kbase+s0,qr,r32,hi);asm volatile("s_nop 15\n\ts_nop 7":"+v"(pA0),"+v"(pA1));CMASK(pA0,pA1,0);
  START(pA0,pA1);
  _Pragma("unroll") for(int r=0;r<16;++r)pA1[r]=__builtin_amdgcn_exp2f(pA1[r]);
  WAIT_BAR(0);
  DMA_K(3,s0);DMA_V(1,s1);
  ROT();
  kload8(kf,kp0+sl_cur);
  WAIT_BAR(2);
  s16x4 vlo[8],vhi[8]; u32x4 pw0,pw1,pw2,pw3;
  #define PKW(P,B) cvtpk_s(P[B],P[B+1])
  #define PAF(k) __builtin_bit_cast(bf16x8,pw##k)
  #define VFR(i) (bf16x8){vlo[i][0],vlo[i][1],vlo[i][2],vlo[i][3],vhi[i][0],vhi[i][1],vhi[i][2],vhi[i][3]}
  #define PIN(x) asm volatile("":"+v"(x))
  #define MX3(a,b,c) __builtin_fmaxf(__builtin_fmaxf((a),(b)),(c))
  #define GAPA(MF,A0,A1,A2,A3,W0,W1,PW) do{ MF; sacc+=A0; sacc+=A1; sacc+=A2; sacc+=A3; PIN(sacc); W0; W1; PIN(PW); SBAR(); }while(0)
  #define EX(v) __builtin_amdgcn_exp2f(v)
  #define GAPB(MF,X,B) do{ MF; X[B]=EX(X[B]); X[B+1]=EX(X[B+1]); X[B+2]=EX(X[B+2]); X[B+3]=EX(X[B+3]); PIN(X); SBAR(); }while(0)
  #define VRD(i) do{ vlo[i]=vtr(vp_+(((i)>>2)*4096+((i)&3)*1024)); vhi[i]=vtr(vp_+(((i)>>2)*4096+((i)&3)*1024+512)); }while(0)
  #define KRD(G,j) do{ if(G){ kload2(kf,kp0+sl_next,j); SBAR(); } }while(0)
  #define STEP(C0,C1,P0,P1,t,GK,GV,GL) do{ SBAR(); CIN(C0,C1,t); SBAR(); \
    const lds_cptr vp_=vp0+sl_prev; \
    VRD(0); SBAR(); float sacc=(P0[0]+P0[1]); \
    GAPA(C0=__builtin_amdgcn_mfma_f32_32x32x16_bf16(kf[0],qr[0],C0,0,0,0), P0[2],P0[3],P0[4],P0[5],     pw0[0]=PKW(P0,0), pw0[1]=PKW(P0,2), pw0); \
    VRD(4); SBAR(); GAPA(C1=__builtin_amdgcn_mfma_f32_32x32x16_bf16(kf[1],qr[0],C1,0,0,0), P0[6],P0[7],P0[8],P0[9],     pw0[2]=PKW(P0,4), pw0[3]=PKW(P0,6), pw0); \
    VRD(1); SBAR(); GAPA(C0=__builtin_amdgcn_mfma_f32_32x32x16_bf16(kf[2],qr[1],C0,0,0,0),   P0[10],P0[11],P0[12],P0[13], pw1[0]=PKW(P0,8), pw1[1]=PKW(P0,10), pw1); \
    VRD(5); SBAR(); GAPA(C1=__builtin_amdgcn_mfma_f32_32x32x16_bf16(kf[3],qr[1],C1,0,0,0),   P0[14],P0[15],P1[0],P1[1],   pw1[2]=PKW(P0,12),pw1[3]=PKW(P0,14), pw1); \
    VRD(2); SBAR(); GAPA(C0=__builtin_amdgcn_mfma_f32_32x32x16_bf16(kf[4],qr[2],C0,0,0,0),   P1[2],P1[3],P1[4],P1[5],     pw2[0]=PKW(P1,0), pw2[1]=PKW(P1,2), pw2); \
    VRD(6); SBAR(); GAPA(C1=__builtin_amdgcn_mfma_f32_32x32x16_bf16(kf[5],qr[2],C1,0,0,0),   P1[6],P1[7],P1[8],P1[9],     pw2[2]=PKW(P1,4), pw2[3]=PKW(P1,6), pw2); \
    VRD(3); SBAR(); GAPA(C0=__builtin_amdgcn_mfma_f32_32x32x16_bf16(kf[6],qr[3],C0,0,0,0),   P1[10],P1[11],P1[12],P1[13], pw3[0]=PKW(P1,8), pw3[1]=PKW(P1,10), pw3); \
    VRD(7); SBAR(); GAPA(C1=__builtin_amdgcn_mfma_f32_32x32x16_bf16(kf[7],qr[3],C1,0,0,0),   P1[14],P1[15],0.f,0.f,       pw3[2]=PKW(P1,12),pw3[3]=PKW(P1,14), pw3); \
    l_reg+=sacc; \
    if(GK){DMA_K((t)+3,sl_cur);} if(GV){DMA_V((t)+1,sl_next);} \
    CMASK(C0,C1,t); \
    { float a=MX3(C0[0],C0[1],C1[0]),b=MX3(C0[2],C0[3],C1[1]); a=MX3(a,C1[2],C1[3]); \
      _Pragma("unroll") for(int r=4;r<16;r+=4){a=MX3(a,C0[r],C0[r+1]);b=MX3(b,C0[r+2],C0[r+3]);a=MX3(a,C1[r],C1[r+1]);b=MX3(b,C1[r+2],C1[r+3]);} \
      float rm=__builtin_fmaxf(a,b); { auto rr=__builtin_amdgcn_permlane32_swap(__float_as_uint(rm),__float_as_uint(rm),false,false); rm=__builtin_fmaxf(__uint_as_float(rr[0]),__uint_as_float(rr[1])); } \
      resc=false; \
      if(__builtin_expect(__any(rm>(float)THRL),0)){ const float dl=__builtin_fmaxf(rm,0.f); mhat+=dl; \
        _Pragma("unroll") for(int r=0;r<16;++r){C0[r]-=dl;C1[r]-=dl;} \
        const float f=__builtin_amdgcn_exp2f(-dl); l_reg*=f; if(hi==0)wsf[r32]=f; resc=true; } } \
    SBAR(); \
    GAPB(o[0]=__builtin_amdgcn_mfma_f32_32x32x16_bf16(PAF(0),VFR(0),o[0],0,0,0), C0,0); \
    GAPB(o[1]=__builtin_amdgcn_mfma_f32_32x32x16_bf16(PAF(0),VFR(4),o[1],0,0,0), C0,4); \
    KRD(GL,0); GAPB(o[0]=__builtin_amdgcn_mfma_f32_32x32x16_bf16(PAF(1),VFR(1),o[0],0,0,0), C0,8); \
    KRD(GL,1); GAPB(o[1]=__builtin_amdgcn_mfma_f32_32x32x16_bf16(PAF(1),VFR(5),o[1],0,0,0), C0,12); \
    KRD(GL,2); GAPB(o[0]=__builtin_amdgcn_mfma_f32_32x32x16_bf16(PAF(2),VFR(2),o[0],0,0,0), C1,0); \
    KRD(GL,3); GAPB(o[1]=__builtin_amdgcn_mfma_f32_32x32x16_bf16(PAF(2),VFR(6),o[1],0,0,0), C1,4); \
    GAPB(o[0]=__builtin_amdgcn_mfma_f32_32x32x16_bf16(PAF(3),VFR(3),o[0],0,0,0), C1,8); \
    GAPB(o[1]=__builtin_amdgcn_mfma_f32_32x32x16_bf16(PAF(3),VFR(7),o[1],0,0,0), C1,12); \
    }while(0)
  int t=1;
  #undef CMASK
  #define CMASK(P0,P1,t) do{}while(0)
  for(;t+5<NT;t+=2){
    STEP(pB0,pB1,pA0,pA1,t,true,true,true);     WAIT_BAR(2); RESC(); ROT();
    STEP(pA0,pA1,pB0,pB1,t+1,true,true,true);   WAIT_BAR(2); RESC(); ROT();
  }
  #undef CMASK
  #define CMASK(P0,P1,t) do{int jb_=(t)-(NT-4); if(jb_>=0)cmask(P0,P1,jb_,qrel,hi);}while(0)
  #define ENDW(tt) do{ if((tt)+3<NT){WAIT_BAR(2);} else if((tt)+2<NT){WAIT_BAR(1);} else {WAIT_BAR(0);} }while(0)
  for(;t+1<NT;t+=2){
    STEP(pB0,pB1,pA0,pA1,t,(t+3<NT),(t+1<NT),(t+1<NT));       ENDW(t);   RESC(); ROT();
    STEP(pA0,pA1,pB0,pB1,t+1,(t+4<NT),(t+2<NT),(t+2<NT));     ENDW(t+1); RESC(); ROT();
  }
  STEP(pB0,pB1,pA0,pA1,NT-1,false,false,false); RESC();
  { const int rn=(r0+NT)%3;
    if(pre_next){ const int n0=rn*SLOTB, n1=(rn==2?0:rn+1)*SLOTB, n2=(rn==0?2:rn-1)*SLOTB;
      DMA_K(0,n0);DMA_V(0,n0);DMA_K(1,n1);DMA_K(2,n2); }
    r0=rn; }
  { float sacc=pB0[0]+pB0[1]; _Pragma("unroll") for(int r=2;r<16;++r)sacc+=pB0[r]; _Pragma("unroll") for(int r=0;r<16;++r)sacc+=pB1[r]; l_reg+=sacc;
    pw0=(u32x4){PKW(pB0,0),PKW(pB0,2),PKW(pB0,4),PKW(pB0,6)};pw1=(u32x4){PKW(pB0,8),PKW(pB0,10),PKW(pB0,12),PKW(pB0,14)};pw2=(u32x4){PKW(pB1,0),PKW(pB1,2),PKW(pB1,4),PKW(pB1,6)};pw3=(u32x4){PKW(pB1,8),PKW(pB1,10),PKW(pB1,12),PKW(pB1,14)};
    SBAR(); pv(o,vb0+sl_cur,PAF(0),PAF(1),PAF(2),PAF(3)); }
  #undef PKW
  #undef PAF
  #undef VFR
  #undef PIN
  #undef MX3
  #undef GAPA
  #undef GAPB
  #undef EX
  #undef VRD
  #undef KRD
  #undef STEP
  #undef ENDW
  {auto rr=__builtin_amdgcn_permlane32_swap(__float_as_uint(l_reg),__float_as_uint(l_reg),false,false);l_reg=__uint_as_float(rr[0])+__uint_as_float(rr[1]);}
  if(hi==0)wsf[32+r32]=l_reg;asm volatile("s_waitcnt lgkmcnt(0)":::"memory");
  float rli[16];
  #pragma unroll
  for(int r=0;r<16;++r)rli[r]=__builtin_amdgcn_rcpf(wsf[32+crow(r,hi)]);
  bf16*Ow=O+(rowbase+q0+wid*QBLK)*OPITCH+OCOL0+h*D;
  { bf16*stg=(bf16*)(shm+LDS_OST)+wid*2048;
    #pragma unroll
    for(int r=0;r<16;++r){const int orow=crow(r,hi);
      #pragma unroll
      for(int d0=0;d0<2;++d0)stg[orow*64+d0*32+r32]=__float2bfloat16(o[d0][r]*rli[r]);}
    asm volatile("s_waitcnt lgkmcnt(0)":::"memory");
    #pragma unroll
    for(int i=0;i<4;++i){const int row=i*8+(lane>>3),ch=lane&7; const u32x4 v=*(const u32x4*)(stg+row*64+ch*8); ATTN_STORE16(Ow+(long)row*OPITCH+ch*8,v);} }
  asm volatile("s_waitcnt lgkmcnt(0)\n\ts_barrier":::"memory");
  #undef DMA_K
  #undef DMA_V
  #undef CMASK
  #undef START
  #undef RESC
  #undef ROT
  #undef CIN
}
constexpr int ATTN_LDS_BYTES=LDS_BYTES;
struct AttnTensors { const bf16* Q; const bf16* K; const bf16* V; bf16* O; };
struct AttnUnit { int bh; int qb; };
struct StaticOrder {
  int vcu;
  __device__ __forceinline__ explicit StaticOrder(int v):vcu(v){}
  __device__ __forceinline__ bool next(int i,AttnUnit&u)const{ u.bh=vcu>>1;
    if((vcu&1)==0){ if(i>=2)return false; u.qb=(i==0)?6:2; }
    else { if(i>=6)return false; u.qb=(i==0)?7:(i==1)?5:(i==2)?4:(i==3)?3:(i==4)?1:0; }
    return true; }
  __device__ __forceinline__ void a_ready(const AttnUnit&)const{}
  __device__ __forceinline__ void done(const AttnUnit&)const{}
};
struct AttnTensorsB { const bf16* Q; const bf16* K; const bf16* V; bf16* O; const float* CB; };
template<class Sched,int THRL=20> __device__ __forceinline__ void attn_phase(char*lds,const AttnTensorsB&T,const Sched&S){
  AttnUnit u; int cur_bh=-1; int r0=0; bool pre=false;
  for(int i=0;S.next(i,u);++i){ S.a_ready(u);
    if(u.bh!=cur_bh){ cur_bh=u.bh; float*cbl=(float*)(lds+LDS_CBL); const float*src=T.CB+(size_t)u.bh*SEQ;
      int j0=threadIdx.x; asm volatile("":"+v"(j0));
      for(int j=j0;j<SEQ/4;j+=NW*64) ((f32x4_t*)cbl)[j]=((const f32x4_t*)src)[j];
      __syncthreads(); }
    AttnUnit un; const bool has_next=S.next(i+1,un)&&un.bh==u.bh;
    attn_unit<THRL>(u.bh/NHEAD,u.bh%NHEAD,u.qb,T.Q,T.K,T.V,T.O,lds,r0,pre,has_next); pre=has_next; S.done(u); }
}
#undef SBAR
#undef WAIT_BAR
}

namespace xattn {
typedef short bf16x8 __attribute__((ext_vector_type(8)));
typedef short s16x4 __attribute__((ext_vector_type(4)));
typedef short v4i16_t __attribute__((ext_vector_type(4)));
typedef float f32x16 __attribute__((ext_vector_type(16)));
typedef unsigned u32x4 __attribute__((ext_vector_type(4)));
constexpr int LDS_KV = 0, LDS_OST = 131072, LDS_WSF = LDS_OST + 8 * 2048, LDS_BYTES = LDS_WSF + 8 * 256;
__device__ __forceinline__ int crow(int r, int hi) { return (r & 3) + 8 * (r >> 2) + 4 * hi; }
__device__ __forceinline__ unsigned cvtpk(float lo, float hi) { typedef float f2 __attribute__((ext_vector_type(2))); typedef __bf16 b2 __attribute__((ext_vector_type(2))); f2 v = {lo, hi}; b2 b = __builtin_convertvector(v, b2); return __builtin_bit_cast(unsigned, b); }
__device__ __forceinline__ void xattn_unit(const bf16_t* QX, const bf16_t* KX, const bf16_t* VX, bf16_t* OX, int b, int h, int qb, LAS unsigned char* lds) {
    const int tid = threadIdx.x, lane = tid & 63, r32 = lane & 31, hi = lane >> 5, wid = __builtin_amdgcn_readfirstlane(tid >> 6);
#pragma unroll
    for (int i = 0; i < 16; ++i) { const int p = wid * 16 + i, c = p >> 2, rg = p & 3;
        __builtin_amdgcn_global_load_lds((const unsigned*)(KX + (size_t)(b * MEML + rg * 64 + lane) * D + h * XHD + c * 8), (LAS unsigned*)(lds + LDS_KV + c * 4096 + rg * 1024), 16, 0, 0); }
    const size_t qrow0 = (size_t)b * SEQ + qb * 256 + wid * 32;
    bf16x8 qf[8];
#pragma unroll
    for (int s_ = 0; s_ < 8; ++s_) qf[s_] = *(const bf16x8*)(QX + (qrow0 + r32) * D + h * XHD + 16 * s_ + 8 * hi);
    asm volatile("s_waitcnt vmcnt(0)" ::: "memory"); __builtin_amdgcn_s_barrier(); asm volatile("" ::: "memory");
    f32x16 S[8];
#pragma unroll
    for (int kb = 0; kb < 8; ++kb) S[kb] = f32x16{};
#pragma unroll
    for (int half = 0; half < 2; ++half) {
        if (half == 1) {
#pragma unroll
            for (int s_ = 0; s_ < 8; ++s_) qf[s_] = *(const bf16x8*)(QX + (qrow0 + r32) * D + h * XHD + 16 * (8 + s_) + 8 * hi);
        }
#pragma unroll
        for (int s_ = 0; s_ < 8; ++s_) { bf16x8 kf[8];
#pragma unroll
            for (int kb = 0; kb < 8; ++kb) kf[kb] = *(const LAS bf16x8*)(lds + LDS_KV + (2 * (8 * half + s_) + hi) * 4096 + (32 * kb + r32) * 16);
            __builtin_amdgcn_sched_barrier(0);
#pragma unroll
            for (int kb = 0; kb < 8; ++kb) S[kb] = __builtin_amdgcn_mfma_f32_32x32x16_bf16(kf[kb], qf[s_], S[kb], 0, 0, 0);
            __builtin_amdgcn_sched_barrier(0); }
        asm volatile("" ::: "memory");
    }
    float mx = S[0][0];
#pragma unroll
    for (int kb = 0; kb < 8; ++kb)
#pragma unroll
        for (int r = 0; r < 16; ++r) mx = fmaxf(mx, S[kb][r]);
    { auto rr = __builtin_amdgcn_permlane32_swap(__float_as_uint(mx), __float_as_uint(mx), false, false); mx = fmaxf(__uint_as_float(rr[0]), __uint_as_float(rr[1])); }
    float l = 0.f;
#pragma unroll
    for (int kb = 0; kb < 8; ++kb)
#pragma unroll
        for (int r = 0; r < 16; ++r) { const float p = __builtin_amdgcn_exp2f(S[kb][r] - mx); S[kb][r] = p; l += p; }
    { auto rr = __builtin_amdgcn_permlane32_swap(__float_as_uint(l), __float_as_uint(l), false, false); l = __uint_as_float(rr[0]) + __uint_as_float(rr[1]); }
    u32x4 pw[16];
#pragma unroll
    for (int kb = 0; kb < 8; ++kb)
#pragma unroll
        for (int sp = 0; sp < 2; ++sp) { u32x4 w; w.x = cvtpk(S[kb][8 * sp + 0], S[kb][8 * sp + 1]); w.y = cvtpk(S[kb][8 * sp + 2], S[kb][8 * sp + 3]); w.z = cvtpk(S[kb][8 * sp + 4], S[kb][8 * sp + 5]); w.w = cvtpk(S[kb][8 * sp + 6], S[kb][8 * sp + 7]); pw[2 * kb + sp] = w; }
    asm volatile("s_waitcnt lgkmcnt(0)" ::: "memory"); __builtin_amdgcn_s_barrier(); asm volatile("" ::: "memory");
#pragma unroll
    for (int i = 0; i < 16; ++i) { const int p = wid * 16 + i, dblk = p >> 4, kg = p & 15;
        __builtin_amdgcn_global_load_lds((const unsigned*)(VX + (size_t)(b * MEML + kg * 16 + (lane >> 2)) * D + h * XHD + dblk * 32 + (lane & 3) * 8), (LAS unsigned*)(lds + LDS_KV + dblk * 16384 + kg * 1024), 16, 0, 0); }
    LAS float* wsf = (LAS float*)(lds + LDS_WSF) + wid * 64;
    if (hi == 0) wsf[r32] = l;
    asm volatile("s_waitcnt vmcnt(0) lgkmcnt(0)" ::: "memory"); __builtin_amdgcn_s_barrier(); asm volatile("" ::: "memory");
    float rli[16];
#pragma unroll
    for (int r = 0; r < 16; ++r) rli[r] = __builtin_amdgcn_rcpf(wsf[crow(r, hi)]);
    const LAS unsigned char* vb = lds + LDS_KV + ((lane >> 4) & 1) * 32 + (lane & 3) * 8 + (4 * hi + ((lane & 15) >> 2)) * 64;
    LAS bf16_t* stg = (LAS bf16_t*)(lds + LDS_OST + wid * 2048);
#pragma unroll 1
    for (int dblk = 0; dblk < 8; ++dblk) {
        f32x16 o = f32x16{};
#pragma unroll
        for (int kh = 0; kh < 2; ++kh) { bf16x8 vf[8];
#pragma unroll
            for (int k8 = 0; k8 < 8; ++k8) { const int ks = 8 * kh + k8;
                const s16x4 lo = __builtin_bit_cast(s16x4, __builtin_amdgcn_ds_read_tr16_b64_v4i16((LAS v4i16_t*)(vb + dblk * 16384 + ks * 1024)));
                const s16x4 hh = __builtin_bit_cast(s16x4, __builtin_amdgcn_ds_read_tr16_b64_v4i16((LAS v4i16_t*)(vb + dblk * 16384 + ks * 1024 + 512)));
                vf[k8] = (bf16x8){lo[0], lo[1], lo[2], lo[3], hh[0], hh[1], hh[2], hh[3]}; }
            __builtin_amdgcn_sched_barrier(0);
#pragma unroll
            for (int k8 = 0; k8 < 8; ++k8) o = __builtin_amdgcn_mfma_f32_32x32x16_bf16(__builtin_bit_cast(bf16x8, pw[8 * kh + k8]), vf[k8], o, 0, 0, 0);
            __builtin_amdgcn_sched_barrier(0); }
#pragma unroll
        for (int r = 0; r < 16; ++r) stg[crow(r, hi) * 32 + r32] = (bf16_t)f2bf(o[r] * rli[r]);
        asm volatile("s_waitcnt lgkmcnt(0)" ::: "memory");
#pragma unroll
        for (int i = 0; i < 2; ++i) { const int idx = lane + 64 * i, row = idx >> 2, ch = idx & 3; const u32x4 v = *(const LAS u32x4*)(stg + row * 32 + ch * 8);
            *(u32x4*)(OX + (qrow0 + row) * D + h * XHD + dblk * 32 + ch * 8) = v; }
        asm volatile("s_waitcnt lgkmcnt(0)" ::: "memory");
    }
    asm volatile("s_waitcnt lgkmcnt(0)" ::: "memory"); __builtin_amdgcn_s_barrier(); asm volatile("" ::: "memory");
}
}

namespace ssd {
typedef short bf16x8 __attribute__((ext_vector_type(8)));
typedef short s16x4 __attribute__((ext_vector_type(4)));
typedef short v4i16_t __attribute__((ext_vector_type(4)));
typedef float f32x16 __attribute__((ext_vector_type(16)));
typedef unsigned u32x4 __attribute__((ext_vector_type(4)));
typedef unsigned u32x2 __attribute__((ext_vector_type(2)));
constexpr int L_B = 0, L_C = 32768, L_XD = 65536, L_XDD = 81920, L_SIN = 98304, L_Y = 114688, L_A2 = 147456, L_FL = 147968  , L_DT = 150528, L_CW = 151040, LDS_BYTES = 152320;
__device__ __forceinline__ int crow(int r, int hi) { return (r & 3) + 8 * (r >> 2) + 4 * hi; }
__device__ __forceinline__ unsigned cvtpk(float lo, float hi) { typedef float f2 __attribute__((ext_vector_type(2))); typedef __bf16 b2 __attribute__((ext_vector_type(2))); f2 v = {lo, hi}; b2 b = __builtin_convertvector(v, b2); return __builtin_bit_cast(unsigned, b); }
__device__ __forceinline__ bf16x8 trpair(const LAS unsigned char* p, int second_off) {
    const s16x4 lo = __builtin_bit_cast(s16x4, __builtin_amdgcn_ds_read_tr16_b64_v4i16((LAS v4i16_t*)(p)));
    const s16x4 hh = __builtin_bit_cast(s16x4, __builtin_amdgcn_ds_read_tr16_b64_v4i16((LAS v4i16_t*)(p + second_off)));
    return (bf16x8){lo[0], lo[1], lo[2], lo[3], hh[0], hh[1], hh[2], hh[3]};
}
#define SSD_BAR() do { asm volatile("s_waitcnt lgkmcnt(0)" ::: "memory"); __builtin_amdgcn_s_barrier(); asm volatile("" ::: "memory"); } while (0)
__device__ __forceinline__ void ssd_item(const KAS Ptrs& P, int bh, LAS unsigned char* lds) {
    const int tid = threadIdx.x, lane = tid & 63, r32 = lane & 31, hi = lane >> 5, wid = __builtin_amdgcn_readfirstlane(tid >> 6);
    const int lb = wid < 4 ? (wid >> 1) : 3 - ((wid - 4) >> 1), pb = wid & 1, par = pb;
    const int b = bh / NH, h = bh % NH, g = h / 8;
    unsigned char* ws = P.ws;
    const bf16_t* XA = (const bf16_t*)(ws + WS_BCA) + (size_t)b * SEQ * 512;
    const bf16_t* XRh = (const bf16_t*)((const unsigned char*)P.out + DO_XRAW) + (size_t)b * SEQ * 1024 + h * 64;
    const bf16_t* ZS = (const bf16_t*)(ws + WS_ZS) + (size_t)b * SEQ * 1024 + h * 64;
    const float* DTT = (const float*)(ws + WS_DTT) + (size_t)bh * SEQ; const float* ACS = (const float*)(ws + WS_ACS) + (size_t)bh * SEQ;
    bf16_t* MX = (bf16_t*)(ws + WS_MIXED) + (size_t)b * SEQ * MIXW + h * 64; float* SSQ = (float*)(ws + WS_SSQ) + (size_t)b * SEQ * 16 + h;
    const bf16_t* CBTw = (const bf16_t*)(ws + WS_CBT) + ((size_t)(b * NCH * NGRP + g) * 10 + lb * (lb + 1) / 2) * 64 * 16 + lane * 16;
    const float Dk = P.d_skip[h];
    f32x16 sacc = f32x16{};
    for (int i = tid; i < 16384 / 16; i += NTHR) ((LAS u32x4*)(lds + L_SIN))[i] = (u32x4){0u, 0u, 0u, 0u};
    if (tid < 320) ((LAS float*)(lds + L_CW))[tid] = tid < 256 ? P.conv_w[(tid >> 6) * CONVD + h * 64 + (tid & 63)] : P.conv_b[h * 64 + (tid & 63)];
    const int brow = tid & 127, bch0 = tid >> 7;
    const int srow0 = tid >> 4, sch = tid & 15;
#define SSD_IMG(row, ch) ((row) * 256 + ((((ch) ^ (row)) & 15) << 4))
    const int xr2 = tid >> 3, xpc = tid & 7;
    u32x4 pB[4], pC[4], pXr[5]; float pdt[2], pac[2], pa127 = 0.f, pas = 0.f, pdtb = 0.f;
    u32x4 ez0, ez1;
    const int el = tid >> 2, ep0 = (tid & 3) * 16;
#define SSD_PREFETCH(c) do { const int t0_ = (c) * CHUNK; \
        _Pragma("unroll") for (int i = 0; i < 4; ++i) { const bf16_t* rp = XA + (size_t)(t0_ + srow0 + 32 * i) * 512 + g * 128 + sch * 8; pB[i] = *(const u32x4*)rp; pC[i] = *(const u32x4*)(rp + 256); } \
        _Pragma("unroll") for (int j = 0; j < 5; ++j) { const int tr_ = t0_ + 2 * xr2 - 3 + j; pXr[j] = (u32x4){0u, 0u, 0u, 0u}; if (tr_ >= 0) pXr[j] = *(const u32x4*)(XRh + (size_t)tr_ * 1024 + xpc * 8); } \
        _Pragma("unroll") for (int i = 0; i < 2; ++i) { pdt[i] = DTT[t0_ + 2 * xr2 + i]; pac[i] = ACS[t0_ + 2 * xr2 + i]; } \
        pa127 = ACS[t0_ + 127]; pas = ACS[t0_ + brow]; pdtb = DTT[t0_ + brow]; } while (0)
#define SSD_WRITE() do { \
        _Pragma("unroll") for (int i = 0; i < 4; ++i) { const int off_ = SSD_IMG(srow0 + 32 * i, sch); *(LAS u32x4*)(lds + L_B + off_) = pB[i]; *(LAS u32x4*)(lds + L_C + off_) = pC[i]; } \
        { float xf_[5][8];   \
          _Pragma("unroll") for (int j = 0; j < 5; ++j) { const unsigned w_[4] = {pXr[j].x, pXr[j].y, pXr[j].z, pXr[j].w}; \
              _Pragma("unroll") for (int k = 0; k < 4; ++k) { xf_[j][2 * k] = __uint_as_float(w_[k] << 16); xf_[j][2 * k + 1] = __uint_as_float(w_[k] & 0xffff0000u); } } \
          float cw_[5][8]; _Pragma("unroll") for (int j = 0; j < 5; ++j) { const f32x4 a_ = *(const LAS f32x4*)(lds + L_CW + (j * 64 + xpc * 8) * 4), b_ = *(const LAS f32x4*)(lds + L_CW + (j * 64 + xpc * 8 + 4) * 4); \
              _Pragma("unroll") for (int k = 0; k < 4; ++k) { cw_[j][k] = a_[k]; cw_[j][4 + k] = b_[k]; } } \
          _Pragma("unroll") for (int i = 0; i < 2; ++i) { const int row = 2 * xr2 + i; const float s1 = pdt[i], s2 = s1 * __builtin_amdgcn_exp2f((pa127 - pac[i]) * LOG2E); \
            float xc_[8]; _Pragma("unroll") for (int k = 0; k < 8; ++k) xc_[k] = silu_f(cw_[4][k] + cw_[0][k] * xf_[i][k] + cw_[1][k] * xf_[i + 1][k] + cw_[2][k] * xf_[i + 2][k] + cw_[3][k] * xf_[i + 3][k]); \
            u32x4 o1, o2; unsigned r1[4], r2[4]; \
            _Pragma("unroll") for (int k = 0; k < 4; ++k) { r1[k] = cvtpk(xc_[2 * k] * s1, xc_[2 * k + 1] * s1); r2[k] = cvtpk(xc_[2 * k] * s2, xc_[2 * k + 1] * s2); } \
            o1 = (u32x4){r1[0], r1[1], r1[2], r1[3]}; o2 = (u32x4){r2[0], r2[1], r2[2], r2[3]}; \
            const int off = (xpc >> 2) * 8192 + (row >> 4) * 1024 + (row & 15) * 64 + (xpc & 3) * 16; \
            *(LAS u32x4*)(lds + L_XD + off) = o1; *(LAS u32x4*)(lds + L_XDD + off) = o2; } } \
        if (bch0 == (brow >> 5)) { ((LAS float*)(lds + L_A2))[brow] = pas * LOG2E; ((LAS float*)(lds + L_FL))[brow] = __builtin_amdgcn_exp2f(pas * LOG2E); ((LAS float*)(lds + L_DT))[brow] = pdtb; } } while (0)
    u32x4 pcb[2][2];
#pragma unroll
    for (int jb = 0; jb < 2; ++jb) { pcb[jb][0] = (u32x4){0u, 0u, 0u, 0u}; pcb[jb][1] = pcb[jb][0]; if (par + 2 * jb <= lb) { const bf16_t* cp = CBTw + (par + 2 * jb) * 64 * 16; pcb[jb][0] = *(const u32x4*)cp; pcb[jb][1] = *(const u32x4*)(cp + 8); } }
    SSD_BAR();
    SSD_PREFETCH(0); SSD_WRITE(); SSD_BAR();
    const int trbase = (4 * hi + ((lane & 15) >> 2)) * 64 + ((lane >> 4) & 1) * 32 + (lane & 3) * 8;
    const int nb = lb;
    const int btr_n = 32 * nb + 16 * ((lane >> 4) & 1) + 4 * (lane & 3);
    const int btr_l = 4 * hi + ((lane & 15) >> 2);
    const int btrb0 = SSD_IMG(btr_l, btr_n >> 3) + (btr_n & 7) * 2, btrb1 = SSD_IMG(btr_l + 8, btr_n >> 3) + (btr_n & 7) * 2;
#pragma unroll 1
    for (int c = 0; c < NCH; ++c) {
        if (c + 1 < NCH) SSD_PREFETCH(c + 1);
        { const size_t t = (size_t)c * CHUNK + el;
          ez0 = *(const u32x4*)(ZS + t * 1024 + ep0); ez1 = *(const u32x4*)(ZS + t * 1024 + ep0 + 8); }
        f32x16 yacc[2]; yacc[0] = f32x16{}; yacc[1] = f32x16{};
        { bf16x8 cfr[4], sfr[2][4];
#pragma unroll
          for (int k4 = 0; k4 < 4; ++k4) { const int kn = 4 * par + k4; cfr[k4] = *(const LAS bf16x8*)(lds + L_C + SSD_IMG(32 * lb + r32, 2 * kn + hi));
#pragma unroll
              for (int q = 0; q < 2; ++q) sfr[q][k4] = *(const LAS bf16x8*)(lds + L_SIN + (2 * kn + hi) * 1024 + (32 * q + r32) * 16); }
          __builtin_amdgcn_sched_barrier(0);
#pragma unroll
          for (int k4 = 0; k4 < 4; ++k4)
#pragma unroll
              for (int q = 0; q < 2; ++q) yacc[q] = __builtin_amdgcn_mfma_f32_32x32x16_bf16(cfr[k4], sfr[q][k4], yacc[q], 0, 0, 0);
#pragma unroll
          for (int g4 = 0; g4 < 4; ++g4) { const f32x4 ea = *(const LAS f32x4*)(lds + L_FL + (32 * lb + 8 * g4 + 4 * hi) * 4);
#pragma unroll
              for (int e_ = 0; e_ < 4; ++e_)
#pragma unroll
                  for (int q = 0; q < 2; ++q) yacc[q][4 * g4 + e_] *= ea[e_]; } }
        const float a2l = *(const LAS float*)(lds + L_A2 + (32 * lb + r32) * 4);
#pragma unroll
        for (int jb = 0; jb < 2; ++jb) { const int sb = par + 2 * jb; if (sb <= lb) {
            f32x4 gv[4];
#pragma unroll
            for (int g4 = 0; g4 < 4; ++g4) gv[g4] = *(const LAS f32x4*)(lds + L_A2 + (32 * sb + 8 * g4 + 4 * hi) * 4);
            const LAS unsigned char* xp = lds + L_XD + (2 * sb) * 1024 + trbase;
            const bf16x8 xv00 = trpair(xp, 512), xv01 = trpair(xp + 1024, 512), xv10 = trpair(xp + 8192, 512), xv11 = trpair(xp + 8192 + 1024, 512);
            const unsigned cw[8] = {pcb[jb][0].x, pcb[jb][0].y, pcb[jb][0].z, pcb[jb][0].w, pcb[jb][1].x, pcb[jb][1].y, pcb[jb][1].z, pcb[jb][1].w};
            float cbt[16];
#pragma unroll
            for (int k = 0; k < 8; ++k) { cbt[2 * k] = __uint_as_float(cw[k] << 16); cbt[2 * k + 1] = __uint_as_float(cw[k] & 0xffff0000u); }
            const bool diag = (sb == lb);
            const float dd = diag ? Dk * __builtin_amdgcn_rcpf(fmaxf(*(const LAS float*)(lds + L_DT + (32 * lb + r32) * 4), 1e-30f)) : 0.f;
#pragma unroll
            for (int g4 = 0; g4 < 4; ++g4)
#pragma unroll
                for (int e_ = 0; e_ < 4; ++e_) { const int r = 4 * g4 + e_; float v = (cbt[r] + (crow(r, hi) == r32 ? dd : 0.f)) * __builtin_amdgcn_exp2f(fminf(a2l - gv[g4][e_], 0.f)); if (diag && crow(r, hi) > r32) v = 0.f; cbt[r] = v; }
            u32x4 pw0, pw1;
            pw0.x = cvtpk(cbt[0], cbt[1]); pw0.y = cvtpk(cbt[2], cbt[3]); pw0.z = cvtpk(cbt[4], cbt[5]); pw0.w = cvtpk(cbt[6], cbt[7]);
            pw1.x = cvtpk(cbt[8], cbt[9]); pw1.y = cvtpk(cbt[10], cbt[11]); pw1.z = cvtpk(cbt[12], cbt[13]); pw1.w = cvtpk(cbt[14], cbt[15]);
            yacc[0] = __builtin_amdgcn_mfma_f32_32x32x16_bf16(__builtin_bit_cast(bf16x8, pw0), xv00, yacc[0], 0, 0, 0);
            yacc[1] = __builtin_amdgcn_mfma_f32_32x32x16_bf16(__builtin_bit_cast(bf16x8, pw0), xv10, yacc[1], 0, 0, 0);
            yacc[0] = __builtin_amdgcn_mfma_f32_32x32x16_bf16(__builtin_bit_cast(bf16x8, pw1), xv01, yacc[0], 0, 0, 0);
            yacc[1] = __builtin_amdgcn_mfma_f32_32x32x16_bf16(__builtin_bit_cast(bf16x8, pw1), xv11, yacc[1], 0, 0, 0);
        } }
        if (c + 1 < NCH) {
#pragma unroll
            for (int jb = 0; jb < 2; ++jb) if (par + 2 * jb <= lb) { const bf16_t* cp = CBTw + (size_t)(c + 1) * (NGRP * 10 * 64 * 16) + (par + 2 * jb) * 64 * 16; pcb[jb][0] = *(const u32x4*)cp; pcb[jb][1] = *(const u32x4*)(cp + 8); } }
#pragma unroll
        for (int g4 = 0; g4 < 4; ++g4)
#pragma unroll
            for (int e_ = 0; e_ < 4; ++e_)
#pragma unroll
                for (int q = 0; q < 2; ++q) ((LAS bf16_t*)(lds + L_Y + par * 16384))[(32 * lb + 8 * g4 + 4 * hi + e_) * 64 + 32 * q + r32] = (bf16_t)(cvtpk(yacc[q][4 * g4 + e_], 0.f) & 0xffffu);
        { const float cd = __builtin_amdgcn_exp2f(*(const LAS float*)(lds + L_A2 + 127 * 4));
#pragma unroll
          for (int r = 0; r < 16; ++r) sacc[r] *= cd;
#pragma unroll
          for (int kh = 0; kh < 2; ++kh) { bf16x8 af[4], bfq[4];
#pragma unroll
              for (int k4 = 0; k4 < 4; ++k4) { const int ks = 4 * kh + k4; af[k4] = trpair(lds + L_B + btrb0 + ks * 4096, btrb1 - btrb0); bfq[k4] = trpair(lds + L_XDD + pb * 8192 + ks * 1024 + trbase, 512); }
              __builtin_amdgcn_sched_barrier(0);
#pragma unroll
              for (int k4 = 0; k4 < 4; ++k4) sacc = __builtin_amdgcn_mfma_f32_32x32x16_bf16(af[k4], bfq[k4], sacc, 0, 0, 0); } }
        SSD_BAR();
        { const int l = el, p0 = ep0; const size_t t = (size_t)c * CHUNK + l;
          const u32x4 z0 = ez0, z1 = ez1;
          const unsigned zw[8] = {z0.x, z0.y, z0.z, z0.w, z1.x, z1.y, z1.z, z1.w};
          unsigned ow[8]; float ss = 0.f;
          const LAS bf16_t* ya = (const LAS bf16_t*)(lds + L_Y) + l * 64 + p0; const LAS bf16_t* yb = (const LAS bf16_t*)(lds + L_Y + 16384) + l * 64 + p0;
          const u32x4 a0 = *(const LAS u32x4*)ya, a1 = *(const LAS u32x4*)(ya + 8), b0 = *(const LAS u32x4*)yb, b1 = *(const LAS u32x4*)(yb + 8);
          const unsigned aw[8] = {a0.x, a0.y, a0.z, a0.w, a1.x, a1.y, a1.z, a1.w}, bw[8] = {b0.x, b0.y, b0.z, b0.w, b1.x, b1.y, b1.z, b1.w};
#pragma unroll
          for (int wi = 0; wi < 8; ++wi) {
              const float ya_ = (__uint_as_float(aw[wi] << 16) + __uint_as_float(bw[wi] << 16)) * __uint_as_float(zw[wi] << 16), yb_ = (__uint_as_float(aw[wi] & 0xffff0000u) + __uint_as_float(bw[wi] & 0xffff0000u)) * __uint_as_float(zw[wi] & 0xffff0000u);
              const unsigned w = cvtpk(ya_, yb_); ow[wi] = w; const float ra = __uint_as_float(w << 16), rb = __uint_as_float(w & 0xffff0000u); ss += ra * ra + rb * rb; }
          *(u32x4*)(MX + t * MIXW + p0) = (u32x4){ow[0], ow[1], ow[2], ow[3]}; *(u32x4*)(MX + t * MIXW + p0 + 8) = (u32x4){ow[4], ow[5], ow[6], ow[7]};
          ss += __shfl_xor(ss, 1); ss += __shfl_xor(ss, 2);
          if ((tid & 3) == 0) SSQ[t * 16] = ss; }
#pragma unroll
        for (int g4 = 0; g4 < 4; ++g4) { const int n0 = 32 * nb + 8 * g4 + 4 * hi; u32x2 w; w.x = cvtpk(sacc[4 * g4], sacc[4 * g4 + 1]); w.y = cvtpk(sacc[4 * g4 + 2], sacc[4 * g4 + 3]);
            *(LAS u32x2*)(lds + L_SIN + (n0 >> 3) * 1024 + (32 * pb + r32) * 16 + (n0 & 7) * 2) = w; }
        if (c + 1 < NCH) SSD_WRITE();
        SSD_BAR();
    }
#undef SSD_PREFETCH
#undef SSD_WRITE
#undef SSD_IMG
}
#undef SSD_BAR
}

constexpr int LDS_BYTES = 160 * 1024;
constexpr int RING_BYTES = 156 * 1024;
constexpr int MISC_OFF = RING_BYTES;

struct Frame {
    LAS unsigned char* lds; int tid, lane, wave, vcu, G; PtrsK PP;
};

template <bool MAPCOL> __device__ __forceinline__ void p0_transpose_item(const float* W, int K, int N, const float* gk, int gklen, bf16_t* WT, LAS float* scr, int item, int nblk, int lane) {
    const int kb = item / nblk, nb = item % nblk, k0 = 64 * kb, n0 = 64 * nb;
    const int c4 = lane & 15, kr = lane >> 4, ncol = n0 + 4 * c4, sc = MAPCOL ? win_src_col(ncol) : ncol;
    f32x4 v[16];
#pragma unroll
    for (int i = 0; i < 16; ++i) { const int kk = 4 * i + kr; v[i] = (f32x4){0.f, 0.f, 0.f, 0.f}; if (sc >= 0) v[i] = __builtin_nontemporal_load((const f32x4*)(W + (size_t)(k0 + kk) * N + sc)); }
#pragma unroll
    for (int i = 0; i < 16; ++i) { const int kk = 4 * i + kr; f32x4 t = v[i]; if (gk && k0 + kk < gklen) t = t * gk[k0 + kk];
        LAS float* d = scr + kk * 65 + 4 * c4; d[0] = t[0]; d[1] = t[1]; d[2] = t[2]; d[3] = t[3]; }
    asm volatile("s_waitcnt lgkmcnt(0)" ::: "memory");
    const int c = lane & 7;
#pragma unroll
    for (int j = 0; j < 8; ++j) { const int n = (lane >> 3) + 8 * j; const LAS float* sp = scr + (8 * c) * 65 + n;
        v4u o; o.x = pk2(sp[0 * 65], sp[1 * 65]); o.y = pk2(sp[2 * 65], sp[3 * 65]); o.z = pk2(sp[4 * 65], sp[5 * 65]); o.w = pk2(sp[6 * 65], sp[7 * 65]);
        *(GAS v4u*)(WT + (size_t)(n0 + n) * K + k0 + 8 * c) = o; }
    asm volatile("s_waitcnt lgkmcnt(0)" ::: "memory");
}
constexpr int I_IN = (D / 64) * (NIN / 64), I_XKV = (D / 64) * (2 * D / 64), I_OUT = (MIXW / 64) * (D / 64), I_XQ = (D / 64) * (D / 64), I_XO = I_XQ, I_UP = (D / 64) * (FF / 64), I_DN = (FF / 64) * (D / 64);
constexpr int I_EARLY = I_IN + I_XKV, I_ALL = I_EARLY + I_OUT + I_XQ + I_XO + I_UP + I_DN;
__device__ __forceinline__ void p0_transposes(Frame& F, const int lo, const int hi) {
    const PtrsK PPk = F.PP; const KAS Ptrs& P = *PPk; unsigned char* ws = P.ws;
    LAS float* scr = (LAS float*)(F.lds + F.wave * 16640);
    const int gw = F.vcu * NWAVES + F.wave, NGW = F.G * NWAVES;
    for (int it = lo + gw; it < hi; it += NGW) {
        int r = it;
        if (r < I_IN) { p0_transpose_item<true>(P.w_in, D, IN_COLS, P.g_mix, D, (bf16_t*)(ws + WS_WIN), scr, r, NIN / 64, F.lane); continue; } r -= I_IN;
        if (r < I_XKV) { p0_transpose_item<false>(P.xkv_w, D, 2 * D, nullptr, 0, (bf16_t*)(ws + WS_XKV), scr, r, 2 * D / 64, F.lane); continue; } r -= I_XKV;
        if (r < I_OUT) { p0_transpose_item<false>(P.w_out, MIXW, D, P.ssm_norm_w, 1024, (bf16_t*)(ws + WS_WOUT), scr, r, D / 64, F.lane); continue; } r -= I_OUT;
        if (r < I_XQ) { p0_transpose_item<false>(P.xq_w, D, D, P.g_xattn, D, (bf16_t*)(ws + WS_XQ), scr, r, D / 64, F.lane); continue; } r -= I_XQ;
        if (r < I_XO) { p0_transpose_item<false>(P.xo_w, D, D, nullptr, 0, (bf16_t*)(ws + WS_XO), scr, r, D / 64, F.lane); continue; } r -= I_XO;
        if (r < I_UP) { p0_transpose_item<false>(P.w_up, D, FF, P.g_mlp, D, (bf16_t*)(ws + WS_WUP), scr, r, FF / 64, F.lane); continue; } r -= I_UP;
        p0_transpose_item<false>(P.w_down, FF, D, nullptr, 0, (bf16_t*)(ws + WS_WDN), scr, r, D / 64, F.lane);
    }
}
__device__ __forceinline__ void p0_transposes_dyn(Frame& F, unsigned* ctr) {
    const PtrsK PPk = F.PP; const KAS Ptrs& P = *PPk; unsigned char* ws = P.ws;
    LAS float* scr = (LAS float*)(F.lds + F.wave * 16640);
    constexpr int NLATE = I_ALL - I_EARLY - I_DN, PER = NLATE / 8;
    static_assert(NLATE % 16 == 0, "late items split evenly over 8 counters, pulled two at a time");
    const int grp = F.vcu >> 5; unsigned* myctr = ctr + 64 * grp;
    for (;;) {
        unsigned it0 = 0; if (F.lane == 0) it0 = __hip_atomic_fetch_add(myctr, 2u, __ATOMIC_RELAXED, __HIP_MEMORY_SCOPE_AGENT);
        it0 = (unsigned)__builtin_amdgcn_readfirstlane((int)it0);
        if (it0 >= (unsigned)PER) break;
      for (int sub = 0; sub < 2; ++sub) {
        int r = grp * PER + (int)it0 + sub;
        if (r < I_OUT) { p0_transpose_item<false>(P.w_out, MIXW, D, P.ssm_norm_w, 1024, (bf16_t*)(ws + WS_WOUT), scr, r, D / 64, F.lane); continue; } r -= I_OUT;
        if (r < I_XQ) { p0_transpose_item<false>(P.xq_w, D, D, P.g_xattn, D, (bf16_t*)(ws + WS_XQ), scr, r, D / 64, F.lane); continue; } r -= I_XQ;
        if (r < I_XO) { p0_transpose_item<false>(P.xo_w, D, D, nullptr, 0, (bf16_t*)(ws + WS_XO), scr, r, D / 64, F.lane); continue; } r -= I_XO;
        if (r < I_UP) { p0_transpose_item<false>(P.w_up, D, FF, P.g_mlp, D, (bf16_t*)(ws + WS_WUP), scr, r, FF / 64, F.lane); continue; } r -= I_UP;
        p0_transpose_item<false>(P.w_down, FF, D, nullptr, 0, (bf16_t*)(ws + WS_WDN), scr, r, D / 64, F.lane);
      }
    }
}
__device__ __forceinline__ void p0_prologue(Frame& F) {
    const PtrsK PPk = F.PP; const KAS Ptrs& P = *PPk; unsigned char* ws = P.ws;
    const int gw = F.vcu * NWAVES + F.wave, NGW = F.G * NWAVES;
    bf16_t* XB = (bf16_t*)(ws + WS_XB); float* RS = (float*)(ws + WS_RSTD1);
    for (int m0 = 8 * gw; m0 < 8 * gw + 8 && m0 < M; m0 += 4) {
        f32x4 v[4][4]; float s2[4];
#pragma unroll
        for (int q = 0; q < 4; ++q) { const int m = m0 + q; const GAS f32x4* xr = (const GAS f32x4*)(P.x + (size_t)(m < M ? m : 0) * D) + F.lane;
#pragma unroll
            for (int j = 0; j < 4; ++j) v[q][j] = __builtin_nontemporal_load(xr + 64 * j); }
#pragma unroll
        for (int q = 0; q < 4; ++q) { float a = 0.f;
#pragma unroll
            for (int j = 0; j < 4; ++j) a += (v[q][j].x * v[q][j].x + v[q][j].y * v[q][j].y) + (v[q][j].z * v[q][j].z + v[q][j].w * v[q][j].w);
            s2[q] = wave_sum(a); }
#pragma unroll
        for (int q = 0; q < 4; ++q) { const int m = m0 + q; if (m < M) {
            if (F.lane == 0) RS[m] = rsqrtf(s2[q] * (1.f / D) + EPS);
            GAS unsigned long long* o8 = (GAS unsigned long long*)(XB + (size_t)m * D) + F.lane;
#pragma unroll
            for (int j = 0; j < 4; ++j) o8[64 * j] = (unsigned long long)pk2(v[q][j].x, v[q][j].y) | ((unsigned long long)pk2(v[q][j].z, v[q][j].w) << 32); } }
    }
    bf16_t* MN = (bf16_t*)(ws + WS_MEMN);
    for (int m = gw; m < MM; m += NGW) {
        const GAS f32x4* xr = (const GAS f32x4*)(P.mem + (size_t)m * D) + F.lane;
        f32x4 v[4]; float s2 = 0.f;
#pragma unroll
        for (int j = 0; j < 4; ++j) { v[j] = __builtin_nontemporal_load(xr + 64 * j); s2 += (v[j].x * v[j].x + v[j].y * v[j].y) + (v[j].z * v[j].z + v[j].w * v[j].w); }
        const float rs = rsqrtf(wave_sum(s2) * (1.f / D) + EPS);
        GAS unsigned long long* o8 = (GAS unsigned long long*)(MN + (size_t)m * D) + F.lane;
#pragma unroll
        for (int j = 0; j < 4; ++j) { const f32x4 g = ((const GAS f32x4*)P.g_mem)[F.lane + 64 * j];
            o8[64 * j] = (unsigned long long)pk2(v[j].x * rs * g.x, v[j].y * rs * g.y) | ((unsigned long long)pk2(v[j].z * rs * g.z, v[j].w * rs * g.w) << 32); }
    }
    p0_transposes(F, 0, I_EARLY);
}

__device__ __forceinline__ void p2_conv_scan(Frame& F) {
    const PtrsK PPk = F.PP; const KAS Ptrs& P = *PPk; unsigned char* ws = P.ws;
    const bf16_t* XR = (const bf16_t*)(ws + WS_BCR); bf16_t* XA = (bf16_t*)(ws + WS_BCA);
    for (int item = F.vcu; item < BATCH * NCH * NGRP; item += F.G) {
        typedef short bf16x8 __attribute__((ext_vector_type(8))); typedef float f32x16 __attribute__((ext_vector_type(16)));
        const int b = item >> 5, c = (item >> 1) & 15, g = item & 1, tid = F.tid, lane = F.lane, r32 = lane & 31, hi = lane >> 5;
        const size_t t0 = (size_t)b * SEQ + c * CHUNK;
        { const int ch8 = tid & 31, run = tid >> 5, isC = ch8 >> 4, c0 = 1024 + isC * 256 + g * 128 + (ch8 & 15) * 8, cb0 = c0 - 1024;
          float w[4][8], bb[8];
#pragma unroll
          for (int j = 0; j < 4; ++j)
#pragma unroll
              for (int i = 0; i < 8; ++i) w[j][i] = P.conv_w[j * CONVD + c0 + i];
#pragma unroll
          for (int i = 0; i < 8; ++i) bb[i] = P.conv_b[c0 + i];
          float h0[8], h1[8], h2[8];
          { v4u r0 = {0, 0, 0, 0}, r1 = r0, r2 = r0; const size_t tr = t0 + run * 8;
            if (!(c == 0 && run == 0)) { r0 = *(const v4u*)(XR + (tr - 3) * 512 + cb0); r1 = *(const v4u*)(XR + (tr - 2) * 512 + cb0); r2 = *(const v4u*)(XR + (tr - 1) * 512 + cb0); }
            const unsigned a0[4] = {r0.x, r0.y, r0.z, r0.w}, a1[4] = {r1.x, r1.y, r1.z, r1.w}, a2[4] = {r2.x, r2.y, r2.z, r2.w};
#pragma unroll
            for (int i = 0; i < 4; ++i) { h0[2 * i] = __uint_as_float(a0[i] << 16); h0[2 * i + 1] = __uint_as_float(a0[i] & 0xffff0000u);
                h1[2 * i] = __uint_as_float(a1[i] << 16); h1[2 * i + 1] = __uint_as_float(a1[i] & 0xffff0000u);
                h2[2 * i] = __uint_as_float(a2[i] << 16); h2[2 * i + 1] = __uint_as_float(a2[i] & 0xffff0000u); } }
#pragma unroll
          for (int r = 0; r < 8; ++r) { const int row = run * 8 + r;
              const v4u cv = *(const v4u*)(XR + (t0 + row) * 512 + cb0); const unsigned cw[4] = {cv.x, cv.y, cv.z, cv.w};
              float cur[8], o[8];
#pragma unroll
              for (int i = 0; i < 4; ++i) { cur[2 * i] = __uint_as_float(cw[i] << 16); cur[2 * i + 1] = __uint_as_float(cw[i] & 0xffff0000u); }
#pragma unroll
              for (int i = 0; i < 8; ++i) { o[i] = silu_f(bb[i] + w[0][i] * h0[i] + w[1][i] * h1[i] + w[2][i] * h2[i] + w[3][i] * cur[i]); h0[i] = h1[i]; h1[i] = h2[i]; h2[i] = cur[i]; }
              v4u ov; ov.x = pk2(o[0], o[1]); ov.y = pk2(o[2], o[3]); ov.z = pk2(o[4], o[5]); ov.w = pk2(o[6], o[7]);
              *(v4u*)(XA + (t0 + row) * 512 + cb0) = ov;
              *(LAS v4u*)(F.lds + isC * 32768 + (ch8 & 15) * 2048 + row * 16) = ov; } }
        asm volatile("s_waitcnt lgkmcnt(0)" ::: "memory"); __builtin_amdgcn_s_barrier(); asm volatile("" ::: "memory");
        bf16_t* CBT = (bf16_t*)(ws + WS_CBT) + (size_t)item * 10 * 64 * 16;
#pragma unroll 1
        for (int blk = F.wave; blk < 10; blk += NWAVES) {
            const int lb = blk < 1 ? 0 : blk < 3 ? 1 : blk < 6 ? 2 : 3, sb = blk - lb * (lb + 1) / 2;
            bf16x8 bfr[8], cfr[8];
#pragma unroll
            for (int kn = 0; kn < 8; ++kn) { bfr[kn] = *(const LAS bf16x8*)(F.lds + (2 * kn + hi) * 2048 + (32 * sb + r32) * 16); cfr[kn] = *(const LAS bf16x8*)(F.lds + 32768 + (2 * kn + hi) * 2048 + (32 * lb + r32) * 16); }
            __builtin_amdgcn_sched_barrier(0);
            f32x16 cbt = f32x16{};
#pragma unroll
            for (int kn = 0; kn < 8; ++kn) cbt = __builtin_amdgcn_mfma_f32_32x32x16_bf16(bfr[kn], cfr[kn], cbt, 0, 0, 0);
            v4u o0, o1;
            o0.x = pk2(cbt[0], cbt[1]); o0.y = pk2(cbt[2], cbt[3]); o0.z = pk2(cbt[4], cbt[5]); o0.w = pk2(cbt[6], cbt[7]);
            o1.x = pk2(cbt[8], cbt[9]); o1.y = pk2(cbt[10], cbt[11]); o1.z = pk2(cbt[12], cbt[13]); o1.w = pk2(cbt[14], cbt[15]);
            *(v4u*)(CBT + ((size_t)blk * 64 + lane) * 16) = o0; *(v4u*)(CBT + ((size_t)blk * 64 + lane) * 16 + 8) = o1;
        }
        asm volatile("s_waitcnt lgkmcnt(0)" ::: "memory"); __builtin_amdgcn_s_barrier(); asm volatile("" ::: "memory");
    }
    if (F.vcu < BATCH * NH) {
        const int bh = F.vcu, b = bh / NH, h = bh % NH, lane = F.lane, p0 = 256 * F.wave + 4 * lane;
        const float* DT = (const float*)(ws + WS_DT); const float* LF = (const float*)(ws + WS_LF);
        float* DTT = (float*)(ws + WS_DTT) + (size_t)bh * SEQ; float* ACS = (float*)(ws + WS_ACS) + (size_t)bh * SEQ; float* CB = (float*)(ws + WS_CUMB) + (size_t)bh * SEQ;
        const float A = -expf(P.a_log[h]);
        float dt[4], da[4], lf[4];
#pragma unroll
        for (int j4 = 0; j4 < 4; ++j4) { const size_t m = (size_t)b * SEQ + p0 + j4; dt[j4] = DT[m * 16 + h]; lf[j4] = LF[m * 16 + h]; }
        da[0] = dt[0] * A;
#pragma unroll
        for (int j4 = 1; j4 < 4; ++j4) { da[j4] = da[j4 - 1] + dt[j4] * A; lf[j4] += lf[j4 - 1]; }
        float pa = da[3], pf = lf[3];
#pragma unroll
        for (int o = 1; o < 32; o <<= 1) { const float t = __shfl_up(pa, o); if ((lane & 31) >= o) pa += t; }
#pragma unroll
        for (int o = 1; o < 64; o <<= 1) { const float t = __shfl_up(pf, o); if (lane >= o) pf += t; }
        LAS float* wt = (LAS float*)(F.lds + 140 * 1024);
        if (lane == 63) wt[F.wave] = pf;
        asm volatile("s_waitcnt lgkmcnt(0)" ::: "memory"); __builtin_amdgcn_s_barrier(); asm volatile("" ::: "memory");
        float base = 0.f;
        for (int w = 0; w < F.wave; ++w) base += wt[w];
        const float ea = pa - da[3], ef = pf - lf[3] + base;
        *(f32x4*)(DTT + p0) = (f32x4){dt[0], dt[1], dt[2], dt[3]};
        *(f32x4*)(ACS + p0) = (f32x4){da[0] + ea, da[1] + ea, da[2] + ea, da[3] + ea};
        *(f32x4*)(CB + p0) = (f32x4){(lf[0] + ef) * LOG2E, (lf[1] + ef) * LOG2E, (lf[2] + ef) * LOG2E, (lf[3] + ef) * LOG2E};
    }
}

struct Args { Ptrs P; int ph_lo, ph_hi, flags, pad; };
__device__ __forceinline__ bool in_phase(const KAS Args* ka, int k) { asm volatile("" : "+s"(ka)); return ka->ph_lo <= k && k < ka->ph_hi; }
__device__ __forceinline__ PtrsK launder(PtrsK p) { asm volatile("" : "+s"(p)); return p; }

typedef GAS unsigned gu32;
#define XB_TMO      128
#define XB_XCNT(j)  (256  + 64 * (j))
#define XB_XSUB(j)  (1280 + 64 * (j))
#define XB_XGEN(j)  (2304 + 64 * (j))
#define XB_TOP      3328
#define XB_TOPGEN   3392
#define XCD_BAR_WORDS 3456
#define XB_SPIN_CAP (1u << 18)
__device__ __forceinline__ unsigned xb_ld(unsigned* p)              { return __hip_atomic_load(p, __ATOMIC_RELAXED, __HIP_MEMORY_SCOPE_AGENT); }
__device__ __forceinline__ unsigned xb_add(unsigned* p, unsigned v) { return __hip_atomic_fetch_add(p, v, __ATOMIC_RELAXED, __HIP_MEMORY_SCOPE_AGENT); }
__device__ __forceinline__ unsigned xb_xcc_id() { return (unsigned)__builtin_amdgcn_s_getreg((3 << 11) | 20) & 0xFu; }
#define XB_SPIN(cond, bar) do { unsigned _sp = 0; while (cond) { __builtin_amdgcn_s_sleep(1); \
    if ((++_sp & 255u) == 0u) { if (xb_ld(&(bar)[XB_TMO])) break; if (_sp > XB_SPIN_CAP) { atomicAdd(&(bar)[XB_TMO], 1u); break; } } } } while (0)
struct XcdBarrier { unsigned* bar; unsigned x; volatile LAS unsigned* st; };
__device__ __forceinline__ XcdBarrier xcd_barrier_post(unsigned* bar, volatile LAS unsigned* st) {
    XcdBarrier b; b.bar = bar; b.x = xb_xcc_id(); b.st = st;
    if (threadIdx.x == 0) (void)xb_add(&bar[XB_XCNT(b.x)], 1u);
    return b;
}
__device__ __forceinline__ void xcd_barrier_complete(unsigned* bar, unsigned x, unsigned& nloc, unsigned& nx) {
    const unsigned G = gridDim.x * gridDim.y * gridDim.z;
    unsigned sum, cnt, mine, sp = 0u;
    for (;;) {
        sum = 0u; cnt = 0u; mine = 0u;
#pragma unroll
        for (unsigned j = 0; j < 16; ++j) { const unsigned c = xb_ld(&bar[XB_XCNT(j)]); sum += c; cnt += (c > 0u) ? 1u : 0u; mine = (j == x) ? c : mine; }
        if (sum == G) break;
        __builtin_amdgcn_s_sleep(1);
        if ((++sp & 255u) == 0u) { if (xb_ld(&bar[XB_TMO])) break; if (sp > XB_SPIN_CAP) { atomicAdd(&bar[XB_TMO], 1u); break; } }
    }
    nloc = mine > 0u ? mine : 1u; nx = cnt > 0u ? cnt : 1u;
}
__device__ __forceinline__ void xcd_barrier(const XcdBarrier& b) {
    asm volatile("s_waitcnt vmcnt(0)" ::: "memory");
    __syncthreads();
    if (threadIdx.x == 0) {
        unsigned* bar = b.bar;
        __builtin_amdgcn_s_waitcnt(0);
        unsigned nloc = b.st[0], nx = b.st[1];
        if (nloc == 0u) { xcd_barrier_complete(bar, b.x, nloc, nx); b.st[0] = nloc; b.st[1] = nx; }
        const unsigned old = xb_add(&bar[XB_XSUB(b.x)], 1u);
        const unsigned gen = old / nloc;
        if (old + 1u == (gen + 1u) * nloc) {
            __builtin_amdgcn_fence(__ATOMIC_RELEASE, "agent");
            asm volatile("s_waitcnt vmcnt(0)" ::: "memory");
            const unsigned og = xb_add(&bar[XB_TOP], 1u);
            const unsigned tg = og / nx;
            if (og + 1u == (tg + 1u) * nx) xb_add(&bar[XB_TOPGEN], 1u);
            else XB_SPIN(xb_ld(&bar[XB_TOPGEN]) == tg, bar);
            __builtin_amdgcn_fence(__ATOMIC_ACQUIRE, "agent");
            xb_add(&bar[XB_XGEN(b.x)], 1u);
            asm volatile("s_waitcnt vmcnt(0)" ::: "memory");
        } else {
            XB_SPIN(xb_ld(&bar[XB_XGEN(b.x)]) == gen, bar);
            __builtin_amdgcn_fence(__ATOMIC_ACQUIRE, "agent");
            asm volatile("s_waitcnt vmcnt(0)" ::: "memory");
        }
    }
    __syncthreads();
}
constexpr int CW_LATE = 7680;
constexpr int CW_BAR = 4096;
typedef const KAS Args* ArgsK;
__device__ __forceinline__ ArgsK launder(ArgsK p) { asm volatile("" : "+s"(p)); return p; }
__device__ __forceinline__ int vcu_of() { const int G = gridDim.x, bx = blockIdx.x; return (G % 8 == 0) ? (bx % 8) * (G / 8) + bx / 8 : bx; }
__device__ __forceinline__ Frame make_frame(LAS unsigned char* lds, PtrsK pp) { Frame F; F.lds = lds; F.tid = threadIdx.x; F.lane = F.tid & 63; F.wave = __builtin_amdgcn_readfirstlane(F.tid >> 6); F.G = gridDim.x; F.vcu = vcu_of(); F.PP = pp; return F; }
__global__ void __launch_bounds__(NTHR, 2) fwd(Args args_unused) {
    extern __shared__ __attribute__((aligned(16))) unsigned char lds_raw[];
    const ArgsK KA = (ArgsK)__builtin_amdgcn_kernarg_segment_ptr();
    volatile LAS unsigned* MISC = (volatile LAS unsigned*)((LAS unsigned char*)lds_raw + MISC_OFF);
    if (threadIdx.x < 4) MISC[threadIdx.x] = 0u;
    __syncthreads();
    XcdBarrier bar; bar.bar = nullptr; bar.x = 0; bar.st = MISC;
    { const ArgsK A = launder(KA); if (A->ph_hi - A->ph_lo > 1) bar = xcd_barrier_post((unsigned*)(A->P.ws + WS_CTL) + CW_BAR, MISC); }
#define SEAM(k) do { if (in_phase(KA, (k)) && in_phase(KA, (k) + 1)) xcd_barrier(bar); } while (0)
#ifndef PH_MASK
#define PH_MASK 0xFFFF
#endif
#define IN(k) (((PH_MASK >> (k)) & 1) && in_phase(KA, (k)))
#define LDSP ((LAS unsigned char*)lds_raw)
#define XLP (LDSP + pg8::STAGE_BYTES)
    if (IN(0)) { const ArgsK A = launder(KA); Frame F = make_frame(LDSP, &A->P); p0_prologue(F); }
    SEAM(0);
    if (IN(1)) {
        const ArgsK A = launder(KA); const PtrsK PP = &A->P; const int v = vcu_of();
        pg8::SchedP1 S{(const char*)PP->out, (const char*)PP->ws, v >> 5, v & 31};
        pg8::EpiP1 E{PP};
        pg8::gemm_phase(LDSP, XLP, D, S, E);
    }
    SEAM(1);
    if (IN(2)) { const ArgsK A = launder(KA); Frame F = make_frame(LDSP, &A->P); p2_conv_scan(F); }
    SEAM(2);
    if (IN(3)) {
        static_assert(attn_body::ATTN_LDS_BYTES <= RING_BYTES && ssd::LDS_BYTES <= RING_BYTES, "mixer LDS");
        { const int v = vcu_of(); const ArgsK A = launder(KA); if ((v & 1) == 0) { ssd::ssd_item(A->P, v >> 1, LDSP); __syncthreads();
            static_assert(I_DN == 128 * NWAVES, "one item per wave of the even CUs");
            const int w = __builtin_amdgcn_readfirstlane(threadIdx.x >> 6);
            p0_transpose_item<false>(A->P.w_down, FF, D, nullptr, 0, (bf16_t*)(A->P.ws + WS_WDN), (LAS float*)(LDSP + w * 16640), (v >> 1) * NWAVES + w, D / 64, threadIdx.x & 63);
            __syncthreads(); } }
        { const ArgsK A = launder(KA); unsigned char* ws = A->P.ws;
        const attn_body::AttnTensorsB AT{(const attn_body::bf16*)(ws + WS_Q), (const attn_body::bf16*)(ws + WS_K), (const attn_body::bf16*)(ws + WS_V), (attn_body::bf16*)(ws + WS_MIXED), (const float*)(ws + WS_CUMB)};
        const attn_body::StaticOrder S(vcu_of());
        attn_body::attn_phase<attn_body::StaticOrder>((char*)lds_raw, AT, S); }
        { __syncthreads(); const ArgsK A = launder(KA); Frame F = make_frame(LDSP, &A->P); p0_transposes_dyn(F, (unsigned*)(A->P.ws + WS_CTL) + CW_LATE); }
    }
    SEAM(3);
    if (IN(4)) {
        const ArgsK A = launder(KA); const PtrsK PP = &A->P; unsigned char* ws = PP->ws; const int v = vcu_of();
        pg8::SchedOne S{(const char*)(ws + WS_MIXED), (const char*)(ws + WS_WOUT), v >> 5, v & 31, 32, (size_t)256 * MIXW * 2};
        pg8::EpiRes<true, false> E{PP->x, (bf16_t*)(ws + WS_X1B), (float*)(ws + WS_SSQ2), (const float*)(ws + WS_SSQ)};
        pg8::gemm_phase(LDSP, XLP, MIXW, S, E);
    }
    SEAM(4);
    if (IN(5)) {
        const ArgsK A = launder(KA); const PtrsK PP = &A->P; unsigned char* ws = PP->ws; const int v = vcu_of();
        pg8::SchedOne S{(const char*)(ws + WS_X1B), (const char*)(ws + WS_XQ), v >> 5, v & 31, 32, (size_t)256 * D * 2};
        pg8::EpiXq E{(const float*)(ws + WS_SSQ2), PP->xg_q, (bf16_t*)(ws + WS_QX)};
        pg8::gemm_phase(LDSP, XLP, D, S, E);
    }
    if (in_phase(KA, 5) && in_phase(KA, 6)) { if (threadIdx.x == 0) { __builtin_amdgcn_fence(__ATOMIC_ACQUIRE, "agent"); asm volatile("s_waitcnt vmcnt(0)" ::: "memory"); } __syncthreads(); }
    if (IN(6)) {
        static_assert(xattn::LDS_BYTES <= RING_BYTES, "xattn LDS");
        const ArgsK A = launder(KA); unsigned char* ws = A->P.ws;
        for (int u = vcu_of(); u < BATCH * XH * 8; u += (int)gridDim.x)
            xattn::xattn_unit((const bf16_t*)(ws + WS_QX), (const bf16_t*)(ws + WS_KX), (const bf16_t*)(ws + WS_VX), (bf16_t*)(ws + WS_OX), u >> 5, (u >> 3) & 3, u & 7, LDSP);
    }
    SEAM(6);
    if (IN(7)) {
        const ArgsK A = launder(KA); const PtrsK PP = &A->P; unsigned char* ws = PP->ws; const int v = vcu_of();
        pg8::SchedOne S{(const char*)(ws + WS_OX), (const char*)(ws + WS_XO), v >> 5, v & 31, 32, (size_t)256 * D * 2};
        pg8::EpiRes<false, true> E{ws + WS_X1B, (bf16_t*)(ws + WS_X2B), (float*)(ws + WS_SSQ3), nullptr};
        pg8::gemm_phase(LDSP, XLP, D, S, E);
    }
    SEAM(7);
    if (IN(8)) {
        const ArgsK A = launder(KA); const PtrsK PP = &A->P; unsigned char* ws = PP->ws; const int v = vcu_of();
        pg8::SchedOne S{(const char*)(ws + WS_X2B), (const char*)(ws + WS_WUP), v >> 5, v & 31, 128, (size_t)256 * D * 2};
        pg8::EpiUp E{(const float*)(ws + WS_SSQ3), (bf16_t*)(ws + WS_HB)};
        pg8::gemm_phase(LDSP, XLP, D, S, E);
    }
    SEAM(8);
    if (IN(9)) {
        const ArgsK A = launder(KA); const PtrsK PP = &A->P; unsigned char* ws = PP->ws; const int v = vcu_of();
        pg8::SchedOne S{(const char*)(ws + WS_HB), (const char*)(ws + WS_WDN), v >> 5, v & 31, 32, (size_t)256 * FF * 2};
        pg8::EpiDown E{(const bf16_t*)(ws + WS_X2B), PP->out};
        pg8::gemm_phase(LDSP, XLP, FF, S, E);
    }
#undef IN
#undef SEAM
#undef LDSP
#undef XLP
}

extern "C" void kernel_launch(void* const* d_in, const int* in_sizes, int n_in, void* d_out, int out_size, void* d_ws, size_t ws_size, hipStream_t stream) {
    static int ready = 0;
    if (!ready) {
        if (n_in != 24 || out_size != M * D || ws_size < WS_END) { fprintf(stderr, "kernel_launch: unexpected shapes (n_in %d out %d ws %zu)\n", n_in, out_size, ws_size); ready = -1; return; }
        if (hipFuncSetAttribute((const void*)fwd, hipFuncAttributeMaxDynamicSharedMemorySize, LDS_BYTES) != hipSuccess) { fprintf(stderr, "kernel_launch: hipFuncSetAttribute failed\n"); ready = -1; return; }
        int dev = 0, cus = 0, per_cu = 0;
        if (hipGetDevice(&dev) != hipSuccess || hipDeviceGetAttribute(&cus, hipDeviceAttributeMultiprocessorCount, dev) != hipSuccess) cus = 0;
        if (hipOccupancyMaxActiveBlocksPerMultiprocessor(&per_cu, (const void*)fwd, NTHR, LDS_BYTES) != hipSuccess) per_cu = 0;
        (void)hipGetLastError();
        ready = (cus * per_cu >= 256) ? 2 : 1;
    }
    if (ready < 0) return;
    Args a{};
    const float** pp = (const float**)&a.P;
    for (int i = 0; i < 24; ++i) pp[i] = (const float*)d_in[i];
    a.P.out = (float*)d_out; a.P.ws = (unsigned char*)d_ws;
    (void)hipMemsetAsync((char*)d_ws + WS_CTL, 0, CTL_ZERO_BYTES, stream);
    const int G = 256;
    auto PH = [&](int lo, int hi) { a.ph_lo = lo; a.ph_hi = hi; hipLaunchKernelGGL(fwd, dim3(G), dim3(NTHR), LDS_BYTES, stream, a); };
#ifndef N_LAUNCHES
#define N_LAUNCHES 1
#endif
    if (N_LAUNCHES == 1 && ready == 2) PH(0, 10);
    else for (int p = 0; p < 10; ++p) PH(p, p + 1);
}
```

```cpp
#include <hip/hip_runtime.h>
#include <hip/hip_bf16.h>
#include <cmath>
#include <cstdio>
#include <cstdint>

typedef unsigned short bf16_t;
#define GAS __attribute__((address_space(1)))
#define LAS __attribute__((address_space(3)))
typedef unsigned v4u __attribute__((ext_vector_type(4)));
typedef float f32x4 __attribute__((ext_vector_type(4)));

constexpr int D = 1024, BATCH = 8, SEQ = 2048, M = BATCH * SEQ, MEML = 256, MM = BATCH * MEML;
constexpr int NH = 16, HD = 64, NGRP = 2, NST = 128, CHUNK = 128, NCH = SEQ / CHUNK, CONVD = 1536, MIXW = 2048;
constexpr int IN_COLS = 5664, NIN = 5888;
constexpr int XH = 4, XHD = 256, FF = 4096;
constexpr float EPS = 1e-5f, LOG2E = 1.4426950408889634f;
constexpr float C2 = 0.125f * LOG2E;
constexpr float CX2 = 0.0625f * LOG2E;

__host__ __device__ __forceinline__ int win_src_col(int n) { if (n < 2560) return n; if (n < 5632) return n + 16; if (n < 5648) return n - 5632 + 2560; if (n < 5664) return n; return -1; }

constexpr int NWAVES = 8, NTHR = NWAVES * 64;
constexpr size_t MiB = 1u << 20;
constexpr size_t WS_CTL = 0, CTL_ZERO_BYTES = 32768;
constexpr size_t WS_WIN = 1 * MiB, WS_XKV = 13 * MiB, WS_WOUT = 17 * MiB, WS_XQ = 21 * MiB, WS_XO = 23 * MiB, WS_WUP = 25 * MiB, WS_WDN = 33 * MiB;
constexpr size_t WS_BCA = 1 * MiB;
constexpr size_t WS_ZS = 41 * MiB;
constexpr size_t WS_X1B = WS_ZS;
constexpr size_t WS_BCR = 73 * MiB;
constexpr size_t WS_MIXED = WS_BCR;
constexpr size_t WS_XB = 89 * MiB;
constexpr size_t WS_Q = 137 * MiB, WS_K = 169 * MiB, WS_V = 201 * MiB;
constexpr size_t WS_QX = WS_Q, WS_OX = WS_K, WS_X2B = WS_V;
constexpr size_t WS_HB = 73 * MiB;
constexpr size_t WS_KX = 233 * MiB, WS_VX = 237 * MiB;
constexpr size_t WS_DT = 241 * MiB, WS_LF = 242 * MiB, WS_DTT = 243 * MiB, WS_ACS = 244 * MiB, WS_CUMB = 245 * MiB;
constexpr size_t WS_SSQ = 246 * MiB, WS_SSQ2 = 247 * MiB, WS_SSQ3 = 248 * MiB, WS_RSTD1 = 249 * MiB, WS_CBT = 250 * MiB, WS_MEMN = WS_CBT, WS_END = 255 * MiB;
constexpr size_t WS_XRA = 17 * MiB;
constexpr size_t DO_XRB = 0;
constexpr size_t DO_XB = 0, DO_BCA = 0, DO_XRAW = 32 * MiB;

__device__ __forceinline__ float bf2f(bf16_t v) { return __uint_as_float((unsigned)v << 16); }
__device__ __forceinline__ unsigned f2bf(float f) { unsigned u = __float_as_uint(f); return (u + 0x7fffu + ((u >> 16) & 1u)) >> 16; }
__device__ __forceinline__ unsigned pk2(float lo, float hi) { return f2bf(lo) | (f2bf(hi) << 16); }
__device__ __forceinline__ float wave_sum(float v) {
#pragma unroll
    for (int o = 1; o < 64; o <<= 1) v += __shfl_xor(v, o);
    return v;
}
__device__ __forceinline__ float wave_max(float v) {
#pragma unroll
    for (int o = 1; o < 64; o <<= 1) v = fmaxf(v, __shfl_xor(v, o));
    return v;
}
__device__ __forceinline__ float silu_f(float x) { return x * __builtin_amdgcn_rcpf(1.f + __builtin_amdgcn_exp2f(-x * LOG2E)); }
__device__ __forceinline__ float softplus_f(float x) { return x > 20.f ? x : log1pf(expf(x)); }

#define KAS __attribute__((address_space(4)))
struct Ptrs {
    const float *x, *mem, *g_mix, *w_in, *conv_w, *conv_b, *dt_bias, *a_log, *d_skip, *ssm_norm_w, *g_q, *g_k, *f_bias, *w_out, *g_xattn, *g_mem,
        *xq_w, *xkv_w, *xg_q, *xg_k, *xo_w, *g_mlp, *w_up, *w_down;
    float* out; unsigned char* ws;
};
typedef const KAS Ptrs* PtrsK;

namespace pg8 {
typedef short bf16x8 __attribute__((ext_vector_type(8)));
typedef unsigned u32x4 __attribute__((ext_vector_type(4)));
constexpr int BM = 256, BK = 64, HALF = 128, HTB = HALF * BK * 2, STAGE_BYTES = 8 * HTB;
__host__ __device__ __forceinline__ int lds_byte(int r, int c) { const int st = (r >> 4) * 2 + (c >> 5), rr = r & 15, cc = c & 31, ob = rr * 64 + cc * 2; return st * 1024 + (ob ^ (((ob >> 9) & 1) << 5)); }
__host__ __device__ __forceinline__ void stage_rc(int b, int& R, int& C) { const int st = b / 1024, sb = b % 1024, swz = sb ^ (((sb >> 9) & 1) << 5); R = (st >> 1) * 16 + swz / 64; C = (st & 1) * 32 + (swz % 64) / 2; }
__host__ __device__ __forceinline__ int perm32(int rho) { const int n = rho >> 4, i = rho & 15; return 8 * (i >> 2) + 4 * n + (i & 3); }
struct Unit { int pm, pn, kind; const char* a; const char* b; };
typedef f32x4 Acc[2][2][4][2];
__device__ __forceinline__ unsigned cvt_pk_bf16(float lo, float hi) { unsigned r; asm volatile("v_cvt_pk_bf16_f32 %0, %1, %2" : "=v"(r) : "v"(lo), "v"(hi)); return r; }

template <class Epi, class Sched>
__device__ __forceinline__ void gemm_phase(LAS unsigned char* lds, LAS unsigned char* xl, const int K, const Sched& S, const Epi& E) {
    const int tid = threadIdx.x, wid = __builtin_amdgcn_readfirstlane(tid >> 6), lane = tid & 63, wr = wid >> 2, wc = wid & 3, fr = lane & 15, fq = lane >> 4;
    const int nt = K / BK;
    unsigned voffA[2], voffB[2];
#pragma unroll
    for (int i = 0; i < 2; ++i) { int R, C; stage_rc(tid * 16 + i * 8192, R, C); const int Rb = (R >> 5) * 64 + perm32(R & 31);
        voffA[i] = (unsigned)(R * K + C) * 2u; voffB[i] = (unsigned)(Rb * K + C) * 2u; }
    const size_t kstep = (size_t)(BK * 2);
    const size_t hstep = (size_t)HALF * K * 2;
    const size_t bstep = (size_t)32 * K * 2;
    const unsigned ldsw = (unsigned)wid * 1024u;
    const int aoff = lds_byte(wr * 64 + fr, fq * 8), boff = lds_byte(wc * 32 + fr, fq * 8);
#define PG8_SA(b, h) (((b) * 2 + (h)) * HTB)
#define PG8_SB(b, h) ((4 + (b) * 2 + (h)) * HTB)
#define PG8_STAGE(bufoff, gbase, voff) do { _Pragma("unroll") for (int _i = 0; _i < 2; ++_i) \
        __builtin_amdgcn_global_load_lds((const unsigned*)((const char*)(gbase) + (voff)[_i]), (LAS unsigned*)(lds + (bufoff) + ldsw + _i * 8192), 16, 0, 0); } while (0)
#define PG8_LDA(dst, b, h) do { _Pragma("unroll") for (int m = 0; m < 4; ++m) _Pragma("unroll") for (int k = 0; k < 2; ++k) dst[m][k] = *(const LAS bf16x8*)(lds + PG8_SA(b, h) + aoff + m * 2048 + k * 1024); } while (0)
#define PG8_LDB(dst, b, h) do { _Pragma("unroll") for (int n = 0; n < 2; ++n) _Pragma("unroll") for (int k = 0; k < 2; ++k) dst[n][k] = *(const LAS bf16x8*)(lds + PG8_SB(b, h) + boff + n * 2048 + k * 1024); } while (0)
#define PG8_MMA(ai, bj, At, Bt) do { __builtin_amdgcn_s_setprio(1); _Pragma("unroll") for (int m = 0; m < 4; ++m) _Pragma("unroll") for (int n = 0; n < 2; ++n) _Pragma("unroll") for (int k = 0; k < 2; ++k) \
        acc[ai][bj][m][n] = __builtin_amdgcn_mfma_f32_16x16x32_bf16(Bt[n][k], At[m][k], acc[ai][bj][m][n], 0, 0, 0); __builtin_amdgcn_s_setprio(0); } while (0)
#define PG8_WAIT_V(n) asm volatile("s_waitcnt vmcnt(" #n ")" ::: "memory")
#define PG8_WAIT_L(n) asm volatile("s_waitcnt lgkmcnt(" #n ")" ::: "memory")
#define PG8_BAR __builtin_amdgcn_s_barrier()
#define PG8_SCHED __builtin_amdgcn_sched_barrier(0)
    Unit cur, nxt; int ui = 0;
    if (!S.next(0, cur)) return;
    E.prepare(xl, cur, tid);
    asm volatile("s_waitcnt vmcnt(0) lgkmcnt(0)" ::: "memory"); __builtin_amdgcn_s_barrier(); asm volatile("" ::: "memory");
    Acc acc;
#pragma unroll
    for (int a = 0; a < 2; ++a)
#pragma unroll
        for (int b = 0; b < 2; ++b)
#pragma unroll
            for (int m = 0; m < 4; ++m)
#pragma unroll
                for (int n = 0; n < 2; ++n) acc[a][b][m][n] = (f32x4){0.f, 0.f, 0.f, 0.f};
    bf16x8 At[4][2], B0[2][2], B1[2][2];
    const char* cA = cur.a; const char* cB = cur.b;
    PG8_STAGE(PG8_SB(0, 0), cB, voffB); PG8_STAGE(PG8_SB(0, 1), cB + bstep, voffB); PG8_STAGE(PG8_SA(0, 0), cA, voffA); PG8_STAGE(PG8_SA(0, 1), cA + hstep, voffA);
    if (wr == 1) PG8_BAR;
    PG8_WAIT_V(2); PG8_BAR;
    PG8_STAGE(PG8_SB(1, 0), cB + kstep, voffB); PG8_STAGE(PG8_SA(1, 0), cA + kstep, voffA); PG8_STAGE(PG8_SB(1, 1), cB + bstep + kstep, voffB);
    PG8_WAIT_V(6); PG8_BAR;
    for (;;) {
        const bool has_next = S.next(ui + 1, nxt);
        const char* nA = has_next ? nxt.a : cA; const char* nB = has_next ? nxt.b : cB;
        for (int t = 0; t < nt; t += 2) {
            const bool last = (t == nt - 2);
            const char* a1 = cA + (size_t)(t + 1) * kstep;
            const char* a2 = last ? nA : cA + (size_t)(t + 2) * kstep; const char* b2 = last ? nB : cB + (size_t)(t + 2) * kstep;
            const char* a3 = a2 + kstep; const char* b3 = b2 + kstep;
            if constexpr (Epi::KSEG) { if (t == 8 || t == 16) E.kseg(acc, cur, t, wr, fr, xl); }
            PG8_LDB(B0, 0, 0); PG8_LDB(B1, 0, 1); PG8_SCHED; PG8_LDA(At, 0, 0); PG8_STAGE(PG8_SA(1, 1), a1 + hstep, voffA);
            PG8_WAIT_V(8); PG8_WAIT_L(0); PG8_BAR; PG8_MMA(0, 0, At, B0); PG8_MMA(0, 1, At, B1); PG8_BAR; PG8_SCHED;
            PG8_LDA(At, 0, 1); PG8_STAGE(PG8_SB(0, 0), b2, voffB); PG8_STAGE(PG8_SB(0, 1), b2 + bstep, voffB); PG8_STAGE(PG8_SA(0, 0), a2, voffA);
            PG8_WAIT_V(8); PG8_WAIT_L(0); PG8_BAR; PG8_MMA(1, 0, At, B0); PG8_MMA(1, 1, At, B1); PG8_BAR; PG8_SCHED;
            PG8_LDB(B0, 1, 0); PG8_LDB(B1, 1, 1); PG8_SCHED; PG8_LDA(At, 1, 0); PG8_STAGE(PG8_SA(0, 1), a2 + hstep, voffA);
            PG8_WAIT_V(8); PG8_WAIT_L(0); PG8_BAR; PG8_MMA(0, 0, At, B0); PG8_MMA(0, 1, At, B1); PG8_BAR; PG8_SCHED;
            PG8_LDA(At, 1, 1); PG8_STAGE(PG8_SB(1, 0), b3, voffB); PG8_STAGE(PG8_SB(1, 1), b3 + bstep, voffB); PG8_STAGE(PG8_SA(1, 0), a3, voffA);
            PG8_WAIT_V(8); PG8_WAIT_L(0); PG8_BAR; PG8_MMA(1, 0, At, B0); PG8_MMA(1, 1, At, B1); PG8_BAR; PG8_SCHED;
        }
        if (wr == 0) PG8_BAR;
        E.run(acc, cur, wr, wc, fr, fq, xl, lane);
        if (!has_next) break;
#pragma unroll
        for (int a = 0; a < 2; ++a)
#pragma unroll
            for (int b = 0; b < 2; ++b)
#pragma unroll
                for (int m = 0; m < 4; ++m)
#pragma unroll
                    for (int n = 0; n < 2; ++n) acc[a][b][m][n] = (f32x4){0.f, 0.f, 0.f, 0.f};
        cur = nxt; cA = nA; cB = nB; ++ui;
        if (wr == 1) PG8_BAR;
    }
    PG8_WAIT_V(0);
    PG8_BAR;
#undef PG8_SA
#undef PG8_SB
#undef PG8_STAGE
#undef PG8_LDA
#undef PG8_LDB
#undef PG8_MMA
#undef PG8_WAIT_V
#undef PG8_WAIT_L
#undef PG8_BAR
#undef PG8_SCHED
}

struct SchedOne {
    const char* A; const char* Bt; int x, c, ntile; size_t tstep;
    __device__ __forceinline__ bool next(int i, Unit& u) const { const int j = i * 32 + c; if (j >= ntile) return false; u.pm = 8 * x + (j & 7); u.pn = j >> 3; u.kind = 0; u.a = A + (size_t)u.pm * tstep; u.b = Bt + (size_t)u.pn * tstep; return true; }
};
struct SchedP1 {
    const char *outb, *ws; int x, c;
    __device__ __forceinline__ bool next(int i, Unit& u) const {
        const int j = i * 32 + c; if (j >= 192) return false; constexpr size_t tstep = (size_t)256 * D * 2;
        if (j < 184) { u.pm = 8 * x + (j & 7); u.pn = j >> 3; const int pn = u.pn; u.kind = pn < 4 ? 0 : pn < 10 ? 1 : pn < 14 ? 2 : pn < 18 ? 3 : pn < 22 ? 4 : 5; u.a = ws + WS_XB + (size_t)u.pm * tstep; u.b = ws + WS_WIN + (size_t)pn * tstep; }
        else { u.pm = x; u.pn = j - 184; u.kind = u.pn < 4 ? 6 : 7; u.a = ws + WS_MEMN + (size_t)u.pm * tstep; u.b = ws + WS_XKV + (size_t)u.pn * tstep; }
        return true;
    }
};

__device__ __forceinline__ float row_ssq64(const Acc& acc, int ai, int m) {
    float s = 0.f;
#pragma unroll
    for (int bj = 0; bj < 2; ++bj)
#pragma unroll
        for (int n = 0; n < 2; ++n) { const f32x4 v = acc[ai][bj][m][n]; s += (v[0] * v[0] + v[1] * v[1]) + (v[2] * v[2] + v[3] * v[3]); }
    s += __shfl_xor(s, 16); s += __shfl_xor(s, 32); return s;
}
__device__ __forceinline__ void row_ssq256(const Acc& acc, int wr, int wc, int fr, int fq, LAS unsigned char* xl, float (&tot)[2][4]) {
    LAS float* Pp = (LAS float*)xl;
#pragma unroll
    for (int ai = 0; ai < 2; ++ai)
#pragma unroll
        for (int m = 0; m < 4; ++m) { const float s = row_ssq64(acc, ai, m); if (fq == 0) Pp[(ai * HALF + wr * 64 + m * 16 + fr) * 4 + wc] = s; }
    asm volatile("s_waitcnt lgkmcnt(0)" ::: "memory"); __builtin_amdgcn_s_barrier(); asm volatile("" ::: "memory");
#pragma unroll
    for (int ai = 0; ai < 2; ++ai)
#pragma unroll
        for (int m = 0; m < 4; ++m) { const f32x4 p = *(const LAS f32x4*)(Pp + (ai * HALF + wr * 64 + m * 16 + fr) * 4); tot[ai][m] = (p[0] + p[1]) + (p[2] + p[3]); }
    asm volatile("s_waitcnt lgkmcnt(0)" ::: "memory"); __builtin_amdgcn_s_barrier(); asm volatile("" ::: "memory");
}
__device__ __forceinline__ u32x4 pack8(const f32x4 a, const f32x4 b) { u32x4 w; w.x = cvt_pk_bf16(a[0], a[1]); w.y = cvt_pk_bf16(a[2], a[3]); w.z = cvt_pk_bf16(b[0], b[1]); w.w = cvt_pk_bf16(b[2], b[3]); return w; }
__device__ __forceinline__ float sum16(const float* p) { const f32x4 a = *(const f32x4*)p, b = *(const f32x4*)(p + 4), c = *(const f32x4*)(p + 8), d = *(const f32x4*)(p + 12);
    return ((a[0] + a[1]) + (a[2] + a[3])) + ((b[0] + b[1]) + (b[2] + b[3])) + ((c[0] + c[1]) + (c[2] + c[3])) + ((d[0] + d[1]) + (d[2] + d[3])); }

__device__ __forceinline__ float softplus_fast(float x) {
    const float t = __builtin_amdgcn_exp2f(fminf(x, 60.f) * LOG2E);
    const float small = t * (1.f - t * (0.5f - t * 0.33333334f)), big = __builtin_amdgcn_logf(1.f + t) * 0.6931471805599453f;
    return x > 20.f ? x : (t < 0.015625f ? small : big);
}
struct EpiP1 {
    static constexpr bool KSEG = false;
    PtrsK PP;
    __device__ __forceinline__ void kseg(Acc&, const Unit&, int, int, int, LAS unsigned char*) const {}
    __device__ __forceinline__ void prepare(LAS unsigned char* xl, const Unit& u, int tid) const {
        if (tid < 256) ((LAS float*)(xl + 4096))[tid] = ((const float*)(PP->ws + WS_RSTD1))[u.pm * BM + tid]; }
    template <int KIND> __device__ __forceinline__ void body(Acc& acc, const Unit& u, int wr, int wc, int fr, int fq, LAS unsigned char* xl, bf16_t* base, int ldc, int colt, const float* gp) const {
        const int rowt = wr * 64 + fr, row0 = u.pm * BM + rowt, colw = wc * 64 + 8 * fq;
        const LAS float* RSC = (const LAS float*)(xl + 4096) + rowt;
        float tot[2][4];
        if (KIND == 6) row_ssq256(acc, wr, wc, fr, fq, xl, tot);
        f32x4 g[2][2];
        if (KIND == 2 || KIND == 3 || KIND == 6) {
#pragma unroll
            for (int bj = 0; bj < 2; ++bj)
#pragma unroll
                for (int n = 0; n < 2; ++n) g[bj][n] = *(const f32x4*)(gp + bj * 32 + n * 4);
        }
#pragma unroll
        for (int ai = 0; ai < 2; ++ai)
#pragma unroll
            for (int m = 0; m < 4; ++m) {
                const int row = row0 + ai * HALF + m * 16;
                float rs = KIND < 6 ? RSC[ai * HALF + m * 16] : 1.f;
                if (KIND == 2 || KIND == 3) { const float s2 = row_ssq64(acc, ai, m) * rs * rs; rs *= rsqrtf(s2 * (1.f / 64.f) + EPS); if (KIND == 2) rs *= C2; }
                if (KIND == 6) rs = rsqrtf(tot[ai][m] * (1.f / 256.f) + EPS);
                bf16_t* rowp = base + (size_t)row * ldc + colt + colw;
#pragma unroll
                for (int bj = 0; bj < 2; ++bj) {
                    f32x4 v0 = acc[ai][bj][m][0], v1 = acc[ai][bj][m][1];
                    if (KIND != 7) { v0 = v0 * rs; v1 = v1 * rs; }
                    if (KIND == 2 || KIND == 3 || KIND == 6) { v0 = v0 * g[bj][0]; v1 = v1 * g[bj][1]; }
                    if (KIND == 0) {
#pragma unroll
                        for (int e = 0; e < 4; ++e) { v0[e] = silu_f(v0[e]); v1[e] = silu_f(v1[e]); } }
                    *(u32x4*)(rowp + bj * 32) = pack8(v0, v1);
                }
            }
    }
    __device__ __forceinline__ void run(Acc& acc, const Unit& u, int wr, int wc, int fr, int fq, LAS unsigned char* xl, int lane) const {
        const int kind = u.kind; unsigned char* ws = PP->ws; const int colw = wc * 64 + 8 * fq;
        switch (kind) {
        case 0: body<0>(acc, u, wr, wc, fr, fq, xl, (bf16_t*)(ws + WS_ZS), 1024, u.pn * 256, nullptr); break;
        case 1: if (u.pn < 6) body<1>(acc, u, wr, wc, fr, fq, xl, (bf16_t*)(ws + WS_XRA), 512, (u.pn - 4) * 256, nullptr);
                else if (u.pn < 8) body<1>(acc, u, wr, wc, fr, fq, xl, (bf16_t*)((unsigned char*)PP->out + DO_XRB), 512, (u.pn - 6) * 256, nullptr);
                else body<1>(acc, u, wr, wc, fr, fq, xl, (bf16_t*)(ws + WS_BCR), 512, (u.pn - 8) * 256, nullptr); break;
        case 2: body<2>(acc, u, wr, wc, fr, fq, xl, (bf16_t*)(ws + WS_Q), 1024, (u.pn - 10) * 256, PP->g_q + 8 * fq); break;
        case 3: body<3>(acc, u, wr, wc, fr, fq, xl, (bf16_t*)(ws + WS_K), 1024, (u.pn - 14) * 256, PP->g_k + 8 * fq); break;
        case 4: body<1>(acc, u, wr, wc, fr, fq, xl, (bf16_t*)(ws + WS_V), 1024, (u.pn - 18) * 256, nullptr); break;
        case 6: body<6>(acc, u, wr, wc, fr, fq, xl, (bf16_t*)(ws + WS_KX), 1024, u.pn * 256, PP->xg_k + colw); break;
        case 7: body<7>(acc, u, wr, wc, fr, fq, xl, (bf16_t*)(ws + WS_VX), 1024, (u.pn - 4) * 256, nullptr); break;
        default: {
            if (wc == 0) {
                const int rowt = wr * 64 + fr, row0 = u.pm * BM + rowt; const LAS float* RSC = (const LAS float*)(xl + 4096) + rowt;
                const int c0 = 8 * fq; const bool isdt = fq < 2;
                const float* bias = isdt ? PP->dt_bias + c0 : PP->f_bias + (c0 - 16); float* dst = isdt ? (float*)(ws + WS_DT) + c0 : (float*)(ws + WS_LF) + (c0 - 16);
                const f32x4 b0 = *(const f32x4*)bias, b1 = *(const f32x4*)(bias + 4); const float sg = isdt ? 1.f : -1.f;
#pragma unroll
                for (int ai = 0; ai < 2; ++ai)
#pragma unroll
                    for (int m = 0; m < 4; ++m) { const int row = row0 + ai * HALF + m * 16; const float rs = RSC[ai * HALF + m * 16];
                        f32x4 v0 = acc[ai][0][m][0] * rs + b0, v1 = acc[ai][0][m][1] * rs + b1;
#pragma unroll
                        for (int e = 0; e < 4; ++e) { v0[e] = sg * softplus_fast(sg * v0[e]); v1[e] = sg * softplus_fast(sg * v1[e]); }
                        *(f32x4*)(dst + (size_t)row * 16) = v0; *(f32x4*)(dst + (size_t)row * 16 + 4) = v1; }
            } } break;
        }
    }
};
template <bool KSEG_, bool BASE_BF16> struct EpiRes {
    static constexpr bool KSEG = KSEG_;
    const void* base; bf16_t* XBo; float* SSQo; const float* SSQi;
    __device__ __forceinline__ void prepare(LAS unsigned char* xl, const Unit& u, int tid) const {
        if (KSEG_ && tid < 256) { const float* sp = SSQi + (size_t)(u.pm * BM + tid) * 16;
            const f32x4 a = *(const f32x4*)sp, b = *(const f32x4*)(sp + 4), c = *(const f32x4*)(sp + 8), d = *(const f32x4*)(sp + 12);
            const float q0 = ((a[0] + a[1]) + (a[2] + a[3])) + ((b[0] + b[1]) + (b[2] + b[3])), q1 = ((c[0] + c[1]) + (c[2] + c[3])) + ((d[0] + d[1]) + (d[2] + d[3]));
            const float r0 = rsqrtf(q0 * (1.f / 512.f) + EPS), r1 = rsqrtf(q1 * (1.f / 512.f) + EPS);
            ((LAS float*)(xl + 4096))[tid] = r0 / r1; ((LAS float*)(xl + 5120))[tid] = r1; } }
    __device__ __forceinline__ void kseg(Acc& acc, const Unit& u, int t, int wr, int fr, LAS unsigned char* xl) const {
        const LAS float* F = (const LAS float*)(xl + (t == 8 ? 4096 : 5120)) + wr * 64 + fr;
#pragma unroll
        for (int ai = 0; ai < 2; ++ai)
#pragma unroll
            for (int m = 0; m < 4; ++m) { const float f = F[ai * HALF + m * 16];
#pragma unroll
                for (int bj = 0; bj < 2; ++bj)
#pragma unroll
                    for (int n = 0; n < 2; ++n) acc[ai][bj][m][n] = acc[ai][bj][m][n] * f; }
    }
    __device__ __forceinline__ void run(Acc& acc, const Unit& u, int wr, int wc, int fr, int fq, LAS unsigned char* xl, int lane) const {
        const int row0 = u.pm * BM + wr * 64 + fr, col0 = u.pn * 256 + wc * 64 + 8 * fq;
#pragma unroll
        for (int ai = 0; ai < 2; ++ai) {
            f32x4 xr[4][2][2];
#pragma unroll
            for (int m = 0; m < 4; ++m) { const size_t off = (size_t)(row0 + ai * HALF + m * 16) * D + col0;
#pragma unroll
                for (int bj = 0; bj < 2; ++bj) {
                    if (BASE_BF16) { const u32x4 w = *(const u32x4*)((const bf16_t*)base + off + bj * 32);
                        xr[m][bj][0] = (f32x4){__uint_as_float(w.x << 16), __uint_as_float(w.x & 0xffff0000u), __uint_as_float(w.y << 16), __uint_as_float(w.y & 0xffff0000u)};
                        xr[m][bj][1] = (f32x4){__uint_as_float(w.z << 16), __uint_as_float(w.z & 0xffff0000u), __uint_as_float(w.w << 16), __uint_as_float(w.w & 0xffff0000u)}; }
                    else { xr[m][bj][0] = __builtin_nontemporal_load((const f32x4*)((const float*)base + off + bj * 32)); xr[m][bj][1] = __builtin_nontemporal_load((const f32x4*)((const float*)base + off + bj * 32 + 4)); } } }
            asm volatile("" ::: "memory");
#pragma unroll
            for (int m = 0; m < 4; ++m) { const int row = row0 + ai * HALF + m * 16; const size_t off = (size_t)row * D + col0; float s = 0.f;
#pragma unroll
                for (int bj = 0; bj < 2; ++bj) {
                    const f32x4 v0 = acc[ai][bj][m][0] + xr[m][bj][0], v1 = acc[ai][bj][m][1] + xr[m][bj][1];
                    *(u32x4*)(XBo + off + bj * 32) = pack8(v0, v1);
                    s += ((v0[0] * v0[0] + v0[1] * v0[1]) + (v0[2] * v0[2] + v0[3] * v0[3])) + ((v1[0] * v1[0] + v1[1] * v1[1]) + (v1[2] * v1[2] + v1[3] * v1[3])); }
                s += __shfl_xor(s, 16); s += __shfl_xor(s, 32);
                if (fq == 0) SSQo[(size_t)row * 16 + u.pn * 4 + wc] = s; }
            asm volatile("" ::: "memory"); }
    }
};
struct EpiXq {
    static constexpr bool KSEG = false;
    const float *SSQ2, *xg_q; bf16_t* QX;
    __device__ __forceinline__ void kseg(Acc&, const Unit&, int, int, int, LAS unsigned char*) const {}
    __device__ __forceinline__ void prepare(LAS unsigned char* xl, const Unit& u, int tid) const {
        if (tid < 256) ((LAS float*)(xl + 4096))[tid] = rsqrtf(sum16(SSQ2 + (size_t)(u.pm * BM + tid) * 16) * (1.f / 1024.f) + EPS); }
    __device__ __forceinline__ void run(Acc& acc, const Unit& u, int wr, int wc, int fr, int fq, LAS unsigned char* xl, int lane) const {
        const int row0 = u.pm * BM + wr * 64 + fr, colw = wc * 64 + 8 * fq;
        float tot[2][4];
        row_ssq256(acc, wr, wc, fr, fq, xl, tot);
        f32x4 g[2][2];
#pragma unroll
        for (int bj = 0; bj < 2; ++bj)
#pragma unroll
            for (int n = 0; n < 2; ++n) g[bj][n] = *(const f32x4*)(xg_q + colw + bj * 32 + n * 4);
#pragma unroll
        for (int ai = 0; ai < 2; ++ai)
#pragma unroll
            for (int m = 0; m < 4; ++m) { const int row = row0 + ai * HALF + m * 16;
                const float rs2 = ((const LAS float*)(xl + 4096))[wr * 64 + fr + ai * HALF + m * 16];
                const float rs = rs2 * rsqrtf(tot[ai][m] * rs2 * rs2 * (1.f / 256.f) + EPS) * CX2;
                bf16_t* rowp = QX + (size_t)row * D + u.pn * 256 + colw;
#pragma unroll
                for (int bj = 0; bj < 2; ++bj) *(u32x4*)(rowp + bj * 32) = pack8(acc[ai][bj][m][0] * rs * g[bj][0], acc[ai][bj][m][1] * rs * g[bj][1]); }
    }
};
struct EpiUp {
    static constexpr bool KSEG = false;
    const float* SSQ3; bf16_t* HB;
    __device__ __forceinline__ void kseg(Acc&, const Unit&, int, int, int, LAS unsigned char*) const {}
    __device__ __forceinline__ void prepare(LAS unsigned char* xl, const Unit& u, int tid) const {
        if (tid < 256) ((LAS float*)(xl + 4096))[tid] = rsqrtf(sum16(SSQ3 + (size_t)(u.pm * BM + tid) * 16) * (1.f / 1024.f) + EPS); }
    __device__ __forceinline__ void run(Acc& acc, const Unit& u, int wr, int wc, int fr, int fq, LAS unsigned char* xl, int lane) const {
        const int row0 = u.pm * BM + wr * 64 + fr, colw = wc * 64 + 8 * fq;
#pragma unroll
        for (int ai = 0; ai < 2; ++ai)
#pragma unroll
            for (int m = 0; m < 4; ++m) { const int row = row0 + ai * HALF + m * 16;
                const float rs = ((const LAS float*)(xl + 4096))[wr * 64 + fr + ai * HALF + m * 16];
                bf16_t* rowp = HB + (size_t)row * FF + u.pn * 256 + colw;
#pragma unroll
                for (int bj = 0; bj < 2; ++bj) { f32x4 v0 = acc[ai][bj][m][0] * rs, v1 = acc[ai][bj][m][1] * rs;
#pragma unroll
                    for (int e = 0; e < 4; ++e) { const float a = fmaxf(v0[e], 0.f), b = fmaxf(v1[e], 0.f); v0[e] = a * a; v1[e] = b * b; }
                    *(u32x4*)(rowp + bj * 32) = pack8(v0, v1); } }
    }
};
struct EpiDown {
    static constexpr bool KSEG = false;
    const bf16_t* X2B; float* out;
    __device__ __forceinline__ void kseg(Acc&, const Unit&, int, int, int, LAS unsigned char*) const {}
    __device__ __forceinline__ void prepare(LAS unsigned char*, const Unit&, int) const {}
    __device__ __forceinline__ void run(Acc& acc, const Unit& u, int wr, int wc, int fr, int fq, LAS unsigned char* xl, int lane) const {
        const int row0 = u.pm * BM + wr * 64 + fr, col0 = u.pn * 256 + wc * 64 + 8 * fq;
#pragma unroll
        for (int ai = 0; ai < 2; ++ai) {
            u32x4 w[4][2];
#pragma unroll
            for (int m = 0; m < 4; ++m)
#pragma unroll
                for (int bj = 0; bj < 2; ++bj) w[m][bj] = *(const u32x4*)(X2B + (size_t)(row0 + ai * HALF + m * 16) * D + col0 + bj * 32);
            asm volatile("" ::: "memory");
#pragma unroll
            for (int m = 0; m < 4; ++m) { const size_t off = (size_t)(row0 + ai * HALF + m * 16) * D + col0;
#pragma unroll
                for (int bj = 0; bj < 2; ++bj) { const u32x4 ww = w[m][bj];
                    const f32x4 x0 = (f32x4){__uint_as_float(ww.x << 16), __uint_as_float(ww.x & 0xffff0000u), __uint_as_float(ww.y << 16), __uint_as_float(ww.y & 0xffff0000u)};
                    const f32x4 x1 = (f32x4){__uint_as_float(ww.z << 16), __uint_as_float(ww.z & 0xffff0000u), __uint_as_float(ww.w << 16), __uint_as_float(ww.w & 0xffff0000u)};
                    *(f32x4*)(out + off + bj * 32) = acc[ai][bj][m][0] + x0; *(f32x4*)(out + off + bj * 32 + 4) = acc[ai][bj][m][1] + x1; } }
            asm volatile("" ::: "memory"); }
    }
};
}

namespace attn_body {
using bf16=__hip_bfloat16;
using bf16x8=__attribute__((ext_vector_type(8)))short;
using s16x4=__attribute__((ext_vector_type(4)))short;
using f32x16=__attribute__((ext_vector_type(16)))float;
using u32x4=__attribute__((ext_vector_type(4)))unsigned;
using f32x4_t=__attribute__((ext_vector_type(4)))float;
constexpr int BATCH=8,NHEAD=16,SEQ=2048,D=64,DM=NHEAD*D,OPITCH=2048,OCOL0=1024;
constexpr int NW=8,QBLK=32,QB=QBLK*NW,KVBLK=64,NQB=SEQ/QB;
constexpr int ATTN_PITCH=DM, ATTN_UNIT_ROWS=QB;
__device__ __forceinline__ int crow(int r,int hi){return (r&3)+8*(r>>2)+4*hi;}
#define SBAR() __builtin_amdgcn_sched_barrier(0)
__device__ __forceinline__ void cmask(f32x16&p0,f32x16&p1,int jb,int qrel,int hi){
  const float NEG=-INFINITY; int kb=64*jb+4*hi;
  #pragma unroll
  for(int r=0;r<16;++r){int kv=kb+(r&3)+8*(r>>2); if(kv>qrel)p0[r]=NEG; if(kv+32>qrel)p1[r]=NEG;}
}

constexpr int NSLOT=3, SLOTB=8192;
constexpr int LDS_K=0, LDS_V=NSLOT*SLOTB, LDS_WS=2*NSLOT*SLOTB, LDS_OST=LDS_WS+NW*64*4, LDS_CBL=LDS_OST+NW*4096, LDS_BYTES=LDS_CBL+SEQ*4;
__device__ __forceinline__ void glds16(const void*sbase,unsigned voff,unsigned lds_dst){unsigned keep;
  asm volatile("s_mov_b32 %0, m0\n\ts_mov_b32 m0, %2\n\ts_nop 4\n\tglobal_load_lds_dwordx4 %1, %3\n\ts_mov_b32 m0, %0":"=&s"(keep):"v"(voff),"s"(lds_dst),"s"(sbase):"memory");}
__device__ __forceinline__ float max3f(float a,float b,float c){float r;asm("v_max3_f32 %0, %1, %2, %3":"=v"(r):"v"(a),"v"(b),"v"(c));return r;}
__device__ __forceinline__ float max2f(float a,float b){float r;asm("v_max_f32_e32 %0, %1, %2":"=v"(r):"v"(a),"v"(b));return r;}
__device__ __forceinline__ float fadd_s(float a,float b){float r;asm("v_add_f32_e32 %0, %1, %2":"=v"(r):"v"(a),"v"(b));return r;}
__device__ __forceinline__ float fsub_s(float a,float b){float r;asm("v_sub_f32_e32 %0, %1, %2":"=v"(r):"v"(a),"v"(b));return r;}
typedef float f32x2_t __attribute__((ext_vector_type(2))); typedef __bf16 bf16x2_t __attribute__((ext_vector_type(2)));
__device__ __forceinline__ unsigned cvtpk_s(float lo,float hi){f32x2_t v={lo,hi};bf16x2_t b=__builtin_convertvector(v,bf16x2_t);return __builtin_bit_cast(unsigned,b);}
#define WAIT_BAR(N) asm volatile("s_waitcnt vmcnt(" #N ") lgkmcnt(0)\n\ts_barrier":::"memory")

__device__ __forceinline__ void qkt(f32x16&p0,f32x16&p1,const char*Kslot,const bf16x8*qr,int r32,int hi){
  const char*kb=Kslot+hi*1024+r32*16;
  #pragma unroll
  for(int d0=0;d0<4;++d0){
    const bf16x8 b0=*reinterpret_cast<const bf16x8*>(kb+d0*2048);
    const bf16x8 b1=*reinterpret_cast<const bf16x8*>(kb+d0*2048+512);
    p0=__builtin_amdgcn_mfma_f32_32x32x16_bf16(b0,qr[d0],p0,0,0,0);p1=__builtin_amdgcn_mfma_f32_32x32x16_bf16(b1,qr[d0],p1,0,0,0);}
}
typedef __attribute__((address_space(3))) const char* lds_cptr;
typedef short v4i16_t __attribute__((ext_vector_type(4)));
__device__ __forceinline__ void kload8(bf16x8*kf,lds_cptr kp){
  kf[0]=*(const __attribute__((address_space(3))) bf16x8*)(kp);      kf[1]=*(const __attribute__((address_space(3))) bf16x8*)(kp+512);
  kf[2]=*(const __attribute__((address_space(3))) bf16x8*)(kp+2048); kf[3]=*(const __attribute__((address_space(3))) bf16x8*)(kp+2560);
  kf[4]=*(const __attribute__((address_space(3))) bf16x8*)(kp+4096); kf[5]=*(const __attribute__((address_space(3))) bf16x8*)(kp+4608);
  kf[6]=*(const __attribute__((address_space(3))) bf16x8*)(kp+6144); kf[7]=*(const __attribute__((address_space(3))) bf16x8*)(kp+6656);
}
__device__ __forceinline__ void kload2(bf16x8*kf,lds_cptr kp,int j){ kf[2*j]=*(const __attribute__((address_space(3))) bf16x8*)(kp+j*2048); kf[2*j+1]=*(const __attribute__((address_space(3))) bf16x8*)(kp+j*2048+512); }
__device__ __forceinline__ s16x4 vtr(lds_cptr p){ return __builtin_bit_cast(s16x4,__builtin_amdgcn_ds_read_tr16_b64_v4i16((__attribute__((address_space(3))) v4i16_t*)p)); }
__device__ __forceinline__ float rowmax(const f32x16&p0,const f32x16&p1){
  float a=max3f(p0[0],p0[1],p1[0]),b=max3f(p0[2],p0[3],p1[1]);a=max3f(a,p1[2],p1[3]);
  #pragma unroll
  for(int r=4;r<16;r+=4){a=max3f(a,p0[r],p0[r+1]);b=max3f(b,p0[r+2],p0[r+3]);a=max3f(a,p1[r],p1[r+1]);b=max3f(b,p1[r+2],p1[r+3]);}
  const float m=max2f(a,b);
  auto rr=__builtin_amdgcn_permlane32_swap(__float_as_uint(m),__float_as_uint(m),false,false);
  return max2f(__uint_as_float(rr[0]),__uint_as_float(rr[1]));
}
__device__ __forceinline__ void pv(f32x16*o,int vb,bf16x8 pa0,bf16x8 pa1,bf16x8 pa2,bf16x8 pa3){
  #pragma unroll
  for(int d0=0;d0<2;++d0){s16x4 lo[4],hi[4];
    #pragma unroll
    for(int ks=0;ks<4;++ks){
      asm volatile("ds_read_b64_tr_b16 %0,%1 offset:%c2":"=&v"(lo[ks]):"v"(vb),"i"(d0*4096+ks*1024):"memory");
      asm volatile("ds_read_b64_tr_b16 %0,%1 offset:%c2":"=&v"(hi[ks]):"v"(vb),"i"(d0*4096+ks*1024+512):"memory");}
    asm volatile("s_waitcnt lgkmcnt(0)":::"memory");SBAR();
    #define PK(k) (bf16x8){lo[k][0],lo[k][1],lo[k][2],lo[k][3],hi[k][0],hi[k][1],hi[k][2],hi[k][3]}
    o[d0]=__builtin_amdgcn_mfma_f32_32x32x16_bf16(pa0,PK(0),o[d0],0,0,0);
    o[d0]=__builtin_amdgcn_mfma_f32_32x32x16_bf16(pa1,PK(1),o[d0],0,0,0);
    o[d0]=__builtin_amdgcn_mfma_f32_32x32x16_bf16(pa2,PK(2),o[d0],0,0,0);
    o[d0]=__builtin_amdgcn_mfma_f32_32x32x16_bf16(pa3,PK(3),o[d0],0,0,0);
    #undef PK
  }
}

#ifndef ATTN_STORE16
#define ATTN_STORE16(p,v) (*(u32x4*)(p)=(v))
#endif
template<int THRL> __device__ __forceinline__ void attn_unit(int b,int h,int qb,const bf16*Q,const bf16*__restrict__ K,const bf16*__restrict__ V,bf16*O,char*shm,int&r0,const bool pre,const bool pre_next){
  const int tid=threadIdx.x,lane=tid&63,r32=lane&31,hi=lane>>5; const int wid=__builtin_amdgcn_readfirstlane(tid>>6);
  const long rowbase=(long)b*SEQ; const int q0=qb*QB;
  const bf16*Qw=Q+(rowbase+q0+wid*QBLK)*DM+h*D;
  const bf16*Kh=K+rowbase*DM+h*D,*Vh=V+rowbase*DM+h*D;
  const unsigned lds0=(unsigned)(uintptr_t)shm;
  float*wsf=(float*)(shm+LDS_WS)+wid*64;
  const unsigned koff=(unsigned)((lane*DM+wid*8)*2);
  const unsigned voff=(unsigned)(((16*(wid&3)+(lane>>2))*DM+(wid>>2)*32+(lane&3)*8)*2);
  const unsigned kdst=lds0+LDS_K+wid*1024, vdst=lds0+LDS_V+wid*1024;
  #define DMA_K(t,slot) glds16(Kh+(long)(t)*KVBLK*DM,koff,(unsigned)__builtin_amdgcn_readfirstlane(kdst+(slot)))
  #define DMA_V(t,slot) glds16(Vh+(long)(t)*KVBLK*DM,voff,(unsigned)__builtin_amdgcn_readfirstlane(vdst+(slot)))
  const int vb0=(int)(lds0+LDS_V)+((lane>>4)&1)*32+(lane&3)*8+(4*hi+((lane&15)>>2))*64;
  const char*Kbase=shm+LDS_K; bf16x8 kf[8];
  const lds_cptr shm3=(lds_cptr)shm; const lds_cptr kp0=shm3+LDS_K+hi*1024+r32*16; const lds_cptr vp0=shm3+LDS_V+((lane>>4)&1)*32+(lane&3)*8+(4*hi+((lane&15)>>2))*64;
  const int NT=(q0+QB)/KVBLK;
  const int s0=r0*SLOTB, s1=(r0==2?0:r0+1)*SLOTB, s2=(r0==0?2:r0-1)*SLOTB;
  if(!pre){ DMA_K(0,s0);DMA_V(0,s0);DMA_K(1,s1); }
  bf16x8 qr[4];
  #pragma unroll
  for(int d0=0;d0<4;++d0)qr[d0]=*reinterpret_cast<const bf16x8*>(&Qw[(long)r32*DM+d0*16+hi*8]);
  float mhat=0.f,l_reg=0.f;f32x16 o[2];o[0]=f32x16{};o[1]=f32x16{};
  const int qrel=wid*QBLK+r32;
  #define CMASK(P0,P1,t) do{int jb_=(t)-(NT-4); if(jb_>=0)cmask(P0,P1,jb_,qrel,hi);}while(0)
  typedef __attribute__((address_space(3))) const f32x4_t* lds_f4p;
  #define CIN(C0,C1,t) do{ const float nm_=-mhat; const lds_f4p cp_=(lds_f4p)(shm3+LDS_CBL+(t)*256+hi*16); \
    const f32x4_t b0_=cp_[0],b1_=cp_[2],b2_=cp_[4],b3_=cp_[6],b4_=cp_[8],b5_=cp_[10],b6_=cp_[12],b7_=cp_[14]; \
    _Pragma("unroll") for(int e_=0;e_<4;++e_){ C0[e_]=nm_-b0_[e_]; C0[4+e_]=nm_-b1_[e_]; C0[8+e_]=nm_-b2_[e_]; C0[12+e_]=nm_-b3_[e_]; C1[e_]=nm_-b4_[e_]; C1[4+e_]=nm_-b5_[e_]; C1[8+e_]=nm_-b6_[e_]; C1[12+e_]=nm_-b7_[e_]; } \
    asm volatile("":"+v"(C0),"+v"(C1)); }while(0)
  bool resc=false;
  #define START(P0,P1) do{ const float rm=rowmax(P0,P1); resc=false; \
    { const float dl=rm; mhat=fadd_s(mhat,dl); \
      _Pragma("unroll") for(int r=0;r<16;++r){P0[r]=fsub_s(P0[r],dl);P1[r]=fsub_s(P1[r],dl);} } \
    _Pragma("unroll") for(int r=0;r<16;++r)P0[r]=__builtin_amdgcn_exp2f(P0[r]); }while(0)
  #define RESC() do{ if(resc){ asm volatile("s_waitcnt lgkmcnt(0)":::"memory"); \
      _Pragma("unroll") for(int d_=0;d_<2;++d_) _Pragma("unroll") for(int r=0;r<16;++r)o[d_][r]*=wsf[crow(r,hi)]; } }while(0)
  f32x16 pA0,pA1,pB0,pB1;
  int sl_prev=s0,sl_cur=s0,sl_next=s1;
  #define ROT() do{sl_prev=sl_cur;sl_cur=sl_next;sl_next=(sl_next==(NSLOT-1)*SLOTB)?0:sl_next+SLOTB;}while(0)
  if(!pre){ DMA_K(2,s2); }
  WAIT_BAR(3);
  CIN(pA0,pA1,0);
  qkt(pA0,pA1,Kbase+s0,qr,r32,hi);asm volatile("s_nop 15\n\ts_nop 7":"+v"(pA0),"+v"(pA1));CMASK(pA0,pA1,0);
  START(pA0,pA1);
  _Pragma("unroll") for(int r=0;r<16;++r)pA1[r]=__builtin_amdgcn_exp2f(pA1[r]);
  WAIT_BAR(0);
  DMA_K(3,s0);DMA_V(1,s1);
  ROT();
  kload8(kf,kp0+sl_cur);
  WAIT_BAR(2);
  s16x4 vlo[8],vhi[8]; u32x4 pw0,pw1,pw2,pw3;
  #define PKW(P,B) cvtpk_s(P[B],P[B+1])
  #define PAF(k) __builtin_bit_cast(bf16x8,pw##k)
  #define VFR(i) (bf16x8){vlo[i][0],vlo[i][1],vlo[i][2],vlo[i][3],vhi[i][0],vhi[i][1],vhi[i][2],vhi[i][3]}
  #define PIN(x) asm volatile("":"+v"(x))
  #define MX3(a,b,c) __builtin_fmaxf(__builtin_fmaxf((a),(b)),(c))
  #define GAPA(MF,A0,A1,A2,A3,W0,W1,PW) do{ MF; sacc+=A0; sacc+=A1; sacc+=A2; sacc+=A3; PIN(sacc); W0; W1; PIN(PW); SBAR(); }while(0)
  #define EX(v) __builtin_amdgcn_exp2f(v)
  #define GAPB(MF,X,B) do{ MF; X[B]=EX(X[B]); X[B+1]=EX(X[B+1]); X[B+2]=EX(X[B+2]); X[B+3]=EX(X[B+3]); PIN(X); SBAR(); }while(0)
  #define VRD(i) do{ vlo[i]=vtr(vp_+(((i)>>2)*4096+((i)&3)*1024)); vhi[i]=vtr(vp_+(((i)>>2)*4096+((i)&3)*1024+512)); }while(0)
  #define KRD(G,j) do{ if(G){ kload2(kf,kp0+sl_next,j); SBAR(); } }while(0)
  #define STEP(C0,C1,P0,P1,t,GK,GV,GL) do{ SBAR(); CIN(C0,C1,t); SBAR(); \
    const lds_cptr vp_=vp0+sl_prev; \
    VRD(0); SBAR(); float sacc=(P0[0]+P0[1]); \
    GAPA(C0=__builtin_amdgcn_mfma_f32_32x32x16_bf16(kf[0],qr[0],C0,0,0,0), P0[2],P0[3],P0[4],P0[5],     pw0[0]=PKW(P0,0), pw0[1]=PKW(P0,2), pw0); \
    VRD(4); SBAR(); GAPA(C1=__builtin_amdgcn_mfma_f32_32x32x16_bf16(kf[1],qr[0],C1,0,0,0), P0[6],P0[7],P0[8],P0[9],     pw0[2]=PKW(P0,4), pw0[3]=PKW(P0,6), pw0); \
    VRD(1); SBAR(); GAPA(C0=__builtin_amdgcn_mfma_f32_32x32x16_bf16(kf[2],qr[1],C0,0,0,0),   P0[10],P0[11],P0[12],P0[13], pw1[0]=PKW(P0,8), pw1[1]=PKW(P0,10), pw1); \
    VRD(5); SBAR(); GAPA(C1=__builtin_amdgcn_mfma_f32_32x32x16_bf16(kf[3],qr[1],C1,0,0,0),   P0[14],P0[15],P1[0],P1[1],   pw1[2]=PKW(P0,12),pw1[3]=PKW(P0,14), pw1); \
    VRD(2); SBAR(); GAPA(C0=__builtin_amdgcn_mfma_f32_32x32x16_bf16(kf[4],qr[2],C0,0,0,0),   P1[2],P1[3],P1[4],P1[5],     pw2[0]=PKW(P1,0), pw2[1]=PKW(P1,2), pw2); \
    VRD(6); SBAR(); GAPA(C1=__builtin_amdgcn_mfma_f32_32x32x16_bf16(kf[5],qr[2],C1,0,0,0),   P1[6],P1[7],P1[8],P1[9],     pw2[2]=PKW(P1,4), pw2[3]=PKW(P1,6), pw2); \
    VRD(3); SBAR(); GAPA(C0=__builtin_amdgcn_mfma_f32_32x32x16_bf16(kf[6],qr[3],C0,0,0,0),   P1[10],P1[11],P1[12],P1[13], pw3[0]=PKW(P1,8), pw3[1]=PKW(P1,10), pw3); \
    VRD(7); SBAR(); GAPA(C1=__builtin_amdgcn_mfma_f32_32x32x16_bf16(kf[7],qr[3],C1,0,0,0),   P1[14],P1[15],0.f,0.f,       pw3[2]=PKW(P1,12),pw3[3]=PKW(P1,14), pw3); \
    l_reg+=sacc; \
    if(GK){DMA_K((t)+3,sl_cur);} if(GV){DMA_V((t)+1,sl_next);} \
    CMASK(C0,C1,t); \
    { float a=MX3(C0[0],C0[1],C1[0]),b=MX3(C0[2],C0[3],C1[1]); a=MX3(a,C1[2],C1[3]); \
      _Pragma("unroll") for(int r=4;r<16;r+=4){a=MX3(a,C0[r],C0[r+1]);b=MX3(b,C0[r+2],C0[r+3]);a=MX3(a,C1[r],C1[r+1]);b=MX3(b,C1[r+2],C1[r+3]);} \
      float rm=__builtin_fmaxf(a,b); { auto rr=__builtin_amdgcn_permlane32_swap(__float_as_uint(rm),__float_as_uint(rm),false,false); rm=__builtin_fmaxf(__uint_as_float(rr[0]),__uint_as_float(rr[1])); } \
      resc=false; \
      if(__builtin_expect(__any(rm>(float)THRL),0)){ const float dl=__builtin_fmaxf(rm,0.f); mhat+=dl; \
        _Pragma("unroll") for(int r=0;r<16;++r){C0[r]-=dl;C1[r]-=dl;} \
        const float f=__builtin_amdgcn_exp2f(-dl); l_reg*=f; if(hi==0)wsf[r32]=f; resc=true; } } \
    SBAR(); \
    GAPB(o[0]=__builtin_amdgcn_mfma_f32_32x32x16_bf16(PAF(0),VFR(0),o[0],0,0,0), C0,0); \
    GAPB(o[1]=__builtin_amdgcn_mfma_f32_32x32x16_bf16(PAF(0),VFR(4),o[1],0,0,0), C0,4); \
    KRD(GL,0); GAPB(o[0]=__builtin_amdgcn_mfma_f32_32x32x16_bf16(PAF(1),VFR(1),o[0],0,0,0), C0,8); \
    KRD(GL,1); GAPB(o[1]=__builtin_amdgcn_mfma_f32_32x32x16_bf16(PAF(1),VFR(5),o[1],0,0,0), C0,12); \
    KRD(GL,2); GAPB(o[0]=__builtin_amdgcn_mfma_f32_32x32x16_bf16(PAF(2),VFR(2),o[0],0,0,0), C1,0); \
    KRD(GL,3); GAPB(o[1]=__builtin_amdgcn_mfma_f32_32x32x16_bf16(PAF(2),VFR(6),o[1],0,0,0), C1,4); \
    GAPB(o[0]=__builtin_amdgcn_mfma_f32_32x32x16_bf16(PAF(3),VFR(3),o[0],0,0,0), C1,8); \
    GAPB(o[1]=__builtin_amdgcn_mfma_f32_32x32x16_bf16(PAF(3),VFR(7),o[1],0,0,0), C1,12); \
    }while(0)
  int t=1;
  #undef CMASK
  #define CMASK(P0,P1,t) do{}while(0)
  for(;t+5<NT;t+=2){
    STEP(pB0,pB1,pA0,pA1,t,true,true,true);     WAIT_BAR(2); RESC(); ROT();
    STEP(pA0,pA1,pB0,pB1,t+1,true,true,true);   WAIT_BAR(2); RESC(); ROT();
  }
  #undef CMASK
  #define CMASK(P0,P1,t) do{int jb_=(t)-(NT-4); if(jb_>=0)cmask(P0,P1,jb_,qrel,hi);}while(0)
  #define ENDW(tt) do{ if((tt)+3<NT){WAIT_BAR(2);} else if((tt)+2<NT){WAIT_BAR(1);} else {WAIT_BAR(0);} }while(0)
  for(;t+1<NT;t+=2){
    STEP(pB0,pB1,pA0,pA1,t,(t+3<NT),(t+1<NT),(t+1<NT));       ENDW(t);   RESC(); ROT();
    STEP(pA0,pA1,pB0,pB1,t+1,(t+4<NT),(t+2<NT),(t+2<NT));     ENDW(t+1); RESC(); ROT();
  }
  STEP(pB0,pB1,pA0,pA1,NT-1,false,false,false); RESC();
  { const int rn=(r0+NT)%3;
    if(pre_next){ const int n0=rn*SLOTB, n1=(rn==2?0:rn+1)*SLOTB, n2=(rn==0?2:rn-1)*SLOTB;
      DMA_K(0,n0);DMA_V(0,n0);DMA_K(1,n1);DMA_K(2,n2); }
    r0=rn; }
  { float sacc=pB0[0]+pB0[1]; _Pragma("unroll") for(int r=2;r<16;++r)sacc+=pB0[r]; _Pragma("unroll") for(int r=0;r<16;++r)sacc+=pB1[r]; l_reg+=sacc;
    pw0=(u32x4){PKW(pB0,0),PKW(pB0,2),PKW(pB0,4),PKW(pB0,6)};pw1=(u32x4){PKW(pB0,8),PKW(pB0,10),PKW(pB0,12),PKW(pB0,14)};pw2=(u32x4){PKW(pB1,0),PKW(pB1,2),PKW(pB1,4),PKW(pB1,6)};pw3=(u32x4){PKW(pB1,8),PKW(pB1,10),PKW(pB1,12),PKW(pB1,14)};
    SBAR(); pv(o,vb0+sl_cur,PAF(0),PAF(1),PAF(2),PAF(3)); }
  #undef PKW
  #undef PAF
  #undef VFR
  #undef PIN
  #undef MX3
  #undef GAPA
  #undef GAPB
  #undef EX
  #undef VRD
  #undef KRD
  #undef STEP
  #undef ENDW
  {auto rr=__builtin_amdgcn_permlane32_swap(__float_as_uint(l_reg),__float_as_uint(l_reg),false,false);l_reg=__uint_as_float(rr[0])+__uint_as_float(rr[1]);}
  if(hi==0)wsf[32+r32]=l_reg;asm volatile("s_waitcnt lgkmcnt(0)":::"memory");
  float rli[16];
  #pragma unroll
  for(int r=0;r<16;++r)rli[r]=__builtin_amdgcn_rcpf(wsf[32+crow(r,hi)]);
  bf16*Ow=O+(rowbase+q0+wid*QBLK)*OPITCH+OCOL0+h*D;
  { bf16*stg=(bf16*)(shm+LDS_OST)+wid*2048;
    #pragma unroll
    for(int r=0;r<16;++r){const int orow=crow(r,hi);
      #pragma unroll
      for(int d0=0;d0<2;++d0)stg[orow*64+d0*32+r32]=__float2bfloat16(o[d0][r]*rli[r]);}
    asm volatile("s_waitcnt lgkmcnt(0)":::"memory");
    #pragma unroll
    for(int i=0;i<4;++i){const int row=i*8+(lane>>3),ch=lane&7; const u32x4 v=*(const u32x4*)(stg+row*64+ch*8); ATTN_STORE16(Ow+(long)row*OPITCH+ch*8,v);} }
  asm volatile("s_waitcnt lgkmcnt(0)\n\ts_barrier":::"memory");
  #undef DMA_K
  #undef DMA_V
  #undef CMASK
  #undef START
  #undef RESC
  #undef ROT
  #undef CIN
}
constexpr int ATTN_LDS_BYTES=LDS_BYTES;
struct AttnTensors { const bf16* Q; const bf16* K; const bf16* V; bf16* O; };
struct AttnUnit { int bh; int qb; };
struct StaticOrder {
  int vcu;
  __device__ __forceinline__ explicit StaticOrder(int v):vcu(v){}
  __device__ __forceinline__ bool next(int i,AttnUnit&u)const{ u.bh=vcu>>1;
    if((vcu&1)==0){ if(i>=2)return false; u.qb=(i==0)?6:2; }
    else { if(i>=6)return false; u.qb=(i==0)?7:(i==1)?5:(i==2)?4:(i==3)?3:(i==4)?1:0; }
    return true; }
  __device__ __forceinline__ void a_ready(const AttnUnit&)const{}
  __device__ __forceinline__ void done(const AttnUnit&)const{}
};
struct AttnTensorsB { const bf16* Q; const bf16* K; const bf16* V; bf16* O; const float* CB; };
template<class Sched,int THRL=20> __device__ __forceinline__ void attn_phase(char*lds,const AttnTensorsB&T,const Sched&S){
  AttnUnit u; int cur_bh=-1; int r0=0; bool pre=false;
  for(int i=0;S.next(i,u);++i){ S.a_ready(u);
    if(u.bh!=cur_bh){ cur_bh=u.bh; float*cbl=(float*)(lds+LDS_CBL); const float*src=T.CB+(size_t)u.bh*SEQ;
      int j0=threadIdx.x; asm volatile("":"+v"(j0));
      for(int j=j0;j<SEQ/4;j+=NW*64) ((f32x4_t*)cbl)[j]=((const f32x4_t*)src)[j];
      __syncthreads(); }
    AttnUnit un; const bool has_next=S.next(i+1,un)&&un.bh==u.bh;
    attn_unit<THRL>(u.bh/NHEAD,u.bh%NHEAD,u.qb,T.Q,T.K,T.V,T.O,lds,r0,pre,has_next); pre=has_next; S.done(u); }
}
#undef SBAR
#undef WAIT_BAR
}

namespace xattn {
typedef short bf16x8 __attribute__((ext_vector_type(8)));
typedef short s16x4 __attribute__((ext_vector_type(4)));
typedef short v4i16_t __attribute__((ext_vector_type(4)));
typedef float f32x16 __attribute__((ext_vector_type(16)));
typedef unsigned u32x4 __attribute__((ext_vector_type(4)));
constexpr int LDS_KV = 0, LDS_OST = 131072, LDS_WSF = LDS_OST + 8 * 2048, LDS_BYTES = LDS_WSF + 8 * 256;
__device__ __forceinline__ int crow(int r, int hi) { return (r & 3) + 8 * (r >> 2) + 4 * hi; }
__device__ __forceinline__ unsigned cvtpk(float lo, float hi) { typedef float f2 __attribute__((ext_vector_type(2))); typedef __bf16 b2 __attribute__((ext_vector_type(2))); f2 v = {lo, hi}; b2 b = __builtin_convertvector(v, b2); return __builtin_bit_cast(unsigned, b); }
__device__ __forceinline__ void xattn_unit(const bf16_t* QX, const bf16_t* KX, const bf16_t* VX, bf16_t* OX, int b, int h, int qb, LAS unsigned char* lds) {
    const int tid = threadIdx.x, lane = tid & 63, r32 = lane & 31, hi = lane >> 5, wid = __builtin_amdgcn_readfirstlane(tid >> 6);
#pragma unroll
    for (int i = 0; i < 16; ++i) { const int p = wid * 16 + i, c = p >> 2, rg = p & 3;
        __builtin_amdgcn_global_load_lds((const unsigned*)(KX + (size_t)(b * MEML + rg * 64 + lane) * D + h * XHD + c * 8), (LAS unsigned*)(lds + LDS_KV + c * 4096 + rg * 1024), 16, 0, 0); }
    const size_t qrow0 = (size_t)b * SEQ + qb * 256 + wid * 32;
    bf16x8 qf[8];
#pragma unroll
    for (int s_ = 0; s_ < 8; ++s_) qf[s_] = *(const bf16x8*)(QX + (qrow0 + r32) * D + h * XHD + 16 * s_ + 8 * hi);
    asm volatile("s_waitcnt vmcnt(0)" ::: "memory"); __builtin_amdgcn_s_barrier(); asm volatile("" ::: "memory");
    f32x16 S[8];
#pragma unroll
    for (int kb = 0; kb < 8; ++kb) S[kb] = f32x16{};
#pragma unroll
    for (int half = 0; half < 2; ++half) {
        if (half == 1) {
#pragma unroll
            for (int s_ = 0; s_ < 8; ++s_) qf[s_] = *(const bf16x8*)(QX + (qrow0 + r32) * D + h * XHD + 16 * (8 + s_) + 8 * hi);
        }
#pragma unroll
        for (int s_ = 0; s_ < 8; ++s_) { bf16x8 kf[8];
#pragma unroll
            for (int kb = 0; kb < 8; ++kb) kf[kb] = *(const LAS bf16x8*)(lds + LDS_KV + (2 * (8 * half + s_) + hi) * 4096 + (32 * kb + r32) * 16);
            __builtin_amdgcn_sched_barrier(0);
#pragma unroll
            for (int kb = 0; kb < 8; ++kb) S[kb] = __builtin_amdgcn_mfma_f32_32x32x16_bf16(kf[kb], qf[s_], S[kb], 0, 0, 0);
            __builtin_amdgcn_sched_barrier(0); }
        asm volatile("" ::: "memory");
    }
    float mx = S[0][0];
#pragma unroll
    for (int kb = 0; kb < 8; ++kb)
#pragma unroll
        for (int r = 0; r < 16; ++r) mx = fmaxf(mx, S[kb][r]);
    { auto rr = __builtin_amdgcn_permlane32_swap(__float_as_uint(mx), __float_as_uint(mx), false, false); mx = fmaxf(__uint_as_float(rr[0]), __uint_as_float(rr[1])); }
    float l = 0.f;
#pragma unroll
    for (int kb = 0; kb < 8; ++kb)
#pragma unroll
        for (int r = 0; r < 16; ++r) { const float p = __builtin_amdgcn_exp2f(S[kb][r] - mx); S[kb][r] = p; l += p; }
    { auto rr = __builtin_amdgcn_permlane32_swap(__float_as_uint(l), __float_as_uint(l), false, false); l = __uint_as_float(rr[0]) + __uint_as_float(rr[1]); }
    u32x4 pw[16];
#pragma unroll
    for (int kb = 0; kb < 8; ++kb)
#pragma unroll
        for (int sp = 0; sp < 2; ++sp) { u32x4 w; w.x = cvtpk(S[kb][8 * sp + 0], S[kb][8 * sp + 1]); w.y = cvtpk(S[kb][8 * sp + 2], S[kb][8 * sp + 3]); w.z = cvtpk(S[kb][8 * sp + 4], S[kb][8 * sp + 5]); w.w = cvtpk(S[kb][8 * sp + 6], S[kb][8 * sp + 7]); pw[2 * kb + sp] = w; }
    asm volatile("s_waitcnt lgkmcnt(0)" ::: "memory"); __builtin_amdgcn_s_barrier(); asm volatile("" ::: "memory");
#pragma unroll
    for (int i = 0; i < 16; ++i) { const int p = wid * 16 + i, dblk = p >> 4, kg = p & 15;
        __builtin_amdgcn_global_load_lds((const unsigned*)(VX + (size_t)(b * MEML + kg * 16 + (lane >> 2)) * D + h * XHD + dblk * 32 + (lane & 3) * 8), (LAS unsigned*)(lds + LDS_KV + dblk * 16384 + kg * 1024), 16, 0, 0); }
    LAS float* wsf = (LAS float*)(lds + LDS_WSF) + wid * 64;
    if (hi == 0) wsf[r32] = l;
    asm volatile("s_waitcnt vmcnt(0) lgkmcnt(0)" ::: "memory"); __builtin_amdgcn_s_barrier(); asm volatile("" ::: "memory");
    float rli[16];
#pragma unroll
    for (int r = 0; r < 16; ++r) rli[r] = __builtin_amdgcn_rcpf(wsf[crow(r, hi)]);
    const LAS unsigned char* vb = lds + LDS_KV + ((lane >> 4) & 1) * 32 + (lane & 3) * 8 + (4 * hi + ((lane & 15) >> 2)) * 64;
    LAS bf16_t* stg = (LAS bf16_t*)(lds + LDS_OST + wid * 2048);
#pragma unroll 1
    for (int dblk = 0; dblk < 8; ++dblk) {
        f32x16 o = f32x16{};
#pragma unroll
        for (int kh = 0; kh < 2; ++kh) { bf16x8 vf[8];
#pragma unroll
            for (int k8 = 0; k8 < 8; ++k8) { const int ks = 8 * kh + k8;
                const s16x4 lo = __builtin_bit_cast(s16x4, __builtin_amdgcn_ds_read_tr16_b64_v4i16((LAS v4i16_t*)(vb + dblk * 16384 + ks * 1024)));
                const s16x4 hh = __builtin_bit_cast(s16x4, __builtin_amdgcn_ds_read_tr16_b64_v4i16((LAS v4i16_t*)(vb + dblk * 16384 + ks * 1024 + 512)));
                vf[k8] = (bf16x8){lo[0], lo[1], lo[2], lo[3], hh[0], hh[1], hh[2], hh[3]}; }
            __builtin_amdgcn_sched_barrier(0);
#pragma unroll
            for (int k8 = 0; k8 < 8; ++k8) o = __builtin_amdgcn_mfma_f32_32x32x16_bf16(__builtin_bit_cast(bf16x8, pw[8 * kh + k8]), vf[k8], o, 0, 0, 0);
            __builtin_amdgcn_sched_barrier(0); }
#pragma unroll
        for (int r = 0; r < 16; ++r) stg[crow(r, hi) * 32 + r32] = (bf16_t)f2bf(o[r] * rli[r]);
        asm volatile("s_waitcnt lgkmcnt(0)" ::: "memory");
#pragma unroll
        for (int i = 0; i < 2; ++i) { const int idx = lane + 64 * i, row = idx >> 2, ch = idx & 3; const u32x4 v = *(const LAS u32x4*)(stg + row * 32 + ch * 8);
            *(u32x4*)(OX + (qrow0 + row) * D + h * XHD + dblk * 32 + ch * 8) = v; }
        asm volatile("s_waitcnt lgkmcnt(0)" ::: "memory");
    }
    asm volatile("s_waitcnt lgkmcnt(0)" ::: "memory"); __builtin_amdgcn_s_barrier(); asm volatile("" ::: "memory");
}
}

namespace ssd {
typedef short bf16x8 __attribute__((ext_vector_type(8)));
typedef short s16x4 __attribute__((ext_vector_type(4)));
typedef short v4i16_t __attribute__((ext_vector_type(4)));
typedef float f32x16 __attribute__((ext_vector_type(16)));
typedef unsigned u32x4 __attribute__((ext_vector_type(4)));
typedef unsigned u32x2 __attribute__((ext_vector_type(2)));
constexpr int L_B = 0, L_C = 32768, L_XD = 65536, L_XDD = 81920, L_SIN = 98304, L_Y = 114688, L_A2 = 147456, L_FL = 147968  , L_DT = 150528, L_CW = 151040, LDS_BYTES = 152320;
__device__ __forceinline__ int crow(int r, int hi) { return (r & 3) + 8 * (r >> 2) + 4 * hi; }
__device__ __forceinline__ unsigned cvtpk(float lo, float hi) { typedef float f2 __attribute__((ext_vector_type(2))); typedef __bf16 b2 __attribute__((ext_vector_type(2))); f2 v = {lo, hi}; b2 b = __builtin_convertvector(v, b2); return __builtin_bit_cast(unsigned, b); }
__device__ __forceinline__ bf16x8 trpair(const LAS unsigned char* p, int second_off) {
    const s16x4 lo = __builtin_bit_cast(s16x4, __builtin_amdgcn_ds_read_tr16_b64_v4i16((LAS v4i16_t*)(p)));
    const s16x4 hh = __builtin_bit_cast(s16x4, __builtin_amdgcn_ds_read_tr16_b64_v4i16((LAS v4i16_t*)(p + second_off)));
    return (bf16x8){lo[0], lo[1], lo[2], lo[3], hh[0], hh[1], hh[2], hh[3]};
}
#define SSD_BAR() do { asm volatile("s_waitcnt lgkmcnt(0)" ::: "memory"); __builtin_amdgcn_s_barrier(); asm volatile("" ::: "memory"); } while (0)
__device__ __forceinline__ void ssd_item(const KAS Ptrs& P, int bh, LAS unsigned char* lds) {
    const int tid = threadIdx.x, lane = tid & 63, r32 = lane & 31, hi = lane >> 5, wid = __builtin_amdgcn_readfirstlane(tid >> 6);
    const int lb = wid < 4 ? (wid >> 1) : 3 - ((wid - 4) >> 1), pb = wid & 1, par = pb;
    const int b = bh / NH, h = bh % NH, g = h / 8;
    unsigned char* ws = P.ws;
    const bf16_t* XA = (const bf16_t*)(ws + WS_BCA) + (size_t)b * SEQ * 512;
    const bf16_t* XRh = (h < 8 ? (const bf16_t*)(ws + WS_XRA) : (const bf16_t*)((const unsigned char*)P.out + DO_XRB)) + (size_t)b * SEQ * 512 + (h & 7) * 64;
    const bf16_t* ZS = (const bf16_t*)(ws + WS_ZS) + (size_t)b * SEQ * 1024 + h * 64;
    const float* DTT = (const float*)(ws + WS_DTT) + (size_t)bh * SEQ; const float* ACS = (const float*)(ws + WS_ACS) + (size_t)bh * SEQ;
    bf16_t* MX = (bf16_t*)(ws + WS_MIXED) + (size_t)b * SEQ * MIXW + h * 64; float* SSQ = (float*)(ws + WS_SSQ) + (size_t)b * SEQ * 16 + h;
    const bf16_t* CBTw = (const bf16_t*)(ws + WS_CBT) + ((size_t)(b * NCH * NGRP + g) * 10 + lb * (lb + 1) / 2) * 64 * 16 + lane * 16;
    const float Dk = P.d_skip[h];
    f32x16 sacc = f32x16{};
    for (int i = tid; i < 16384 / 16; i += NTHR) ((LAS u32x4*)(lds + L_SIN))[i] = (u32x4){0u, 0u, 0u, 0u};
    if (tid < 320) ((LAS float*)(lds + L_CW))[tid] = tid < 256 ? P.conv_w[(tid >> 6) * CONVD + h * 64 + (tid & 63)] : P.conv_b[h * 64 + (tid & 63)];
    const int brow = tid & 127, bch0 = tid >> 7;
    const int srow0 = tid >> 4, sch = tid & 15;
#define SSD_IMG(row, ch) ((row) * 256 + ((((ch) ^ (row)) & 15) << 4))
    const int xr2 = tid >> 3, xpc = tid & 7;
    u32x4 pB[4], pC[4], pXr[5]; float pdt[2], pac[2], pa127 = 0.f, pas = 0.f, pdtb = 0.f;
    u32x4 ez0, ez1;
    const int el = tid >> 2, ep0 = (tid & 3) * 16;
#define SSD_PREFETCH(c) do { const int t0_ = (c) * CHUNK; \
        _Pragma("unroll") for (int i = 0; i < 4; ++i) { const bf16_t* rp = XA + (size_t)(t0_ + srow0 + 32 * i) * 512 + g * 128 + sch * 8; pB[i] = *(const u32x4*)rp; pC[i] = *(const u32x4*)(rp + 256); } \
        _Pragma("unroll") for (int j = 0; j < 5; ++j) { const int tr_ = t0_ + 2 * xr2 - 3 + j; pXr[j] = (u32x4){0u, 0u, 0u, 0u}; if (tr_ >= 0) pXr[j] = *(const u32x4*)(XRh + (size_t)tr_ * 512 + xpc * 8); } \
        _Pragma("unroll") for (int i = 0; i < 2; ++i) { pdt[i] = DTT[t0_ + 2 * xr2 + i]; pac[i] = ACS[t0_ + 2 * xr2 + i]; } \
        pa127 = ACS[t0_ + 127]; pas = ACS[t0_ + brow]; pdtb = DTT[t0_ + brow]; } while (0)
#define SSD_WRITE() do { \
        _Pragma("unroll") for (int i = 0; i < 4; ++i) { const int off_ = SSD_IMG(srow0 + 32 * i, sch); *(LAS u32x4*)(lds + L_B + off_) = pB[i]; *(LAS u32x4*)(lds + L_C + off_) = pC[i]; } \
        { float xf_[5][8];   \
          _Pragma("unroll") for (int j = 0; j < 5; ++j) { const unsigned w_[4] = {pXr[j].x, pXr[j].y, pXr[j].z, pXr[j].w}; \
              _Pragma("unroll") for (int k = 0; k < 4; ++k) { xf_[j][2 * k] = __uint_as_float(w_[k] << 16); xf_[j][2 * k + 1] = __uint_as_float(w_[k] & 0xffff0000u); } } \
          float cw_[5][8]; _Pragma("unroll") for (int j = 0; j < 5; ++j) { const f32x4 a_ = *(const LAS f32x4*)(lds + L_CW + (j * 64 + xpc * 8) * 4), b_ = *(const LAS f32x4*)(lds + L_CW + (j * 64 + xpc * 8 + 4) * 4); \
              _Pragma("unroll") for (int k = 0; k < 4; ++k) { cw_[j][k] = a_[k]; cw_[j][4 + k] = b_[k]; } } \
          _Pragma("unroll") for (int i = 0; i < 2; ++i) { const int row = 2 * xr2 + i; const float s1 = pdt[i], s2 = s1 * __builtin_amdgcn_exp2f((pa127 - pac[i]) * LOG2E); \
            float xc_[8]; _Pragma("unroll") for (int k = 0; k < 8; ++k) xc_[k] = silu_f(cw_[4][k] + cw_[0][k] * xf_[i][k] + cw_[1][k] * xf_[i + 1][k] + cw_[2][k] * xf_[i + 2][k] + cw_[3][k] * xf_[i + 3][k]); \
            u32x4 o1, o2; unsigned r1[4], r2[4]; \
            _Pragma("unroll") for (int k = 0; k < 4; ++k) { r1[k] = cvtpk(xc_[2 * k] * s1, xc_[2 * k + 1] * s1); r2[k] = cvtpk(xc_[2 * k] * s2, xc_[2 * k + 1] * s2); } \
            o1 = (u32x4){r1[0], r1[1], r1[2], r1[3]}; o2 = (u32x4){r2[0], r2[1], r2[2], r2[3]}; \
            const int off = (xpc >> 2) * 8192 + (row >> 4) * 1024 + (row & 15) * 64 + (xpc & 3) * 16; \
            *(LAS u32x4*)(lds + L_XD + off) = o1; *(LAS u32x4*)(lds + L_XDD + off) = o2; } } \
        if (bch0 == (brow >> 5)) { ((LAS float*)(lds + L_A2))[brow] = pas * LOG2E; ((LAS float*)(lds + L_FL))[brow] = __builtin_amdgcn_exp2f(pas * LOG2E); ((LAS float*)(lds + L_DT))[brow] = pdtb; } } while (0)
    u32x4 pcb[2][2];
#pragma unroll
    for (int jb = 0; jb < 2; ++jb) { pcb[jb][0] = (u32x4){0u, 0u, 0u, 0u}; pcb[jb][1] = pcb[jb][0]; if (par + 2 * jb <= lb) { const bf16_t* cp = CBTw + (par + 2 * jb) * 64 * 16; pcb[jb][0] = *(const u32x4*)cp; pcb[jb][1] = *(const u32x4*)(cp + 8); } }
    SSD_BAR();
    SSD_PREFETCH(0); SSD_WRITE(); SSD_BAR();
    const int trbase = (4 * hi + ((lane & 15) >> 2)) * 64 + ((lane >> 4) & 1) * 32 + (lane & 3) * 8;
    const int nb = lb;
    const int btr_n = 32 * nb + 16 * ((lane >> 4) & 1) + 4 * (lane & 3);
    const int btr_l = 4 * hi + ((lane & 15) >> 2);
    const int btrb0 = SSD_IMG(btr_l, btr_n >> 3) + (btr_n & 7) * 2, btrb1 = SSD_IMG(btr_l + 8, btr_n >> 3) + (btr_n & 7) * 2;
#pragma unroll 1
    for (int c = 0; c < NCH; ++c) {
        if (c + 1 < NCH) SSD_PREFETCH(c + 1);
        { const size_t t = (size_t)c * CHUNK + el;
          ez0 = *(const u32x4*)(ZS + t * 1024 + ep0); ez1 = *(const u32x4*)(ZS + t * 1024 + ep0 + 8); }
        f32x16 yacc[2]; yacc[0] = f32x16{}; yacc[1] = f32x16{};
        { bf16x8 cfr[4], sfr[2][4];
#pragma unroll
          for (int k4 = 0; k4 < 4; ++k4) { const int kn = 4 * par + k4; cfr[k4] = *(const LAS bf16x8*)(lds + L_C + SSD_IMG(32 * lb + r32, 2 * kn + hi));
#pragma unroll
              for (int q = 0; q < 2; ++q) sfr[q][k4] = *(const LAS bf16x8*)(lds + L_SIN + (2 * kn + hi) * 1024 + (32 * q + r32) * 16); }
          __builtin_amdgcn_sched_barrier(0);
#pragma unroll
          for (int k4 = 0; k4 < 4; ++k4)
#pragma unroll
              for (int q = 0; q < 2; ++q) yacc[q] = __builtin_amdgcn_mfma_f32_32x32x16_bf16(cfr[k4], sfr[q][k4], yacc[q], 0, 0, 0);
#pragma unroll
          for (int g4 = 0; g4 < 4; ++g4) { const f32x4 ea = *(const LAS f32x4*)(lds + L_FL + (32 * lb + 8 * g4 + 4 * hi) * 4);
#pragma unroll
              for (int e_ = 0; e_ < 4; ++e_)
#pragma unroll
                  for (int q = 0; q < 2; ++q) yacc[q][4 * g4 + e_] *= ea[e_]; } }
        const float a2l = *(const LAS float*)(lds + L_A2 + (32 * lb + r32) * 4);
#pragma unroll
        for (int jb = 0; jb < 2; ++jb) { const int sb = par + 2 * jb; if (sb <= lb) {
            f32x4 gv[4];
#pragma unroll
            for (int g4 = 0; g4 < 4; ++g4) gv[g4] = *(const LAS f32x4*)(lds + L_A2 + (32 * sb + 8 * g4 + 4 * hi) * 4);
            const LAS unsigned char* xp = lds + L_XD + (2 * sb) * 1024 + trbase;
            const bf16x8 xv00 = trpair(xp, 512), xv01 = trpair(xp + 1024, 512), xv10 = trpair(xp + 8192, 512), xv11 = trpair(xp + 8192 + 1024, 512);
            const unsigned cw[8] = {pcb[jb][0].x, pcb[jb][0].y, pcb[jb][0].z, pcb[jb][0].w, pcb[jb][1].x, pcb[jb][1].y, pcb[jb][1].z, pcb[jb][1].w};
            float cbt[16];
#pragma unroll
            for (int k = 0; k < 8; ++k) { cbt[2 * k] = __uint_as_float(cw[k] << 16); cbt[2 * k + 1] = __uint_as_float(cw[k] & 0xffff0000u); }
            const bool diag = (sb == lb);
            const float dd = diag ? Dk * __builtin_amdgcn_rcpf(fmaxf(*(const LAS float*)(lds + L_DT + (32 * lb + r32) * 4), 1e-30f)) : 0.f;
#pragma unroll
            for (int g4 = 0; g4 < 4; ++g4)
#pragma unroll
                for (int e_ = 0; e_ < 4; ++e_) { const int r = 4 * g4 + e_; float v = (cbt[r] + (crow(r, hi) == r32 ? dd : 0.f)) * __builtin_amdgcn_exp2f(fminf(a2l - gv[g4][e_], 0.f)); if (diag && crow(r, hi) > r32) v = 0.f; cbt[r] = v; }
            u32x4 pw0, pw1;
            pw0.x = cvtpk(cbt[0], cbt[1]); pw0.y = cvtpk(cbt[2], cbt[3]); pw0.z = cvtpk(cbt[4], cbt[5]); pw0.w = cvtpk(cbt[6], cbt[7]);
            pw1.x = cvtpk(cbt[8], cbt[9]); pw1.y = cvtpk(cbt[10], cbt[11]); pw1.z = cvtpk(cbt[12], cbt[13]); pw1.w = cvtpk(cbt[14], cbt[15]);
            yacc[0] = __builtin_amdgcn_mfma_f32_32x32x16_bf16(__builtin_bit_cast(bf16x8, pw0), xv00, yacc[0], 0, 0, 0);
            yacc[1] = __builtin_amdgcn_mfma_f32_32x32x16_bf16(__builtin_bit_cast(bf16x8, pw0), xv10, yacc[1], 0, 0, 0);
            yacc[0] = __builtin_amdgcn_mfma_f32_32x32x16_bf16(__builtin_bit_cast(bf16x8, pw1), xv01, yacc[0], 0, 0, 0);
            yacc[1] = __builtin_amdgcn_mfma_f32_32x32x16_bf16(__builtin_bit_cast(bf16x8, pw1), xv11, yacc[1], 0, 0, 0);
        } }
        if (c + 1 < NCH) {
#pragma unroll
            for (int jb = 0; jb < 2; ++jb) if (par + 2 * jb <= lb) { const bf16_t* cp = CBTw + (size_t)(c + 1) * (NGRP * 10 * 64 * 16) + (par + 2 * jb) * 64 * 16; pcb[jb][0] = *(const u32x4*)cp; pcb[jb][1] = *(const u32x4*)(cp + 8); } }
#pragma unroll
        for (int g4 = 0; g4 < 4; ++g4)
#pragma unroll
            for (int e_ = 0; e_ < 4; ++e_)
#pragma unroll
                for (int q = 0; q < 2; ++q) ((LAS bf16_t*)(lds + L_Y + par * 16384))[(32 * lb + 8 * g4 + 4 * hi + e_) * 64 + 32 * q + r32] = (bf16_t)(cvtpk(yacc[q][4 * g4 + e_], 0.f) & 0xffffu);
        { const float cd = __builtin_amdgcn_exp2f(*(const LAS float*)(lds + L_A2 + 127 * 4));
#pragma unroll
          for (int r = 0; r < 16; ++r) sacc[r] *= cd;
#pragma unroll
          for (int kh = 0; kh < 2; ++kh) { bf16x8 af[4], bfq[4];
#pragma unroll
              for (int k4 = 0; k4 < 4; ++k4) { const int ks = 4 * kh + k4; af[k4] = trpair(lds + L_B + btrb0 + ks * 4096, btrb1 - btrb0); bfq[k4] = trpair(lds + L_XDD + pb * 8192 + ks * 1024 + trbase, 512); }
              __builtin_amdgcn_sched_barrier(0);
#pragma unroll
              for (int k4 = 0; k4 < 4; ++k4) sacc = __builtin_amdgcn_mfma_f32_32x32x16_bf16(af[k4], bfq[k4], sacc, 0, 0, 0); } }
        SSD_BAR();
        { const int l = el, p0 = ep0; const size_t t = (size_t)c * CHUNK + l;
          const u32x4 z0 = ez0, z1 = ez1;
          const unsigned zw[8] = {z0.x, z0.y, z0.z, z0.w, z1.x, z1.y, z1.z, z1.w};
          unsigned ow[8]; float ss = 0.f;
          const LAS bf16_t* ya = (const LAS bf16_t*)(lds + L_Y) + l * 64 + p0; const LAS bf16_t* yb = (const LAS bf16_t*)(lds + L_Y + 16384) + l * 64 + p0;
          const u32x4 a0 = *(const LAS u32x4*)ya, a1 = *(const LAS u32x4*)(ya + 8), b0 = *(const LAS u32x4*)yb, b1 = *(const LAS u32x4*)(yb + 8);
          const unsigned aw[8] = {a0.x, a0.y, a0.z, a0.w, a1.x, a1.y, a1.z, a1.w}, bw[8] = {b0.x, b0.y, b0.z, b0.w, b1.x, b1.y, b1.z, b1.w};
#pragma unroll
          for (int wi = 0; wi < 8; ++wi) {
              const float ya_ = (__uint_as_float(aw[wi] << 16) + __uint_as_float(bw[wi] << 16)) * __uint_as_float(zw[wi] << 16), yb_ = (__uint_as_float(aw[wi] & 0xffff0000u) + __uint_as_float(bw[wi] & 0xffff0000u)) * __uint_as_float(zw[wi] & 0xffff0000u);
              const unsigned w = cvtpk(ya_, yb_); ow[wi] = w; const float ra = __uint_as_float(w << 16), rb = __uint_as_float(w & 0xffff0000u); ss += ra * ra + rb * rb; }
          *(u32x4*)(MX + t * MIXW + p0) = (u32x4){ow[0], ow[1], ow[2], ow[3]}; *(u32x4*)(MX + t * MIXW + p0 + 8) = (u32x4){ow[4], ow[5], ow[6], ow[7]};
          ss += __shfl_xor(ss, 1); ss += __shfl_xor(ss, 2);
          if ((tid & 3) == 0) SSQ[t * 16] = ss; }
#pragma unroll
        for (int g4 = 0; g4 < 4; ++g4) { const int n0 = 32 * nb + 8 * g4 + 4 * hi; u32x2 w; w.x = cvtpk(sacc[4 * g4], sacc[4 * g4 + 1]); w.y = cvtpk(sacc[4 * g4 + 2], sacc[4 * g4 + 3]);
            *(LAS u32x2*)(lds + L_SIN + (n0 >> 3) * 1024 + (32 * pb + r32) * 16 + (n0 & 7) * 2) = w; }
        if (c + 1 < NCH) SSD_WRITE();
        SSD_BAR();
    }
#undef SSD_PREFETCH
#undef SSD_WRITE
#undef SSD_IMG
}
#undef SSD_BAR
}

constexpr int LDS_BYTES = 160 * 1024;
constexpr int RING_BYTES = 156 * 1024;
constexpr int MISC_OFF = RING_BYTES;

struct Frame {
    LAS unsigned char* lds; int tid, lane, wave, vcu, G; PtrsK PP;
};

template <bool MAPCOL> __device__ __forceinline__ void p0_transpose_item(const float* W, int K, int N, const float* gk, int gklen, bf16_t* WT, LAS float* scr, int item, int nblk, int lane) {
    const int kb = item / nblk, nb = item % nblk, k0 = 64 * kb, n0 = 64 * nb;
    const int c4 = lane & 15, kr = lane >> 4, ncol = n0 + 4 * c4, sc = MAPCOL ? win_src_col(ncol) : ncol;
    f32x4 v[16];
#pragma unroll
    for (int i = 0; i < 16; ++i) { const int kk = 4 * i + kr; v[i] = (f32x4){0.f, 0.f, 0.f, 0.f}; if (sc >= 0) v[i] = __builtin_nontemporal_load((const f32x4*)(W + (size_t)(k0 + kk) * N + sc)); }
#pragma unroll
    for (int i = 0; i < 16; ++i) { const int kk = 4 * i + kr; f32x4 t = v[i]; if (gk && k0 + kk < gklen) t = t * gk[k0 + kk];
        LAS float* d = scr + kk * 65 + 4 * c4; d[0] = t[0]; d[1] = t[1]; d[2] = t[2]; d[3] = t[3]; }
    asm volatile("s_waitcnt lgkmcnt(0)" ::: "memory");
    const int c = lane & 7;
#pragma unroll
    for (int j = 0; j < 8; ++j) { const int n = (lane >> 3) + 8 * j; const LAS float* sp = scr + (8 * c) * 65 + n;
        v4u o; o.x = pk2(sp[0 * 65], sp[1 * 65]); o.y = pk2(sp[2 * 65], sp[3 * 65]); o.z = pk2(sp[4 * 65], sp[5 * 65]); o.w = pk2(sp[6 * 65], sp[7 * 65]);
        *(GAS v4u*)(WT + (size_t)(n0 + n) * K + k0 + 8 * c) = o; }
    asm volatile("s_waitcnt lgkmcnt(0)" ::: "memory");
}
constexpr int I_IN = (D / 64) * (NIN / 64), I_XKV = (D / 64) * (2 * D / 64), I_OUT = (MIXW / 64) * (D / 64), I_XQ = (D / 64) * (D / 64), I_XO = I_XQ, I_UP = (D / 64) * (FF / 64), I_DN = (FF / 64) * (D / 64);
constexpr int CW_SSD_REL = 64 * 7 + 32;
constexpr int I_EARLY = I_IN + I_XKV, I_ALL = I_EARLY + I_OUT + I_XQ + I_XO + I_UP + I_DN;
__device__ __forceinline__ void p0_transposes(Frame& F, const int lo, const int hi) {
    const PtrsK PPk = F.PP; const KAS Ptrs& P = *PPk; unsigned char* ws = P.ws;
    LAS float* scr = (LAS float*)(F.lds + F.wave * 16640);
    const int gw = F.vcu * NWAVES + F.wave, NGW = F.G * NWAVES;
    for (int it = lo + gw; it < hi; it += NGW) {
        int r = it;
        if (r < I_IN) { p0_transpose_item<true>(P.w_in, D, IN_COLS, P.g_mix, D, (bf16_t*)(ws + WS_WIN), scr, r, NIN / 64, F.lane); continue; } r -= I_IN;
        if (r < I_XKV) { p0_transpose_item<false>(P.xkv_w, D, 2 * D, nullptr, 0, (bf16_t*)(ws + WS_XKV), scr, r, 2 * D / 64, F.lane); continue; } r -= I_XKV;
        if (r < I_OUT) { p0_transpose_item<false>(P.w_out, MIXW, D, P.ssm_norm_w, 1024, (bf16_t*)(ws + WS_WOUT), scr, r, D / 64, F.lane); continue; } r -= I_OUT;
        if (r < I_XQ) { p0_transpose_item<false>(P.xq_w, D, D, P.g_xattn, D, (bf16_t*)(ws + WS_XQ), scr, r, D / 64, F.lane); continue; } r -= I_XQ;
        if (r < I_XO) { p0_transpose_item<false>(P.xo_w, D, D, nullptr, 0, (bf16_t*)(ws + WS_XO), scr, r, D / 64, F.lane); continue; } r -= I_XO;
        if (r < I_UP) { p0_transpose_item<false>(P.w_up, D, FF, P.g_mlp, D, (bf16_t*)(ws + WS_WUP), scr, r, FF / 64, F.lane); continue; } r -= I_UP;
        p0_transpose_item<false>(P.w_down, FF, D, nullptr, 0, (bf16_t*)(ws + WS_WDN), scr, r, D / 64, F.lane);
    }
}
__device__ __forceinline__ void p0_transposes_dyn(Frame& F, unsigned* ctr) {
    const PtrsK PPk = F.PP; const KAS Ptrs& P = *PPk; unsigned char* ws = P.ws;
    LAS float* scr = (LAS float*)(F.lds + F.wave * 16640);
    constexpr int NLATE = I_ALL - I_EARLY - I_DN, PER = NLATE / 8;
    static_assert(NLATE % 16 == 0, "late items split evenly over 8 counters, pulled two at a time");
    const int grp = F.vcu >> 5; unsigned* myctr = ctr + 64 * grp;
    {
        unsigned done = 0, sp = 0;
        for (;;) { if (F.lane == 0) done = __hip_atomic_load(ctr + CW_SSD_REL, __ATOMIC_RELAXED, __HIP_MEMORY_SCOPE_AGENT);
            done = (unsigned)__builtin_amdgcn_readfirstlane((int)done); if (done >= (unsigned)(BATCH * NH) || ++sp > (1u << 20)) break; __builtin_amdgcn_s_sleep(8); } }
    for (;;) {
        unsigned it0 = 0; if (F.lane == 0) it0 = __hip_atomic_fetch_add(myctr, 2u, __ATOMIC_RELAXED, __HIP_MEMORY_SCOPE_AGENT);
        it0 = (unsigned)__builtin_amdgcn_readfirstlane((int)it0);
        if (it0 >= (unsigned)PER) break;
      for (int sub = 0; sub < 2; ++sub) {
        int r = grp * PER + (int)it0 + sub;
        if (r < I_OUT) { p0_transpose_item<false>(P.w_out, MIXW, D, P.ssm_norm_w, 1024, (bf16_t*)(ws + WS_WOUT), scr, r, D / 64, F.lane); continue; } r -= I_OUT;
        if (r < I_XQ) { p0_transpose_item<false>(P.xq_w, D, D, P.g_xattn, D, (bf16_t*)(ws + WS_XQ), scr, r, D / 64, F.lane); continue; } r -= I_XQ;
        if (r < I_XO) { p0_transpose_item<false>(P.xo_w, D, D, nullptr, 0, (bf16_t*)(ws + WS_XO), scr, r, D / 64, F.lane); continue; } r -= I_XO;
        if (r < I_UP) { p0_transpose_item<false>(P.w_up, D, FF, P.g_mlp, D, (bf16_t*)(ws + WS_WUP), scr, r, FF / 64, F.lane); continue; } r -= I_UP;
        p0_transpose_item<false>(P.w_down, FF, D, nullptr, 0, (bf16_t*)(ws + WS_WDN), scr, r, D / 64, F.lane);
      }
    }
}
__device__ __forceinline__ void p0_prologue(Frame& F) {
    const PtrsK PPk = F.PP; const KAS Ptrs& P = *PPk; unsigned char* ws = P.ws;
    const int gw = F.vcu * NWAVES + F.wave, NGW = F.G * NWAVES;
    bf16_t* XB = (bf16_t*)(ws + WS_XB); float* RS = (float*)(ws + WS_RSTD1);
    for (int m0 = 8 * gw; m0 < 8 * gw + 8 && m0 < M; m0 += 4) {
        f32x4 v[4][4]; float s2[4];
#pragma unroll
        for (int q = 0; q < 4; ++q) { const int m = m0 + q; const GAS f32x4* xr = (const GAS f32x4*)(P.x + (size_t)(m < M ? m : 0) * D) + F.lane;
#pragma unroll
            for (int j = 0; j < 4; ++j) v[q][j] = __builtin_nontemporal_load(xr + 64 * j); }
#pragma unroll
        for (int q = 0; q < 4; ++q) { float a = 0.f;
#pragma unroll
            for (int j = 0; j < 4; ++j) a += (v[q][j].x * v[q][j].x + v[q][j].y * v[q][j].y) + (v[q][j].z * v[q][j].z + v[q][j].w * v[q][j].w);
            s2[q] = wave_sum(a); }
#pragma unroll
        for (int q = 0; q < 4; ++q) { const int m = m0 + q; if (m < M) {
            if (F.lane == 0) RS[m] = rsqrtf(s2[q] * (1.f / D) + EPS);
            GAS unsigned long long* o8 = (GAS unsigned long long*)(XB + (size_t)m * D) + F.lane;
#pragma unroll
            for (int j = 0; j < 4; ++j) o8[64 * j] = (unsigned long long)pk2(v[q][j].x, v[q][j].y) | ((unsigned long long)pk2(v[q][j].z, v[q][j].w) << 32); } }
    }
    bf16_t* MN = (bf16_t*)(ws + WS_MEMN);
    for (int m = gw; m < MM; m += NGW) {
        const GAS f32x4* xr = (const GAS f32x4*)(P.mem + (size_t)m * D) + F.lane;
        f32x4 v[4]; float s2 = 0.f;
#pragma unroll
        for (int j = 0; j < 4; ++j) { v[j] = __builtin_nontemporal_load(xr + 64 * j); s2 += (v[j].x * v[j].x + v[j].y * v[j].y) + (v[j].z * v[j].z + v[j].w * v[j].w); }
        const float rs = rsqrtf(wave_sum(s2) * (1.f / D) + EPS);
        GAS unsigned long long* o8 = (GAS unsigned long long*)(MN + (size_t)m * D) + F.lane;
#pragma unroll
        for (int j = 0; j < 4; ++j) { const f32x4 g = ((const GAS f32x4*)P.g_mem)[F.lane + 64 * j];
            o8[64 * j] = (unsigned long long)pk2(v[j].x * rs * g.x, v[j].y * rs * g.y) | ((unsigned long long)pk2(v[j].z * rs * g.z, v[j].w * rs * g.w) << 32); }
    }
    p0_transposes(F, 0, I_EARLY);
}

__device__ __forceinline__ void p2_conv_scan(Frame& F) {
    const PtrsK PPk = F.PP; const KAS Ptrs& P = *PPk; unsigned char* ws = P.ws;
    const bf16_t* XR = (const bf16_t*)(ws + WS_BCR); bf16_t* XA = (bf16_t*)(ws + WS_BCA);
    for (int item = F.vcu; item < BATCH * NCH * NGRP; item += F.G) {
        typedef short bf16x8 __attribute__((ext_vector_type(8))); typedef float f32x16 __attribute__((ext_vector_type(16)));
        const int b = item >> 5, c = (item >> 1) & 15, g = item & 1, tid = F.tid, lane = F.lane, r32 = lane & 31, hi = lane >> 5;
        const size_t t0 = (size_t)b * SEQ + c * CHUNK;
        { const int ch8 = tid & 31, run = tid >> 5, isC = ch8 >> 4, c0 = 1024 + isC * 256 + g * 128 + (ch8 & 15) * 8, cb0 = c0 - 1024;
          float w[4][8], bb[8];
#pragma unroll
          for (int j = 0; j < 4; ++j)
#pragma unroll
              for (int i = 0; i < 8; ++i) w[j][i] = P.conv_w[j * CONVD + c0 + i];
#pragma unroll
          for (int i = 0; i < 8; ++i) bb[i] = P.conv_b[c0 + i];
          float h0[8], h1[8], h2[8];
          { v4u r0 = {0, 0, 0, 0}, r1 = r0, r2 = r0; const size_t tr = t0 + run * 8;
            if (!(c == 0 && run == 0)) { r0 = *(const v4u*)(XR + (tr - 3) * 512 + cb0); r1 = *(const v4u*)(XR + (tr - 2) * 512 + cb0); r2 = *(const v4u*)(XR + (tr - 1) * 512 + cb0); }
            const unsigned a0[4] = {r0.x, r0.y, r0.z, r0.w}, a1[4] = {r1.x, r1.y, r1.z, r1.w}, a2[4] = {r2.x, r2.y, r2.z, r2.w};
#pragma unroll
            for (int i = 0; i < 4; ++i) { h0[2 * i] = __uint_as_float(a0[i] << 16); h0[2 * i + 1] = __uint_as_float(a0[i] & 0xffff0000u);
                h1[2 * i] = __uint_as_float(a1[i] << 16); h1[2 * i + 1] = __uint_as_float(a1[i] & 0xffff0000u);
                h2[2 * i] = __uint_as_float(a2[i] << 16); h2[2 * i + 1] = __uint_as_float(a2[i] & 0xffff0000u); } }
#pragma unroll
          for (int r = 0; r < 8; ++r) { const int row = run * 8 + r;
              const v4u cv = *(const v4u*)(XR + (t0 + row) * 512 + cb0); const unsigned cw[4] = {cv.x, cv.y, cv.z, cv.w};
              float cur[8], o[8];
#pragma unroll
              for (int i = 0; i < 4; ++i) { cur[2 * i] = __uint_as_float(cw[i] << 16); cur[2 * i + 1] = __uint_as_float(cw[i] & 0xffff0000u); }
#pragma unroll
              for (int i = 0; i < 8; ++i) { o[i] = silu_f(bb[i] + w[0][i] * h0[i] + w[1][i] * h1[i] + w[2][i] * h2[i] + w[3][i] * cur[i]); h0[i] = h1[i]; h1[i] = h2[i]; h2[i] = cur[i]; }
              v4u ov; ov.x = pk2(o[0], o[1]); ov.y = pk2(o[2], o[3]); ov.z = pk2(o[4], o[5]); ov.w = pk2(o[6], o[7]);
              *(v4u*)(XA + (t0 + row) * 512 + cb0) = ov;
              *(LAS v4u*)(F.lds + isC * 32768 + (ch8 & 15) * 2048 + row * 16) = ov; } }
        asm volatile("s_waitcnt lgkmcnt(0)" ::: "memory"); __builtin_amdgcn_s_barrier(); asm volatile("" ::: "memory");
        bf16_t* CBT = (bf16_t*)(ws + WS_CBT) + (size_t)item * 10 * 64 * 16;
#pragma unroll 1
        for (int blk = F.wave; blk < 10; blk += NWAVES) {
            const int lb = blk < 1 ? 0 : blk < 3 ? 1 : blk < 6 ? 2 : 3, sb = blk - lb * (lb + 1) / 2;
            bf16x8 bfr[8], cfr[8];
#pragma unroll
            for (int kn = 0; kn < 8; ++kn) { bfr[kn] = *(const LAS bf16x8*)(F.lds + (2 * kn + hi) * 2048 + (32 * sb + r32) * 16); cfr[kn] = *(const LAS bf16x8*)(F.lds + 32768 + (2 * kn + hi) * 2048 + (32 * lb + r32) * 16); }
            __builtin_amdgcn_sched_barrier(0);
            f32x16 cbt = f32x16{};
#pragma unroll
            for (int kn = 0; kn < 8; ++kn) cbt = __builtin_amdgcn_mfma_f32_32x32x16_bf16(bfr[kn], cfr[kn], cbt, 0, 0, 0);
            v4u o0, o1;
            o0.x = pk2(cbt[0], cbt[1]); o0.y = pk2(cbt[2], cbt[3]); o0.z = pk2(cbt[4], cbt[5]); o0.w = pk2(cbt[6], cbt[7]);
            o1.x = pk2(cbt[8], cbt[9]); o1.y = pk2(cbt[10], cbt[11]); o1.z = pk2(cbt[12], cbt[13]); o1.w = pk2(cbt[14], cbt[15]);
            *(v4u*)(CBT + ((size_t)blk * 64 + lane) * 16) = o0; *(v4u*)(CBT + ((size_t)blk * 64 + lane) * 16 + 8) = o1;
        }
        asm volatile("s_waitcnt lgkmcnt(0)" ::: "memory"); __builtin_amdgcn_s_barrier(); asm volatile("" ::: "memory");
    }
    if (F.vcu < BATCH * NH) {
        const int bh = F.vcu, b = bh / NH, h = bh % NH, lane = F.lane, p0 = 256 * F.wave + 4 * lane;
        const float* DT = (const float*)(ws + WS_DT); const float* LF = (const float*)(ws + WS_LF);
        float* DTT = (float*)(ws + WS_DTT) + (size_t)bh * SEQ; float* ACS = (float*)(ws + WS_ACS) + (size_t)bh * SEQ; float* CB = (float*)(ws + WS_CUMB) + (size_t)bh * SEQ;
        const float A = -expf(P.a_log[h]);
        float dt[4], da[4], lf[4];
#pragma unroll
        for (int j4 = 0; j4 < 4; ++j4) { const size_t m = (size_t)b * SEQ + p0 + j4; dt[j4] = DT[m * 16 + h]; lf[j4] = LF[m * 16 + h]; }
        da[0] = dt[0] * A;
#pragma unroll
        for (int j4 = 1; j4 < 4; ++j4) { da[j4] = da[j4 - 1] + dt[j4] * A; lf[j4] += lf[j4 - 1]; }
        float pa = da[3], pf = lf[3];
#pragma unroll
        for (int o = 1; o < 32; o <<= 1) { const float t = __shfl_up(pa, o); if ((lane & 31) >= o) pa += t; }
#pragma unroll
        for (int o = 1; o < 64; o <<= 1) { const float t = __shfl_up(pf, o); if (lane >= o) pf += t; }
        LAS float* wt = (LAS float*)(F.lds + 140 * 1024);
        if (lane == 63) wt[F.wave] = pf;
        asm volatile("s_waitcnt lgkmcnt(0)" ::: "memory"); __builtin_amdgcn_s_barrier(); asm volatile("" ::: "memory");
        float base = 0.f;
        for (int w = 0; w < F.wave; ++w) base += wt[w];
        const float ea = pa - da[3], ef = pf - lf[3] + base;
        *(f32x4*)(DTT + p0) = (f32x4){dt[0], dt[1], dt[2], dt[3]};
        *(f32x4*)(ACS + p0) = (f32x4){da[0] + ea, da[1] + ea, da[2] + ea, da[3] + ea};
        *(f32x4*)(CB + p0) = (f32x4){(lf[0] + ef) * LOG2E, (lf[1] + ef) * LOG2E, (lf[2] + ef) * LOG2E, (lf[3] + ef) * LOG2E};
    }
}

struct Args { Ptrs P; int ph_lo, ph_hi, flags, pad; };
__device__ __forceinline__ bool in_phase(const KAS Args* ka, int k) { asm volatile("" : "+s"(ka)); return ka->ph_lo <= k && k < ka->ph_hi; }
__device__ __forceinline__ PtrsK launder(PtrsK p) { asm volatile("" : "+s"(p)); return p; }

typedef GAS unsigned gu32;
#define XB_TMO      128
#define XB_XCNT(j)  (256  + 64 * (j))
#define XB_XSUB(j)  (1280 + 64 * (j))
#define XB_XGEN(j)  (2304 + 64 * (j))
#define XB_TOP      3328
#define XB_TOPGEN   3392
#define XCD_BAR_WORDS 3456
#define XB_SPIN_CAP (1u << 18)
__device__ __forceinline__ unsigned xb_ld(unsigned* p)              { return __hip_atomic_load(p, __ATOMIC_RELAXED, __HIP_MEMORY_SCOPE_AGENT); }
__device__ __forceinline__ unsigned xb_add(unsigned* p, unsigned v) { return __hip_atomic_fetch_add(p, v, __ATOMIC_RELAXED, __HIP_MEMORY_SCOPE_AGENT); }
__device__ __forceinline__ unsigned xb_xcc_id() { return (unsigned)__builtin_amdgcn_s_getreg((3 << 11) | 20) & 0xFu; }
#define XB_SPIN(cond, bar) do { unsigned _sp = 0; while (cond) { __builtin_amdgcn_s_sleep(1); \
    if ((++_sp & 255u) == 0u) { if (xb_ld(&(bar)[XB_TMO])) break; if (_sp > XB_SPIN_CAP) { atomicAdd(&(bar)[XB_TMO], 1u); break; } } } } while (0)
struct XcdBarrier { unsigned* bar; unsigned x; volatile LAS unsigned* st; };
__device__ __forceinline__ XcdBarrier xcd_barrier_post(unsigned* bar, volatile LAS unsigned* st) {
    XcdBarrier b; b.bar = bar; b.x = xb_xcc_id(); b.st = st;
    if (threadIdx.x == 0) (void)xb_add(&bar[XB_XCNT(b.x)], 1u);
    return b;
}
__device__ __forceinline__ void xcd_barrier_complete(unsigned* bar, unsigned x, unsigned& nloc, unsigned& nx) {
    const unsigned G = gridDim.x * gridDim.y * gridDim.z;
    unsigned sum, cnt, mine, sp = 0u;
    for (;;) {
        sum = 0u; cnt = 0u; mine = 0u;
#pragma unroll
        for (unsigned j = 0; j < 16; ++j) { const unsigned c = xb_ld(&bar[XB_XCNT(j)]); sum += c; cnt += (c > 0u) ? 1u : 0u; mine = (j == x) ? c : mine; }
        if (sum == G) break;
        __builtin_amdgcn_s_sleep(1);
        if ((++sp & 255u) == 0u) { if (xb_ld(&bar[XB_TMO])) break; if (sp > XB_SPIN_CAP) { atomicAdd(&bar[XB_TMO], 1u); break; } }
    }
    nloc = mine > 0u ? mine : 1u; nx = cnt > 0u ? cnt : 1u;
}
__device__ __forceinline__ void xcd_barrier(const XcdBarrier& b) {
    asm volatile("s_waitcnt vmcnt(0)" ::: "memory");
    __syncthreads();
    if (threadIdx.x == 0) {
        unsigned* bar = b.bar;
        __builtin_amdgcn_s_waitcnt(0);
        unsigned nloc = b.st[0], nx = b.st[1];
        if (nloc == 0u) { xcd_barrier_complete(bar, b.x, nloc, nx); b.st[0] = nloc; b.st[1] = nx; }
        const unsigned old = xb_add(&bar[XB_XSUB(b.x)], 1u);
        const unsigned gen = old / nloc;
        if (old + 1u == (gen + 1u) * nloc) {
            __builtin_amdgcn_fence(__ATOMIC_RELEASE, "agent");
            asm volatile("s_waitcnt vmcnt(0)" ::: "memory");
            const unsigned og = xb_add(&bar[XB_TOP], 1u);
            const unsigned tg = og / nx;
            if (og + 1u == (tg + 1u) * nx) xb_add(&bar[XB_TOPGEN], 1u);
            else XB_SPIN(xb_ld(&bar[XB_TOPGEN]) == tg, bar);
            __builtin_amdgcn_fence(__ATOMIC_ACQUIRE, "agent");
            xb_add(&bar[XB_XGEN(b.x)], 1u);
            asm volatile("s_waitcnt vmcnt(0)" ::: "memory");
        } else {
            XB_SPIN(xb_ld(&bar[XB_XGEN(b.x)]) == gen, bar);
            __builtin_amdgcn_fence(__ATOMIC_ACQUIRE, "agent");
            asm volatile("s_waitcnt vmcnt(0)" ::: "memory");
        }
    }
    __syncthreads();
}
constexpr int CW_LATE = 7680;
constexpr int CW_BAR = 4096;
typedef const KAS Args* ArgsK;
__device__ __forceinline__ ArgsK launder(ArgsK p) { asm volatile("" : "+s"(p)); return p; }
__device__ __forceinline__ int vcu_of() { const int G = gridDim.x, bx = blockIdx.x; return (G % 8 == 0) ? (bx % 8) * (G / 8) + bx / 8 : bx; }
__device__ __forceinline__ Frame make_frame(LAS unsigned char* lds, PtrsK pp) { Frame F; F.lds = lds; F.tid = threadIdx.x; F.lane = F.tid & 63; F.wave = __builtin_amdgcn_readfirstlane(F.tid >> 6); F.G = gridDim.x; F.vcu = vcu_of(); F.PP = pp; return F; }
__global__ void __launch_bounds__(NTHR, 2) fwd(Args args_unused) {
    extern __shared__ __attribute__((aligned(16))) unsigned char lds_raw[];
    const ArgsK KA = (ArgsK)__builtin_amdgcn_kernarg_segment_ptr();
    volatile LAS unsigned* MISC = (volatile LAS unsigned*)((LAS unsigned char*)lds_raw + MISC_OFF);
    if (threadIdx.x < 4) MISC[threadIdx.x] = 0u;
    __syncthreads();
    XcdBarrier bar; bar.bar = nullptr; bar.x = 0; bar.st = MISC;
    { const ArgsK A = launder(KA); if (A->ph_hi - A->ph_lo > 1) bar = xcd_barrier_post((unsigned*)(A->P.ws + WS_CTL) + CW_BAR, MISC); }
#define SEAM(k) do { if (in_phase(KA, (k)) && in_phase(KA, (k) + 1)) xcd_barrier(bar); } while (0)
#ifndef PH_MASK
#define PH_MASK 0xFFFF
#endif
#define IN(k) (((PH_MASK >> (k)) & 1) && in_phase(KA, (k)))
#define LDSP ((LAS unsigned char*)lds_raw)
#define XLP (LDSP + pg8::STAGE_BYTES)
    if (IN(0)) { const ArgsK A = launder(KA); Frame F = make_frame(LDSP, &A->P); p0_prologue(F); }
    SEAM(0);
    if (IN(1)) {
        const ArgsK A = launder(KA); const PtrsK PP = &A->P; const int v = vcu_of();
        pg8::SchedP1 S{(const char*)PP->out, (const char*)PP->ws, v >> 5, v & 31};
        pg8::EpiP1 E{PP};
        pg8::gemm_phase(LDSP, XLP, D, S, E);
    }
    SEAM(1);
    if (IN(2)) { const ArgsK A = launder(KA); Frame F = make_frame(LDSP, &A->P); p2_conv_scan(F); }
    SEAM(2);
    if (IN(3)) {
        static_assert(attn_body::ATTN_LDS_BYTES <= RING_BYTES && ssd::LDS_BYTES <= RING_BYTES, "mixer LDS");
        { const int v = vcu_of(); const ArgsK A = launder(KA); if ((v & 1) == 0) { ssd::ssd_item(A->P, v >> 1, LDSP); __syncthreads();
            if (threadIdx.x == 0) (void)__hip_atomic_fetch_add((unsigned*)(A->P.ws + WS_CTL) + CW_LATE + CW_SSD_REL, 1u, __ATOMIC_RELAXED, __HIP_MEMORY_SCOPE_AGENT);
            static_assert(I_DN == 128 * NWAVES, "one item per wave of the even CUs");
            const int w = __builtin_amdgcn_readfirstlane(threadIdx.x >> 6);
            p0_transpose_item<false>(A->P.w_down, FF, D, nullptr, 0, (bf16_t*)(A->P.ws + WS_WDN), (LAS float*)(LDSP + w * 16640), (v >> 1) * NWAVES + w, D / 64, threadIdx.x & 63);
            __syncthreads(); } }
        { const ArgsK A = launder(KA); unsigned char* ws = A->P.ws;
        const attn_body::AttnTensorsB AT{(const attn_body::bf16*)(ws + WS_Q), (const attn_body::bf16*)(ws + WS_K), (const attn_body::bf16*)(ws + WS_V), (attn_body::bf16*)(ws + WS_MIXED), (const float*)(ws + WS_CUMB)};
        const attn_body::StaticOrder S(vcu_of());
        attn_body::attn_phase<attn_body::StaticOrder>((char*)lds_raw, AT, S); }
        { __syncthreads(); const ArgsK A = launder(KA); Frame F = make_frame(LDSP, &A->P); p0_transposes_dyn(F, (unsigned*)(A->P.ws + WS_CTL) + CW_LATE); }
    }
    SEAM(3);
    if (IN(4)) {
        const ArgsK A = launder(KA); const PtrsK PP = &A->P; unsigned char* ws = PP->ws; const int v = vcu_of();
        pg8::SchedOne S{(const char*)(ws + WS_MIXED), (const char*)(ws + WS_WOUT), v >> 5, v & 31, 32, (size_t)256 * MIXW * 2};
        pg8::EpiRes<true, false> E{PP->x, (bf16_t*)(ws + WS_X1B), (float*)(ws + WS_SSQ2), (const float*)(ws + WS_SSQ)};
        pg8::gemm_phase(LDSP, XLP, MIXW, S, E);
    }
    SEAM(4);
    if (IN(5)) {
        const ArgsK A = launder(KA); const PtrsK PP = &A->P; unsigned char* ws = PP->ws; const int v = vcu_of();
        pg8::SchedOne S{(const char*)(ws + WS_X1B), (const char*)(ws + WS_XQ), v >> 5, v & 31, 32, (size_t)256 * D * 2};
        pg8::EpiXq E{(const float*)(ws + WS_SSQ2), PP->xg_q, (bf16_t*)(ws + WS_QX)};
        pg8::gemm_phase(LDSP, XLP, D, S, E);
    }
    if (in_phase(KA, 5) && in_phase(KA, 6)) { if (threadIdx.x == 0) { __builtin_amdgcn_fence(__ATOMIC_ACQUIRE, "agent"); asm volatile("s_waitcnt vmcnt(0)" ::: "memory"); } __syncthreads(); }
    if (IN(6)) {
        static_assert(xattn::LDS_BYTES <= RING_BYTES, "xattn LDS");
        const ArgsK A = launder(KA); unsigned char* ws = A->P.ws;
        for (int u = vcu_of(); u < BATCH * XH * 8; u += (int)gridDim.x)
            xattn::xattn_unit((const bf16_t*)(ws + WS_QX), (const bf16_t*)(ws + WS_KX), (const bf16_t*)(ws + WS_VX), (bf16_t*)(ws + WS_OX), u >> 5, (u >> 3) & 3, u & 7, LDSP);
    }
    SEAM(6);
    if (IN(7)) {
        const ArgsK A = launder(KA); const PtrsK PP = &A->P; unsigned char* ws = PP->ws; const int v = vcu_of();
        pg8::SchedOne S{(const char*)(ws + WS_OX), (const char*)(ws + WS_XO), v >> 5, v & 31, 32, (size_t)256 * D * 2};
        pg8::EpiRes<false, true> E{ws + WS_X1B, (bf16_t*)(ws + WS_X2B), (float*)(ws + WS_SSQ3), nullptr};
        pg8::gemm_phase(LDSP, XLP, D, S, E);
    }
    SEAM(7);
    if (IN(8)) {
        const ArgsK A = launder(KA); const PtrsK PP = &A->P; unsigned char* ws = PP->ws; const int v = vcu_of();
        pg8::SchedOne S{(const char*)(ws + WS_X2B), (const char*)(ws + WS_WUP), v >> 5, v & 31, 128, (size_t)256 * D * 2};
        pg8::EpiUp E{(const float*)(ws + WS_SSQ3), (bf16_t*)(ws + WS_HB)};
        pg8::gemm_phase(LDSP, XLP, D, S, E);
    }
    SEAM(8);
    if (IN(9)) {
        const ArgsK A = launder(KA); const PtrsK PP = &A->P; unsigned char* ws = PP->ws; const int v = vcu_of();
        pg8::SchedOne S{(const char*)(ws + WS_HB), (const char*)(ws + WS_WDN), v >> 5, v & 31, 32, (size_t)256 * FF * 2};
        pg8::EpiDown E{(const bf16_t*)(ws + WS_X2B), PP->out};
        pg8::gemm_phase(LDSP, XLP, FF, S, E);
    }
#undef IN
#undef SEAM
#undef LDSP
#undef XLP
}

extern "C" void kernel_launch(void* const* d_in, const int* in_sizes, int n_in, void* d_out, int out_size, void* d_ws, size_t ws_size, hipStream_t stream) {
    static int ready = 0;
    if (!ready) {
        if (n_in != 24 || out_size != M * D || ws_size < WS_END) { fprintf(stderr, "kernel_launch: unexpected shapes (n_in %d out %d ws %zu)\n", n_in, out_size, ws_size); ready = -1; return; }
        if (hipFuncSetAttribute((const void*)fwd, hipFuncAttributeMaxDynamicSharedMemorySize, LDS_BYTES) != hipSuccess) { fprintf(stderr, "kernel_launch: hipFuncSetAttribute failed\n"); ready = -1; return; }
        int dev = 0, cus = 0, per_cu = 0;
        if (hipGetDevice(&dev) != hipSuccess || hipDeviceGetAttribute(&cus, hipDeviceAttributeMultiprocessorCount, dev) != hipSuccess) cus = 0;
        if (hipOccupancyMaxActiveBlocksPerMultiprocessor(&per_cu, (const void*)fwd, NTHR, LDS_BYTES) != hipSuccess) per_cu = 0;
        (void)hipGetLastError();
        ready = (cus * per_cu >= 256) ? 2 : 1;
    }
    if (ready < 0) return;
    Args a{};
    const float** pp = (const float**)&a.P;
    for (int i = 0; i < 24; ++i) pp[i] = (const float*)d_in[i];
    a.P.out = (float*)d_out; a.P.ws = (unsigned char*)d_ws;
    (void)hipMemsetAsync((char*)d_ws + WS_CTL, 0, CTL_ZERO_BYTES, stream);
    const int G = 256;
    auto PH = [&](int lo, int hi) { a.ph_lo = lo; a.ph_hi = hi; hipLaunchKernelGGL(fwd, dim3(G), dim3(NTHR), LDS_BYTES, stream, a); };
#ifndef N_LAUNCHES
#define N_LAUNCHES 1
#endif
    if (N_LAUNCHES == 1 && ready == 2) PH(0, 10);
    else for (int p = 0; p < 10; ++p) PH(p, p + 1);
}
```
